# Optimizing an MI355X kernel written in HIP

```python
import math
import jax, jax.numpy as jnp
from jax import lax
import numpy as np

D_MODEL = 2048
BATCH = 4
SEQ = 2048
DEPTH = 2
DEC_BATCH = 128
DEC_SEQ = 8
PAST_LEN = 16384
PAGE_SIZE = 128

GLA_HEADS = 4
GLA_KEY_DIM = D_MODEL // 2
GLA_VAL_DIM = D_MODEL
GLA_HEAD_K = GLA_KEY_DIM // GLA_HEADS
GLA_HEAD_V = GLA_VAL_DIM // GLA_HEADS
GLA_GATE_RANK = 16
GLA_GATE_TAU = 16.0
GLA_CHUNK = 64
GLA_IN_WIDTH = 2 * GLA_KEY_DIM + 2 * GLA_VAL_DIM + GLA_GATE_RANK
SG_WIDTH = D_MODEL
SG_GROUPS = 8
SG_GROUP_DIM = SG_WIDTH // SG_GROUPS
SG_CHUNK = 128
D_FF = 4 * D_MODEL
N_MIXERS = 2
N_GLA = (DEPTH + 1) // 2
N_SG = DEPTH // 2
DEEPNORM_ALPHA = (2.0 * DEPTH) ** 0.25
DEEPNORM_BETA = (8.0 * DEPTH) ** -0.25
LN_EPS = 1e-5
HEAD_NORM_EPS = 1e-6

kernel_name = "gla_gmlp_hybrid_deepnorm_step"


def layer_norm(x, g, b):
    xf = x.astype(jnp.float32)
    mu = jnp.mean(xf, axis=-1, keepdims=True)
    var = jnp.mean(jnp.square(xf - mu), axis=-1, keepdims=True)
    return ((xf - mu) * lax.rsqrt(var + LN_EPS) * g + b).astype(x.dtype)


def gla_chunked(q, k, v, log_a, s0):
    bsz, t, h, _ = q.shape
    dv = v.shape[-1]
    c = min(GLA_CHUNK, t)
    n = -(-t // c)
    pad = n * c - t

    def prep(a):
        a = jnp.pad(a.astype(jnp.float32), ((0, 0), (0, pad), (0, 0), (0, 0)))
        return a.reshape(bsz, n, c, h, a.shape[-1]).transpose(1, 0, 3, 2, 4)

    qc, kc, vc, gc = prep(q), prep(k), prep(v), prep(log_a)
    causal = jnp.tril(jnp.ones((c, c), dtype=bool))

    def step(s, inp):
        qi, ki, vi, gi = inp
        b = jnp.cumsum(gi, axis=-2)
        b_last = b[..., -1:, :]
        q_dec = qi * jnp.exp(b)
        k_inv = ki * jnp.exp(-b)
        k_to_end = ki * jnp.exp(b_last - b)
        scores = jnp.where(causal, jnp.einsum('bhtk,bhsk->bhts', q_dec, k_inv), 0.0)
        o = (jnp.einsum('bhtk,bhkv->bhtv', q_dec, s)
             + jnp.einsum('bhts,bhsv->bhtv', scores, vi))
        s_new = (jnp.exp(b_last[..., 0, :])[..., None] * s
                 + jnp.einsum('bhsk,bhsv->bhkv', k_to_end, vi))
        return s_new, o

    s_fin, o = lax.scan(step, s0.astype(jnp.float32), (qc, kc, vc, gc))
    o = o.transpose(1, 0, 3, 2, 4).reshape(bsz, n * c, h, dv)[:, :t]
    return o, s_fin


def gla_mixer(x, w_in, w_gate, b_gate, norm_g, w_out, s0):
    bsz, t, _ = x.shape
    proj = x @ w_in
    q, k, v, r, g_low = jnp.split(
        proj, [GLA_KEY_DIM, 2 * GLA_KEY_DIM, 2 * GLA_KEY_DIM + GLA_VAL_DIM,
               2 * GLA_KEY_DIM + 2 * GLA_VAL_DIM], axis=-1)
    q = q.reshape(bsz, t, GLA_HEADS, GLA_HEAD_K) * (GLA_HEAD_K ** -0.5)
    k = k.reshape(bsz, t, GLA_HEADS, GLA_HEAD_K)
    v = v.reshape(bsz, t, GLA_HEADS, GLA_HEAD_V)
    gate_logit = (g_low @ w_gate + b_gate).astype(jnp.float32)
    log_a = (jax.nn.log_sigmoid(gate_logit) / GLA_GATE_TAU).reshape(bsz, t, GLA_HEADS, GLA_HEAD_K)
    o, s_fin = gla_chunked(q, k, v, log_a, s0)
    o = o * lax.rsqrt(jnp.mean(jnp.square(o), axis=-1, keepdims=True) + HEAD_NORM_EPS) * norm_g
    o = o.reshape(bsz, t, GLA_VAL_DIM).astype(x.dtype) * jax.nn.silu(r)
    return o @ w_out, s_fin.astype(s0.dtype)


def sg_mixer(x, w_in, b_in, v_norm_g, v_norm_b, w_spatial, b_spatial, w_out):
    bsz, t, _ = x.shape
    z = jax.nn.gelu(x @ w_in + b_in, approximate=False)
    u, v = jnp.split(z, 2, axis=-1)
    v = layer_norm(v, v_norm_g, v_norm_b)
    n = -(-t // SG_CHUNK)
    pad = n * SG_CHUNK - t
    vp = jnp.pad(v, ((0, 0), (0, pad), (0, 0))).reshape(bsz, n, SG_CHUNK, SG_GROUPS, SG_GROUP_DIM)
    causal = jnp.tril(jnp.ones((SG_CHUNK, SG_CHUNK), dtype=bool))
    w_causal = jnp.where(causal, w_spatial, 0.0).astype(v.dtype)
    mixed = jnp.einsum('gts,bnsgd->bntgd', w_causal, vp) + b_spatial.T[:, :, None]
    mixed = mixed.reshape(bsz, n * SG_CHUNK, SG_WIDTH)[:, :t]
    return (u * mixed) @ w_out, v


def sq_relu_mlp(x, w1, w2):
    return jnp.square(jax.nn.relu(x @ w1)) @ w2


def setup_inputs(seed: int = 0) -> dict:
    key = jax.random.key(seed)
    ks = jax.random.split(key, 24)
    nrm = lambda k, shape, s: jax.random.normal(k, shape, jnp.float32) * s
    return {
        "x_prompt": nrm(ks[0], (BATCH, SEQ, D_MODEL), 1.0),
        "x_sample": nrm(ks[1], (DEC_BATCH, DEC_SEQ, D_MODEL), 1.0),
        "state_gla": nrm(ks[2], (N_GLA, DEC_BATCH, GLA_HEADS, GLA_HEAD_K, GLA_HEAD_V), 1.0),
        "gla_w_in": nrm(ks[3], (N_GLA, D_MODEL, GLA_IN_WIDTH), D_MODEL ** -0.5),
        "gla_w_gate": nrm(ks[4], (N_GLA, GLA_GATE_RANK, GLA_KEY_DIM), GLA_GATE_RANK ** -0.5),
        "gla_b_gate": nrm(ks[5], (N_GLA, GLA_KEY_DIM), 0.1),
        "gla_norm_g": 1.0 + nrm(ks[6], (N_GLA, GLA_HEADS, GLA_HEAD_V), 0.02),
        "gla_w_out": nrm(ks[7], (N_GLA, GLA_VAL_DIM, D_MODEL), GLA_VAL_DIM ** -0.5 * DEEPNORM_BETA),
        "sg_w_in": nrm(ks[8], (N_SG, D_MODEL, 2 * SG_WIDTH), D_MODEL ** -0.5),
        "sg_b_in": nrm(ks[9], (N_SG, 2 * SG_WIDTH), 0.02),
        "sg_v_norm_g": 1.0 + nrm(ks[10], (N_SG, SG_WIDTH), 0.02),
        "sg_v_norm_b": nrm(ks[11], (N_SG, SG_WIDTH), 0.02),
        "sg_w_spatial": nrm(ks[12], (N_SG, SG_GROUPS, SG_CHUNK, SG_CHUNK), SG_CHUNK ** -0.5),
        "sg_b_spatial": 1.0 + nrm(ks[13], (N_SG, SG_GROUPS, SG_CHUNK), 0.02),
        "sg_w_out": nrm(ks[14], (N_SG, SG_WIDTH, D_MODEL), SG_WIDTH ** -0.5 * DEEPNORM_BETA),
        "mlp_w1": nrm(ks[15], (DEPTH, D_MODEL, D_FF), D_MODEL ** -0.5),
        "mlp_w2": nrm(ks[16], (DEPTH, D_FF, D_MODEL), D_FF ** -0.5 * DEEPNORM_BETA),
        "ln1_g": 1.0 + nrm(ks[17], (DEPTH, D_MODEL), 0.02),
        "ln1_b": nrm(ks[18], (DEPTH, D_MODEL), 0.02),
        "ln2_g": 1.0 + nrm(ks[19], (DEPTH, D_MODEL), 0.02),
        "ln2_b": nrm(ks[20], (DEPTH, D_MODEL), 0.02),
    }


def reference(x_prompt, x_sample, state_gla, gla_w_in, gla_w_gate, gla_b_gate, gla_norm_g,
              gla_w_out, sg_w_in, sg_b_in, sg_v_norm_g, sg_v_norm_b, sg_w_spatial,
              sg_b_spatial, sg_w_out, mlp_w1, mlp_w2, ln1_g, ln1_b, ln2_g, ln2_b):
    def run(x, gla_state0):
        new_gla, new_v = [], []
        for i in range(DEPTH):
            j = i // N_MIXERS
            if i % N_MIXERS == 0:
                h, s = gla_mixer(x, gla_w_in[j], gla_w_gate[j], gla_b_gate[j], gla_norm_g[j],
                                 gla_w_out[j], gla_state0[j])
                new_gla.append(s)
            else:
                h, v_rows = sg_mixer(x, sg_w_in[j], sg_b_in[j], sg_v_norm_g[j], sg_v_norm_b[j],
                                     sg_w_spatial[j], sg_b_spatial[j], sg_w_out[j])
                new_v.append(v_rows)
            x = layer_norm(DEEPNORM_ALPHA * x + h, ln1_g[i], ln1_b[i])
            x = layer_norm(DEEPNORM_ALPHA * x + sq_relu_mlp(x, mlp_w1[i], mlp_w2[i]), ln2_g[i], ln2_b[i])
        return x, jnp.stack(new_gla), jnp.stack(new_v)

    zero_state = jnp.zeros((N_GLA, x_prompt.shape[0], GLA_HEADS, GLA_HEAD_K, GLA_HEAD_V), state_gla.dtype)
    y_prompt, new_state_gla_prompt, _ = run(x_prompt, zero_state)
    y_sample, new_state_gla_sample, new_sg_v_sample = run(x_sample, state_gla)
    return (y_prompt, y_sample, new_state_gla_prompt, new_state_gla_sample, new_sg_v_sample)
```

```cpp
#include <hip/hip_runtime.h>
#include <hip/hip_cooperative_groups.h>
#include <cstdio>
#include <cstdint>
namespace cg = cooperative_groups;

#ifndef PROBE_MASK
#define PROBE_MASK 0
#endif
#ifndef MK_N_LAUNCHES
#define MK_N_LAUNCHES 1
#endif

namespace pg8 {
#define PG8_LAS __attribute__((address_space(3)))
typedef unsigned short bf16_t;
typedef short bf16x8 __attribute__((ext_vector_type(8)));
typedef float f32x4 __attribute__((ext_vector_type(4)));
typedef float f32x2 __attribute__((ext_vector_type(2)));
typedef unsigned u32x4 __attribute__((ext_vector_type(4)));
constexpr int BM = 256, BK = 64, HALF = 128, HTB = HALF * BK * 2, STAGE_BYTES = 8 * HTB, NXCD = 8, WGM = 8;

__host__ __device__ __forceinline__ int lds_byte(int r, int c) { const int st = (r >> 4) * 2 + (c >> 5), rr = r & 15, cc = c & 31, ob = rr * 64 + cc * 2; return st * 1024 + (ob ^ (((ob >> 9) & 1) << 5)); }
__host__ __device__ __forceinline__ void stage_rc(int b, int& R, int& C) { const int st = b / 1024, sb = b % 1024, swz = sb ^ (((sb >> 9) & 1) << 5); R = (st >> 1) * 16 + swz / 64; C = (st & 1) * 32 + (swz % 64) / 2; }
__host__ __device__ __forceinline__ int perm32(int rho) { const int n = rho >> 4, i = rho & 15; return 8 * (i >> 2) + 4 * n + (i & 3); }

struct Unit { int pm, pn; };
struct Gemm { const bf16_t* A; const bf16_t* Bt; int M, N, K; };

struct StaticOrder {
    int nM, nN, nwg, G, c;
    __host__ __device__ void init(int M, int N, int G_, int c_) { nM = M / BM; nN = N / BM; nwg = nM * nN; G = G_; c = c_; }
    __host__ __device__ bool next(int i, Unit& u) const {
        const long L = (long)i * G + c; if (L >= nwg) return false;
        int wgid = (int)L; { const int q = nwg / NXCD, r = nwg % NXCD, xcd = wgid % NXCD, off = wgid / NXCD; wgid = (xcd < r ? xcd * (q + 1) : r * (q + 1) + (xcd - r) * q) + off; }
        const int nig = WGM * nN, gid = wgid / nig, fm = gid * WGM, gsz = (nM - fm) < WGM ? (nM - fm) : WGM;
        u.pm = fm + ((wgid % nig) % gsz); u.pn = (wgid % nig) / gsz; return true;
    }
    __device__ __forceinline__ void a_ready(const Unit&) const {}
    __device__ __forceinline__ void done(const Unit&) const {}
};

__device__ __forceinline__ unsigned cvt_pk_bf16(float lo, float hi) { unsigned r; asm volatile("v_cvt_pk_bf16_f32 %0, %1, %2" : "=v"(r) : "v"(lo), "v"(hi)); return r; }
__device__ __forceinline__ f32x2 gelu_pk(f32x2 v) {
    const f32x2 av = __builtin_elementwise_abs(v), d = av * 0.2316418882f + 1.0f;
    f32x2 t; t.x = __builtin_amdgcn_rcpf(d.x); t.y = __builtin_amdgcn_rcpf(d.y);
    f32x2 q = t * 0.5307027145f + (-0.7265760135f); q = q * t + 0.7107068705f; q = q * t + (-0.142248368f); q = q * t + 0.127414796f; q = q * t;
    const f32x2 s = (v * v) * (-0.72134752044f);
    f32x2 e; e.x = __builtin_amdgcn_exp2f(s.x); e.y = __builtin_amdgcn_exp2f(s.y);
    const f32x2 m = v * (q * e), r = v - m;
    f32x2 o; o.x = v.x < 0.f ? m.x : r.x; o.y = v.y < 0.f ? m.y : r.y; return o;
}

template <int ACT  > struct EpiBf16 {
    static constexpr bool PERM = true, AFTER_DRAIN = false;
    bf16_t* O; int ldc; const float* bias;
    __device__ __forceinline__ void operator()(const f32x4 (&acc)[2][2][4][2], const Unit& u, int wr, int wc, int fr, int fq) const {
        const int row0 = u.pm * BM + wr * 64 + fr; const int col0 = u.pn * BM + wc * 32 + 8 * fq;
        f32x4 bv[2][2];
#pragma unroll
        for (int bj = 0; bj < 2; ++bj)
#pragma unroll
            for (int n = 0; n < 2; ++n) bv[bj][n] = (ACT == 1) ? *(const f32x4*)(bias + col0 + bj * HALF + 4 * n) : (f32x4){0.f, 0.f, 0.f, 0.f};
#pragma unroll
        for (int ai = 0; ai < 2; ++ai)
#pragma unroll
            for (int m = 0; m < 4; ++m) { bf16_t* rowp = O + (size_t)(row0 + ai * HALF + m * 16) * ldc + col0;
#pragma unroll
                for (int bj = 0; bj < 2; ++bj) { f32x4 v0 = acc[ai][bj][m][0] + bv[bj][0], v1 = acc[ai][bj][m][1] + bv[bj][1];
                    if (ACT == 1) { f32x2 a = gelu_pk((f32x2){v0[0], v0[1]}), b = gelu_pk((f32x2){v0[2], v0[3]}), c = gelu_pk((f32x2){v1[0], v1[1]}), d = gelu_pk((f32x2){v1[2], v1[3]});
                        v0 = (f32x4){a.x, a.y, b.x, b.y}; v1 = (f32x4){c.x, c.y, d.x, d.y}; }
                    if (ACT == 2) {
#pragma unroll
                        for (int j = 0; j < 4; ++j) { const float p = fmaxf(v0[j], 0.f), q = fmaxf(v1[j], 0.f); v0[j] = p * p; v1[j] = q * q; } }
                    u32x4 w; w.x = cvt_pk_bf16(v0[0], v0[1]); w.y = cvt_pk_bf16(v0[2], v0[3]); w.z = cvt_pk_bf16(v1[0], v1[1]); w.w = cvt_pk_bf16(v1[2], v1[3]);
                    *(u32x4*)(rowp + bj * HALF) = w; } }
    }
};
struct EpiRes {
    static constexpr bool PERM = false, AFTER_DRAIN = false;
    float* out; int ldc; const float* resA; const float* resB; int split; float alpha;
    __device__ __forceinline__ void operator()(const f32x4 (&acc)[2][2][4][2], const Unit& u, int wr, int wc, int fr, int fq) const {
        const int row0 = u.pm * BM + wr * 64 + fr, col0 = u.pn * BM + wc * 32 + 4 * fq;
#pragma unroll
        for (int ai = 0; ai < 2; ++ai)
#pragma unroll
            for (int m = 0; m < 4; ++m) { const int row = row0 + ai * HALF + m * 16;
                const float* rp = (row < split ? resA + (size_t)row * ldc : resB + (size_t)(row - split) * ldc) + col0; float* op = out + (size_t)row * ldc + col0;
#pragma unroll
                for (int bj = 0; bj < 2; ++bj)
#pragma unroll
                    for (int n = 0; n < 2; ++n) { const f32x4 rv = *(const f32x4*)(rp + bj * HALF + n * 16); *(f32x4*)(op + bj * HALF + n * 16) = acc[ai][bj][m][n] + rv * alpha; } }
    }
};

template <class Epi, class Sched, bool ALIGN_EPI = false, bool SP2 = false>
__device__ __forceinline__ void gemm_phase(PG8_LAS unsigned char* lds, const Gemm g, const Sched& S, const Epi& E) {
    const int tid = threadIdx.x, wid = __builtin_amdgcn_readfirstlane(tid >> 6), lane = tid & 63, wr = wid >> 2, wc = wid & 3, fr = lane & 15, fq = lane >> 4;
    const int K = g.K, nt = K / BK;
    unsigned voffA[2], voffB[2];
#pragma unroll
    for (int i = 0; i < 2; ++i) { int R, C; stage_rc(tid * 16 + i * 8192, R, C); const int Rb = Epi::PERM ? ((R & ~31) + perm32(R & 31)) : R;
        voffA[i] = (unsigned)(R * K + C) * 2u; voffB[i] = (unsigned)(Rb * K + C) * 2u; }
    const size_t kstep = (size_t)(BK * 2);
    const size_t hstep = (size_t)HALF * K * 2;
    const size_t tstep = 2 * hstep;
    const unsigned ldsw = (unsigned)wid * 1024u;
    const int aoff = lds_byte(wr * 64 + fr, fq * 8), boff = lds_byte(wc * 32 + fr, fq * 8);
#define PG8_SA(b, h) (((b) * 2 + (h)) * HTB)
#define PG8_SB(b, h) ((4 + (b) * 2 + (h)) * HTB)
#define PG8_STAGE(bufoff, gbase, voff) do { _Pragma("unroll") for (int _i = 0; _i < 2; ++_i) \
        __builtin_amdgcn_global_load_lds((const unsigned*)((const char*)(gbase) + (voff)[_i]), (PG8_LAS unsigned*)(lds + (bufoff) + ldsw + _i * 8192), 16, 0, 0); } while (0)
#define PG8_LDA(dst, b, h) do { _Pragma("unroll") for (int m = 0; m < 4; ++m) _Pragma("unroll") for (int k = 0; k < 2; ++k) dst[m][k] = *(const PG8_LAS bf16x8*)(lds + PG8_SA(b, h) + aoff + m * 2048 + k * 1024); } while (0)
#define PG8_LDB(dst, b, h) do { _Pragma("unroll") for (int n = 0; n < 2; ++n) _Pragma("unroll") for (int k = 0; k < 2; ++k) dst[n][k] = *(const PG8_LAS bf16x8*)(lds + PG8_SB(b, h) + boff + n * 2048 + k * 1024); } while (0)
#define PG8_MMA(ai, bj, At, Bt) do { __builtin_amdgcn_s_setprio(1); _Pragma("unroll") for (int m = 0; m < 4; ++m) _Pragma("unroll") for (int n = 0; n < 2; ++n) _Pragma("unroll") for (int k = 0; k < 2; ++k) \
        acc[ai][bj][m][n] = __builtin_amdgcn_mfma_f32_16x16x32_bf16(Bt[n][k], At[m][k], acc[ai][bj][m][n], 0, 0, 0); __builtin_amdgcn_s_setprio(0); } while (0)
#define PG8_WAIT_V(n) asm volatile("s_waitcnt vmcnt(" #n ")" ::: "memory")
#define PG8_WAIT_L(n) asm volatile("s_waitcnt lgkmcnt(" #n ")" ::: "memory")
#define PG8_BAR __builtin_amdgcn_s_barrier()
#define PG8_SCHED __builtin_amdgcn_sched_barrier(0)
    Unit cur, nxt; int ui = 0;
    if (!S.next(0, cur)) return;
    f32x4 acc[2][2][4][2];
#pragma unroll
    for (int a = 0; a < 2; ++a)
#pragma unroll
        for (int b = 0; b < 2; ++b)
#pragma unroll
            for (int m = 0; m < 4; ++m)
#pragma unroll
                for (int n = 0; n < 2; ++n) acc[a][b][m][n] = (f32x4){0.f, 0.f, 0.f, 0.f};
    bf16x8 At[4][2], B0[2][2], B1[2][2];
    const char* cA = (const char*)g.A + (size_t)cur.pm * tstep; const char* cB = (const char*)g.Bt + (size_t)cur.pn * tstep;
    S.a_ready(cur);
    if constexpr (SP2) {
        PG8_STAGE(PG8_SB(0, 0), cB, voffB); PG8_STAGE(PG8_SB(0, 1), cB + hstep, voffB); PG8_STAGE(PG8_SA(0, 0), cA, voffA); PG8_STAGE(PG8_SA(0, 1), cA + hstep, voffA);
        if (wr == 1) PG8_BAR;
        PG8_WAIT_V(2); PG8_BAR;
        PG8_STAGE(PG8_SB(1, 0), cB + kstep, voffB); PG8_STAGE(PG8_SA(1, 0), cA + kstep, voffA); PG8_STAGE(PG8_SB(1, 1), cB + hstep + kstep, voffB);
        PG8_WAIT_V(6); PG8_BAR;
    } else {
        PG8_STAGE(PG8_SB(0, 0), cB, voffB); PG8_STAGE(PG8_SA(0, 0), cA, voffA); PG8_STAGE(PG8_SB(0, 1), cB + hstep, voffB); PG8_STAGE(PG8_SA(0, 1), cA + hstep, voffA);
        if (wr == 1) PG8_BAR;
        PG8_WAIT_V(4); PG8_BAR;
        PG8_STAGE(PG8_SB(1, 0), cB + kstep, voffB); PG8_STAGE(PG8_SA(1, 0), cA + kstep, voffA); PG8_STAGE(PG8_SB(1, 1), cB + hstep + kstep, voffB);
        PG8_WAIT_V(6); PG8_BAR;
    }
    for (;;) {
        const bool has_next = S.next(ui + 1, nxt);
        const char* nA = has_next ? (const char*)g.A + (size_t)nxt.pm * tstep : cA; const char* nB = has_next ? (const char*)g.Bt + (size_t)nxt.pn * tstep : cB;
        for (int t = 0; t < nt; t += 2) {
            const bool last = (t == nt - 2);
            const char* a1 = cA + (size_t)(t + 1) * kstep;
            const char* a2 = last ? nA : cA + (size_t)(t + 2) * kstep; const char* b2 = last ? nB : cB + (size_t)(t + 2) * kstep;
            const char* a3 = a2 + kstep; const char* b3 = b2 + kstep;
            if (last && has_next) S.a_ready(nxt);
            if constexpr (SP2) {
            PG8_LDB(B0, 0, 0); PG8_LDB(B1, 0, 1); PG8_SCHED; PG8_LDA(At, 0, 0); PG8_STAGE(PG8_SA(1, 1), a1 + hstep, voffA);
            PG8_WAIT_V(8); PG8_WAIT_L(0); PG8_BAR; PG8_MMA(0, 0, At, B0); PG8_MMA(0, 1, At, B1); PG8_BAR; PG8_SCHED;
            PG8_LDA(At, 0, 1); PG8_STAGE(PG8_SB(0, 0), b2, voffB); PG8_STAGE(PG8_SB(0, 1), b2 + hstep, voffB); PG8_STAGE(PG8_SA(0, 0), a2, voffA);
            PG8_WAIT_V(8); PG8_WAIT_L(0); PG8_BAR; PG8_MMA(1, 0, At, B0); PG8_MMA(1, 1, At, B1); PG8_BAR; PG8_SCHED;
            PG8_LDB(B0, 1, 0); PG8_LDB(B1, 1, 1); PG8_SCHED; PG8_LDA(At, 1, 0); PG8_STAGE(PG8_SA(0, 1), a2 + hstep, voffA);
            PG8_WAIT_V(8); PG8_WAIT_L(0); PG8_BAR; PG8_MMA(0, 0, At, B0); PG8_MMA(0, 1, At, B1); PG8_BAR; PG8_SCHED;
            PG8_LDA(At, 1, 1); PG8_STAGE(PG8_SB(1, 0), b3, voffB); PG8_STAGE(PG8_SB(1, 1), b3 + hstep, voffB); PG8_STAGE(PG8_SA(1, 0), a3, voffA);
            PG8_WAIT_V(8); PG8_WAIT_L(0); PG8_BAR; PG8_MMA(1, 0, At, B0); PG8_MMA(1, 1, At, B1); PG8_BAR; PG8_SCHED;
            } else {
            PG8_LDB(B0, 0, 0); PG8_SCHED; PG8_LDA(At, 0, 0); PG8_STAGE(PG8_SA(1, 1), a1 + hstep, voffA);
            PG8_WAIT_L(8); PG8_BAR; PG8_WAIT_L(0); PG8_MMA(0, 0, At, B0); PG8_BAR; PG8_SCHED;
            PG8_LDB(B1, 0, 1); PG8_STAGE(PG8_SB(0, 0), b2, voffB);
            PG8_BAR; PG8_WAIT_L(0); PG8_MMA(0, 1, At, B1); PG8_BAR;
            PG8_LDA(At, 0, 1); PG8_STAGE(PG8_SA(0, 0), a2, voffA);
            PG8_BAR; PG8_WAIT_L(0); PG8_MMA(1, 0, At, B0); PG8_BAR; PG8_SCHED;
            PG8_STAGE(PG8_SB(0, 1), b2 + hstep, voffB);
            PG8_WAIT_V(6); PG8_BAR; PG8_MMA(1, 1, At, B1); PG8_BAR;
            PG8_LDB(B0, 1, 0); PG8_SCHED; PG8_LDA(At, 1, 0); PG8_STAGE(PG8_SA(0, 1), a2 + hstep, voffA);
            PG8_WAIT_L(8); PG8_BAR; PG8_WAIT_L(0); PG8_MMA(0, 0, At, B0); PG8_BAR; PG8_SCHED;
            PG8_LDB(B1, 1, 1); PG8_STAGE(PG8_SB(1, 0), b3, voffB);
            PG8_BAR; PG8_WAIT_L(0); PG8_MMA(0, 1, At, B1); PG8_BAR;
            PG8_LDA(At, 1, 1); PG8_STAGE(PG8_SA(1, 0), a3, voffA);
            PG8_BAR; PG8_WAIT_L(0); PG8_MMA(1, 0, At, B0); PG8_BAR; PG8_SCHED;
            PG8_STAGE(PG8_SB(1, 1), b3 + hstep, voffB);
            PG8_WAIT_V(6); PG8_BAR; PG8_MMA(1, 1, At, B1); PG8_BAR;
            }
        }
        if constexpr (ALIGN_EPI) { if (wr == 0) PG8_BAR; }
        E(acc, cur, wr, wc, fr, fq); S.done(cur);
        if (!has_next) break;
#pragma unroll
        for (int a = 0; a < 2; ++a)
#pragma unroll
            for (int b = 0; b < 2; ++b)
#pragma unroll
                for (int m = 0; m < 4; ++m)
#pragma unroll
                    for (int n = 0; n < 2; ++n) acc[a][b][m][n] = (f32x4){0.f, 0.f, 0.f, 0.f};
        cur = nxt; cA = nA; cB = nB; ++ui;
        if constexpr (ALIGN_EPI) { if (wr == 1) PG8_BAR; }
    }
    PG8_WAIT_V(0);
    if constexpr (!ALIGN_EPI) { if (wr == 0) PG8_BAR; }
    PG8_BAR;
#undef PG8_SA
#undef PG8_SB
#undef PG8_STAGE
#undef PG8_LDA
#undef PG8_LDB
#undef PG8_MMA
#undef PG8_WAIT_V
#undef PG8_WAIT_L
#undef PG8_BAR
#undef PG8_SCHED
}
}

namespace pg9 {
using pg8::bf16_t; using pg8::bf16x8; using pg8::f32x4; using pg8::f32x2; using pg8::u32x4; using pg8::stage_rc; using pg8::lds_byte; using pg8::perm32; using pg8::cvt_pk_bf16; using pg8::gelu_pk;
constexpr int BMR = 288, BNC = 256, BK = 64, THIRD = 96, HALF = 128, ATB = THIRD * BK * 2, BHB = HALF * BK * 2, NXCD = 8, WGM = 8;
constexpr int STAGE_BYTES = 6 * ATB + 4 * BHB;
struct Unit { int pm, pn; };
struct Gemm { const bf16_t* A; const bf16_t* Bt; int M, N, K, lda, ldb; };
struct Order {
    int nM, nN, nwg, G, c;
    __host__ __device__ void init(int M, int N, int G_, int c_) { nM = M / BMR; nN = N / BNC; nwg = nM * nN; G = G_; c = c_; }
    __host__ __device__ bool next(int i, Unit& u) const {
        const long L = (long)i * G + c; if (L >= nwg) return false;
        int wgid = (int)L; { const int q = nwg / NXCD, r = nwg % NXCD, xcd = wgid % NXCD, off = wgid / NXCD; wgid = (xcd < r ? xcd * (q + 1) : r * (q + 1) + (xcd - r) * q) + off; }
        const int nig = WGM * nN, gid = wgid / nig, fm = gid * WGM, gsz = (nM - fm) < WGM ? (nM - fm) : WGM;
        u.pm = fm + ((wgid % nig) % gsz); u.pn = (wgid % nig) / gsz; return true;
    }
};
template <int ACT  > struct EpiBf16 {
    static constexpr bool PERM = true, AFTER_DRAIN = false, INIT_ACC = false;
    bf16_t* O; int ldc; const float* bias;
    __device__ __forceinline__ void operator()(const f32x4 (&acc)[3][2][3][2], const Unit& u, int wr, int wc, int fr, int fq) const {
        const int row0 = u.pm * BMR + wr * 48 + fr; const int col0 = u.pn * BNC + wc * 32 + 8 * fq;
        f32x4 bv[2][2];
#pragma unroll
        for (int bj = 0; bj < 2; ++bj)
#pragma unroll
            for (int n = 0; n < 2; ++n) bv[bj][n] = (ACT == 1) ? *(const f32x4*)(bias + col0 + bj * HALF + 4 * n) : (f32x4){0.f, 0.f, 0.f, 0.f};
#pragma unroll
        for (int ai = 0; ai < 3; ++ai)
#pragma unroll
            for (int m = 0; m < 3; ++m) { bf16_t* rowp = O + (size_t)(row0 + ai * THIRD + m * 16) * ldc + col0;
#pragma unroll
                for (int bj = 0; bj < 2; ++bj) { f32x4 v0 = acc[ai][bj][m][0] + bv[bj][0], v1 = acc[ai][bj][m][1] + bv[bj][1];
                    if (ACT == 1) { f32x2 a = gelu_pk((f32x2){v0[0], v0[1]}), b = gelu_pk((f32x2){v0[2], v0[3]}), c = gelu_pk((f32x2){v1[0], v1[1]}), d = gelu_pk((f32x2){v1[2], v1[3]});
                        v0 = (f32x4){a.x, a.y, b.x, b.y}; v1 = (f32x4){c.x, c.y, d.x, d.y}; }
                    if (ACT == 2) {
#pragma unroll
                        for (int j = 0; j < 4; ++j) { const float p = fmaxf(v0[j], 0.f), q = fmaxf(v1[j], 0.f); v0[j] = p * p; v1[j] = q * q; } }
                    u32x4 w; w.x = cvt_pk_bf16(v0[0], v0[1]); w.y = cvt_pk_bf16(v0[2], v0[3]); w.z = cvt_pk_bf16(v1[0], v1[1]); w.w = cvt_pk_bf16(v1[2], v1[3]);
                    *(u32x4*)(rowp + bj * HALF) = w; } }
    }
};
struct EpiRes {
    static constexpr bool PERM = false, AFTER_DRAIN = false, INIT_ACC = false;
    float* out; int ldc; const float* resA; const float* resB; int split; float alpha;
    __device__ __forceinline__ void operator()(const f32x4 (&acc)[3][2][3][2], const Unit& u, int wr, int wc, int fr, int fq) const {
        const int row0 = u.pm * BMR + wr * 48 + fr, col0 = u.pn * BNC + wc * 32 + 4 * fq;
#pragma unroll
        for (int ai = 0; ai < 3; ++ai)
#pragma unroll
            for (int m = 0; m < 3; ++m) { const int row = row0 + ai * THIRD + m * 16;
                const float* rp = (row < split ? resA + (size_t)row * ldc : resB + (size_t)(row - split) * ldc) + col0; float* op = out + (size_t)row * ldc + col0;
#pragma unroll
                for (int bj = 0; bj < 2; ++bj)
#pragma unroll
                    for (int n = 0; n < 2; ++n) { const f32x4 rv = *(const f32x4*)(rp + bj * HALF + n * 16); *(f32x4*)(op + bj * HALF + n * 16) = acc[ai][bj][m][n] + rv * alpha; } }
    }
};

struct EpiSg {
    static constexpr bool PERM = true, AFTER_DRAIN = false, INIT_ACC = false;
    bf16_t* O; int ldc; const float* bias; float* stat;
    __device__ __forceinline__ void operator()(const f32x4 (&acc)[3][2][3][2], const Unit& u, int wr, int wc, int fr, int fq) const {
        const int row0 = u.pm * BMR + wr * 48 + fr; const int col0 = u.pn * BNC + wc * 32 + 8 * fq;
        f32x4 bv[2][2];
#pragma unroll
        for (int bj = 0; bj < 2; ++bj)
#pragma unroll
            for (int n = 0; n < 2; ++n) bv[bj][n] = *(const f32x4*)(bias + col0 + bj * HALF + 4 * n);
        const bool vhalf = u.pn >= 8;
#pragma unroll
        for (int ai = 0; ai < 3; ++ai)
#pragma unroll
            for (int m = 0; m < 3; ++m) { const int row = row0 + ai * THIRD + m * 16; bf16_t* rowp = O + (size_t)row * ldc + col0; float s = 0.f, q = 0.f;
#pragma unroll
                for (int bj = 0; bj < 2; ++bj) { f32x4 v0 = acc[ai][bj][m][0] + bv[bj][0], v1 = acc[ai][bj][m][1] + bv[bj][1];
                    { f32x2 a = gelu_pk((f32x2){v0[0], v0[1]}), b = gelu_pk((f32x2){v0[2], v0[3]}), c = gelu_pk((f32x2){v1[0], v1[1]}), d = gelu_pk((f32x2){v1[2], v1[3]});
                        v0 = (f32x4){a.x, a.y, b.x, b.y}; v1 = (f32x4){c.x, c.y, d.x, d.y}; }
                    s += ((v0[0] + v0[1]) + (v0[2] + v0[3])) + ((v1[0] + v1[1]) + (v1[2] + v1[3]));
                    q += ((v0[0] * v0[0] + v0[1] * v0[1]) + (v0[2] * v0[2] + v0[3] * v0[3])) + ((v1[0] * v1[0] + v1[1] * v1[1]) + (v1[2] * v1[2] + v1[3] * v1[3]));
                    u32x4 w; w.x = cvt_pk_bf16(v0[0], v0[1]); w.y = cvt_pk_bf16(v0[2], v0[3]); w.z = cvt_pk_bf16(v1[0], v1[1]); w.w = cvt_pk_bf16(v1[2], v1[3]);
                    *(u32x4*)(rowp + bj * HALF) = w; }
                if (vhalf) { s += __shfl_xor(s, 16); s += __shfl_xor(s, 32); q += __shfl_xor(q, 16); q += __shfl_xor(q, 32);
                    if (fq == 0) { (void)__hip_atomic_fetch_add(stat + 2 * (size_t)row, s, __ATOMIC_RELAXED, __HIP_MEMORY_SCOPE_AGENT); (void)__hip_atomic_fetch_add(stat + 2 * (size_t)row + 1, q, __ATOMIC_RELAXED, __HIP_MEMORY_SCOPE_AGENT); } } }
    }
};

struct PanelStats {
    unsigned* xbuf; unsigned* cnt; unsigned* tmo; float eps;
    __device__ __forceinline__ void run(const f32x4 (&v)[3][2][3][2], const Unit& u, int wr, int wc, int fr, int fq, PG8_LAS unsigned char* lds, int wid, int lane) const {
        PG8_LAS f32x2* P = (PG8_LAS f32x2*)lds;
        PG8_LAS f32x2* St = (PG8_LAS f32x2*)(lds + 9216);
#pragma unroll
        for (int ai = 0; ai < 3; ++ai)
#pragma unroll
            for (int m = 0; m < 3; ++m) {
                float s = 0.f;
#pragma unroll
                for (int bj = 0; bj < 2; ++bj)
#pragma unroll
                    for (int n = 0; n < 2; ++n) { const f32x4 x = v[ai][bj][m][n]; s += (x[0] + x[1]) + (x[2] + x[3]); }
                s += __shfl_xor(s, 16); s += __shfl_xor(s, 32);
                const float mw = s * (1.0f / 64.0f); float q = 0.f;
#pragma unroll
                for (int bj = 0; bj < 2; ++bj)
#pragma unroll
                    for (int n = 0; n < 2; ++n) { const f32x4 d = v[ai][bj][m][n] - mw; q += (d[0] * d[0] + d[1] * d[1]) + (d[2] * d[2] + d[3] * d[3]); }
                q += __shfl_xor(q, 16); q += __shfl_xor(q, 32);
                if (fq == 0) P[(ai * THIRD + wr * 48 + m * 16 + fr) * 4 + wc] = (f32x2){mw, q};
            }
        asm volatile("s_waitcnt lgkmcnt(0)" ::: "memory"); __builtin_amdgcn_s_barrier(); asm volatile("" ::: "memory");
        const int row = wid * 64 + lane;
        if (row < BMR) {
            const f32x2 a = P[row * 4 + 0], b = P[row * 4 + 1], c = P[row * 4 + 2], d = P[row * 4 + 3];
            const float mt = (a.x + b.x + c.x + d.x) * 0.25f;
            const float da = a.x - mt, db = b.x - mt, dc = c.x - mt, dd = d.x - mt;
            const float m2 = (a.y + b.y) + (c.y + d.y) + 64.0f * ((da * da + db * db) + (dc * dc + dd * dd));
            unsigned long long* slot = (unsigned long long*)xbuf + ((size_t)(u.pm * BMR + row) * 8 + u.pn);
            __hip_atomic_store(slot, ((unsigned long long)__float_as_uint(m2) << 32) | __float_as_uint(mt), __ATOMIC_RELAXED, __HIP_MEMORY_SCOPE_AGENT);
        }
        asm volatile("s_waitcnt vmcnt(0)" ::: "memory");
        if (lane == 0) __hip_atomic_fetch_add(cnt + 64 * u.pm, 1u, __ATOMIC_RELAXED, __HIP_MEMORY_SCOPE_AGENT);
        if (wid == 0) {
            unsigned sp = 0u;
            for (;;) {
                if ((unsigned)__builtin_amdgcn_readfirstlane(__hip_atomic_load(cnt + 64 * u.pm, __ATOMIC_RELAXED, __HIP_MEMORY_SCOPE_AGENT)) >= 64u) break;
                __builtin_amdgcn_s_sleep(2);
                if (++sp > (1u << 22)) { if (lane == 0) __hip_atomic_store(tmo, 1u, __ATOMIC_RELAXED, __HIP_MEMORY_SCOPE_AGENT); break; }
            }
            __builtin_amdgcn_fence(__ATOMIC_ACQUIRE, "agent");
        }
        asm volatile("s_waitcnt vmcnt(0) lgkmcnt(0)" ::: "memory"); __builtin_amdgcn_s_barrier(); asm volatile("" ::: "memory");
        if (row < BMR) {
            const unsigned long long* slot = (const unsigned long long*)xbuf + (size_t)(u.pm * BMR + row) * 8; float mt[8], m2[8]; float ms = 0.f;
#pragma unroll
            for (int t = 0; t < 8; ++t) { const unsigned long long w = __hip_atomic_load(slot + t, __ATOMIC_RELAXED, __HIP_MEMORY_SCOPE_AGENT); mt[t] = __uint_as_float((unsigned)w); m2[t] = __uint_as_float((unsigned)(w >> 32)); ms += mt[t]; }
            const float mean = ms * 0.125f; float q = 0.f;
#pragma unroll
            for (int t = 0; t < 8; ++t) { const float dm = mt[t] - mean; q += m2[t] + 256.0f * dm * dm; }
            St[row] = (f32x2){mean, 1.0f / sqrtf(q * (1.0f / 2048.0f) + eps)};
        }
        asm volatile("s_waitcnt lgkmcnt(0)" ::: "memory"); __builtin_amdgcn_s_barrier(); asm volatile("" ::: "memory");
    }
};
struct EpiLn {
    static constexpr bool PERM = true, AFTER_DRAIN = true, INIT_ACC = true;
    const bf16_t* res; int ldr; float alpha;
    const float* gam; const float* bet; float* outf; bf16_t* outb; int ldb16;
    PanelStats st;
    __device__ __forceinline__ void init_load(u32x4 (&rw)[3][3][2], const Unit& u, int wr, int wc, int fr, int fq) const {
        const int row0 = u.pm * BMR + wr * 48 + fr, col0 = u.pn * BNC + wc * 32 + 8 * fq;
#pragma unroll
        for (int ai = 0; ai < 3; ++ai)
#pragma unroll
            for (int m = 0; m < 3; ++m)
#pragma unroll
                for (int bj = 0; bj < 2; ++bj) rw[ai][m][bj] = *(const u32x4*)(res + (size_t)(row0 + ai * THIRD + m * 16) * ldr + col0 + bj * HALF);
    }
    __device__ __forceinline__ void init_acc(f32x4 (&acc)[3][2][3][2], const u32x4 (&rw)[3][3][2]) const {
#pragma unroll
        for (int ai = 0; ai < 3; ++ai)
#pragma unroll
            for (int m = 0; m < 3; ++m)
#pragma unroll
                for (int bj = 0; bj < 2; ++bj) { const u32x4 w = rw[ai][m][bj];
                    acc[ai][bj][m][0] = (f32x4){__uint_as_float(w.x << 16), __uint_as_float(w.x & 0xffff0000u), __uint_as_float(w.y << 16), __uint_as_float(w.y & 0xffff0000u)} * alpha;
                    acc[ai][bj][m][1] = (f32x4){__uint_as_float(w.z << 16), __uint_as_float(w.z & 0xffff0000u), __uint_as_float(w.w << 16), __uint_as_float(w.w & 0xffff0000u)} * alpha; }
    }
    __device__ __forceinline__ void fused(f32x4 (&acc)[3][2][3][2], const Unit& u, int wr, int wc, int fr, int fq, PG8_LAS unsigned char* lds, int wid, int lane) const {
        const PG8_LAS f32x2* St = (const PG8_LAS f32x2*)(lds + 9216);
        const int row0 = u.pm * BMR + wr * 48 + fr, col0 = u.pn * BNC + wc * 32 + 8 * fq;
        f32x4 gb[2][4];
#pragma unroll
        for (int bj = 0; bj < 2; ++bj) { gb[bj][0] = *(const f32x4*)(gam + col0 + bj * HALF); gb[bj][1] = *(const f32x4*)(gam + col0 + bj * HALF + 4); gb[bj][2] = *(const f32x4*)(bet + col0 + bj * HALF); gb[bj][3] = *(const f32x4*)(bet + col0 + bj * HALF + 4); }
        st.run(acc, u, wr, wc, fr, fq, lds, wid, lane);
#pragma unroll
        for (int bj = 0; bj < 2; ++bj) {
            const f32x4 g0 = gb[bj][0], g1 = gb[bj][1], b0 = gb[bj][2], b1 = gb[bj][3];
#pragma unroll
            for (int ai = 0; ai < 3; ++ai)
#pragma unroll
                for (int m = 0; m < 3; ++m) { const int rl = ai * THIRD + wr * 48 + m * 16 + fr; const f32x2 sr = St[rl]; const size_t off = (size_t)(u.pm * BMR + rl) * 2048 + col0 + bj * HALF;
                    const f32x4 y0 = (acc[ai][bj][m][0] - sr.x) * sr.y * g0 + b0, y1 = (acc[ai][bj][m][1] - sr.x) * sr.y * g1 + b1;
                    if (outf) { *(f32x4*)(outf + off) = y0; *(f32x4*)(outf + off + 4) = y1; }
                    if (outb) { u32x4 w; w.x = cvt_pk_bf16(y0[0], y0[1]); w.y = cvt_pk_bf16(y0[2], y0[3]); w.z = cvt_pk_bf16(y1[0], y1[1]); w.w = cvt_pk_bf16(y1[2], y1[3]); *(u32x4*)(outb + (size_t)(u.pm * BMR + rl) * ldb16 + col0 + bj * HALF) = w; }
                    asm volatile("" ::: "memory"); }
        }
    }
};

struct ListOrder { int first, stride, total, nM;
    __host__ __device__ bool next(int i, Unit& u) const { const int id = first + i * stride; if (id >= total) return false; u.pm = id % nM; u.pn = id / nM; return true; } };

template <class Epi, bool ALIGN_EPI = true, class Sched = Order>
__device__ __forceinline__ void gemm_phase(PG8_LAS unsigned char* lds, const Gemm g, const Sched& S, const Epi& E) {
    const int tid = threadIdx.x, wid = __builtin_amdgcn_readfirstlane(tid >> 6), lane = tid & 63, wr = wid >> 2, wc = wid & 3, fr = lane & 15, fq = lane >> 4;
    const int K = g.K, nt = K / BK;
    const int lda = g.lda, ldb = g.ldb;
    unsigned voffA0, voffA1, voffB[2];
    { int R, C; stage_rc((wid & 3) * 1024 + lane * 16, R, C); voffA0 = (unsigned)(R * lda + C) * 2u; stage_rc((wid + 4) * 1024 + lane * 16, R, C); voffA1 = (unsigned)(R * lda + C) * 2u; }
#pragma unroll
    for (int i = 0; i < 2; ++i) { int R, C; stage_rc(tid * 16 + i * 8192, R, C); const int Rb = Epi::PERM ? ((R & ~31) + perm32(R & 31)) : R; voffB[i] = (unsigned)(Rb * ldb + C) * 2u; }
    const size_t kstep = (size_t)(BK * 2);
    const size_t thstep = (size_t)THIRD * lda * 2, hstep = (size_t)HALF * ldb * 2;
    const size_t tstepA = 3 * thstep, tstepB = 2 * hstep;
    const unsigned ldsw = (unsigned)wid * 1024u;
    const int aoff = lds_byte(wr * 48 + fr, fq * 8), boff = lds_byte(wc * 32 + fr, fq * 8);
#define PG9_SA(b, a) (((b) * 3 + (a)) * ATB)
#define PG9_SB(b, h) (6 * ATB + ((b) * 2 + (h)) * BHB)
#define PG9_GLDS(gp, lp) __builtin_amdgcn_global_load_lds((const unsigned*)(gp), (PG8_LAS unsigned*)(lp), 16, 0, 0)
#define PG9_STAGE_A(slot, gbase) do { if (wr == 0) PG9_GLDS((const char*)(gbase) + voffA0, lds + (slot) + ldsw); PG9_GLDS((const char*)(gbase) + voffA1, lds + (slot) + ldsw + 4096); } while (0)
#define PG9_STAGE_B(slot, gbase) do { PG9_GLDS((const char*)(gbase) + voffB[0], lds + (slot) + ldsw); PG9_GLDS((const char*)(gbase) + voffB[1], lds + (slot) + ldsw + 8192); } while (0)
#define PG9_LDA(dst, b, a) do { _Pragma("unroll") for (int m = 0; m < 3; ++m) _Pragma("unroll") for (int k = 0; k < 2; ++k) dst[m][k] = *(const PG8_LAS bf16x8*)(lds + PG9_SA(b, a) + aoff + m * 2048 + k * 1024); } while (0)
#define PG9_LDB(dst, b, h) do { _Pragma("unroll") for (int n = 0; n < 2; ++n) _Pragma("unroll") for (int k = 0; k < 2; ++k) dst[n][k] = *(const PG8_LAS bf16x8*)(lds + PG9_SB(b, h) + boff + n * 2048 + k * 1024); } while (0)
#define PG9_MMA(ai, bj, At, Bt) do { _Pragma("unroll") for (int m = 0; m < 3; ++m) _Pragma("unroll") for (int n = 0; n < 2; ++n) _Pragma("unroll") for (int k = 0; k < 2; ++k) \
        acc[ai][bj][m][n] = __builtin_amdgcn_mfma_f32_16x16x32_bf16(Bt[n][k], At[m][k], acc[ai][bj][m][n], 0, 0, 0); } while (0)
#define PG9_MMA2(ai) do { __builtin_amdgcn_s_setprio(1); PG9_MMA(ai, 0, At, B0); PG9_MMA(ai, 1, At, B1); __builtin_amdgcn_s_setprio(0); } while (0)
#define PG9_WAIT_V2(a, b) do { if (wr == 0) asm volatile("s_waitcnt vmcnt(" #a ")" ::: "memory"); else asm volatile("s_waitcnt vmcnt(" #b ")" ::: "memory"); } while (0)
#define PG9_WAIT_L0 asm volatile("s_waitcnt lgkmcnt(0)" ::: "memory")
#define PG9_BAR __builtin_amdgcn_s_barrier()
#define PG9_SCHED __builtin_amdgcn_sched_barrier(0)
    Unit cur, nxt; int ui = 0;
    if (!S.next(0, cur)) return;
    f32x4 acc[3][2][3][2];
    u32x4 rinit[3][3][2];
    if constexpr (Epi::INIT_ACC) E.init_load(rinit, cur, wr, wc, fr, fq);
    else {
#pragma unroll
    for (int a = 0; a < 3; ++a)
#pragma unroll
        for (int b = 0; b < 2; ++b)
#pragma unroll
            for (int m = 0; m < 3; ++m)
#pragma unroll
                for (int n = 0; n < 2; ++n) acc[a][b][m][n] = (f32x4){0.f, 0.f, 0.f, 0.f};
    }
    bf16x8 At[3][2], B0[2][2], B1[2][2];
    const char* cA = (const char*)g.A + (size_t)cur.pm * tstepA; const char* cB = (const char*)g.Bt + (size_t)cur.pn * tstepB;
    PG9_STAGE_B(PG9_SB(0, 0), cB); PG9_STAGE_B(PG9_SB(0, 1), cB + hstep); PG9_STAGE_A(PG9_SA(0, 0), cA); PG9_STAGE_A(PG9_SA(0, 1), cA + thstep); PG9_STAGE_A(PG9_SA(0, 2), cA + 2 * thstep);
    if constexpr (Epi::INIT_ACC) { PG9_SCHED; E.init_acc(acc, rinit); PG9_SCHED; }
    if (wr == 1) PG9_BAR;
    PG9_WAIT_V2(4, 2); PG9_BAR;
    PG9_STAGE_B(PG9_SB(1, 0), cB + kstep); PG9_STAGE_B(PG9_SB(1, 1), cB + hstep + kstep); PG9_STAGE_A(PG9_SA(1, 0), cA + kstep); PG9_STAGE_A(PG9_SA(1, 1), cA + thstep + kstep);
    PG9_WAIT_V2(8, 6); PG9_BAR;
    for (;;) {
        const bool has_next = S.next(ui + 1, nxt);
        const char* nA = has_next ? (const char*)g.A + (size_t)nxt.pm * tstepA : cA; const char* nB = has_next ? (const char*)g.Bt + (size_t)nxt.pn * tstepB : cB;
        for (int t = 0; t < nt; t += 2) {
            const bool last = (t == nt - 2);
            const char* a1 = cA + (size_t)(t + 1) * kstep;
            const char* a2 = last ? nA : cA + (size_t)(t + 2) * kstep; const char* b2 = last ? nB : cB + (size_t)(t + 2) * kstep;
            const char* a3 = a2 + kstep; const char* b3 = b2 + kstep;
            PG9_LDB(B0, 0, 0); PG9_LDB(B1, 0, 1); PG9_SCHED; PG9_LDA(At, 0, 0); PG9_STAGE_A(PG9_SA(1, 2), a1 + 2 * thstep);
            PG9_WAIT_V2(12, 8); PG9_WAIT_L0; PG9_BAR; PG9_MMA2(0); PG9_BAR; PG9_SCHED;
            PG9_LDA(At, 0, 1); PG9_STAGE_B(PG9_SB(0, 0), b2); PG9_STAGE_B(PG9_SB(0, 1), b2 + hstep);
            PG9_WAIT_V2(14, 11); PG9_WAIT_L0; PG9_BAR; PG9_MMA2(1); PG9_BAR; PG9_SCHED;
            PG9_LDA(At, 0, 2); PG9_STAGE_A(PG9_SA(0, 0), a2); PG9_STAGE_A(PG9_SA(0, 1), a2 + thstep);
            PG9_WAIT_V2(12, 8); PG9_WAIT_L0; PG9_BAR; PG9_MMA2(2); PG9_BAR; PG9_SCHED;
            PG9_LDB(B0, 1, 0); PG9_LDB(B1, 1, 1); PG9_SCHED; PG9_LDA(At, 1, 0); PG9_STAGE_A(PG9_SA(0, 2), a2 + 2 * thstep);
            PG9_WAIT_V2(12, 8); PG9_WAIT_L0; PG9_BAR; PG9_MMA2(0); PG9_BAR; PG9_SCHED;
            PG9_LDA(At, 1, 1); PG9_STAGE_B(PG9_SB(1, 0), b3); PG9_STAGE_B(PG9_SB(1, 1), b3 + hstep);
            PG9_WAIT_V2(14, 11); PG9_WAIT_L0; PG9_BAR; PG9_MMA2(1); PG9_BAR; PG9_SCHED;
            PG9_LDA(At, 1, 2); PG9_STAGE_A(PG9_SA(1, 0), a3); PG9_STAGE_A(PG9_SA(1, 1), a3 + thstep);
            PG9_WAIT_V2(12, 8); PG9_WAIT_L0; PG9_BAR; PG9_MMA2(2); PG9_BAR; PG9_SCHED;
        }
        if constexpr (ALIGN_EPI) { if (wr == 0) PG9_BAR; }
        if constexpr (!Epi::AFTER_DRAIN) E(acc, cur, wr, wc, fr, fq);
        if (!has_next) break;
#pragma unroll
        for (int a = 0; a < 3; ++a)
#pragma unroll
            for (int b = 0; b < 2; ++b)
#pragma unroll
                for (int m = 0; m < 3; ++m)
#pragma unroll
                    for (int n = 0; n < 2; ++n) acc[a][b][m][n] = (f32x4){0.f, 0.f, 0.f, 0.f};
        cur = nxt; cA = nA; cB = nB; ++ui;
        if constexpr (ALIGN_EPI) { if (wr == 1) PG9_BAR; }
    }
    asm volatile("s_waitcnt vmcnt(0)" ::: "memory");
    if constexpr (!ALIGN_EPI) { if (wr == 0) PG9_BAR; }
    PG9_BAR;
    if constexpr (Epi::AFTER_DRAIN) E.fused(acc, cur, wr, wc, fr, fq, lds, wid, lane);
#undef PG9_SA
#undef PG9_SB
#undef PG9_GLDS
#undef PG9_STAGE_A
#undef PG9_STAGE_B
#undef PG9_LDA
#undef PG9_LDB
#undef PG9_MMA
#undef PG9_MMA2
#undef PG9_WAIT_V2
#undef PG9_WAIT_L0
#undef PG9_BAR
#undef PG9_SCHED
}
}

constexpr int NWAVES = 8, NTHR = NWAVES * 64;
constexpr int N_LAUNCHES = MK_N_LAUNCHES;
constexpr int NPHASE = 12;
constexpr int DM = 2048, MP = 8192, MS = 1024, M = MP + MS;
constexpr int SEQ = 2048, NB = 4, DB = 128, DT = 8;
constexpr int NH = 4, HK = 256, HV = 512, KD = 1024, RANK = 16;
constexpr int NPROJ = 6144, NQKV = 4096, RG_WGS = 86, WIN_LD = 6160, DFF = 8192, SGW = 2048, SGG = 8, SGC = 128, SGD = 256;
constexpr int PK2 = DM + 64, PK8 = DFF + 64;
constexpr float ALPHA = 1.41421356237309515f;
constexpr float LN_EPS = 1e-5f, HN_EPS = 1e-6f;
constexpr size_t OUT_Y = 0, OUT_SP = (size_t)M * DM, OUT_SS = OUT_SP + (size_t)NB * NH * HK * HV, OUT_SGV = OUT_SS + (size_t)DB * NH * HK * HV, OUT_END = OUT_SGV + (size_t)MS * SGW;

constexpr size_t MiB = 1u << 20;
constexpr size_t WS_CTL = 0, CTL_ZERO_BYTES = 1 * MiB;
constexpr size_t WS_WIN = 1 * MiB;
constexpr size_t WS_WOUT = WS_WIN + 25 * MiB;
constexpr size_t WS_W1 = WS_WOUT + 9 * MiB;
constexpr size_t WS_W2 = WS_W1 + 66 * MiB;
constexpr size_t WS_SGIN = WS_W2 + 65 * MiB;
constexpr size_t WS_SGOUT = WS_SGIN + 17 * MiB;
constexpr size_t WS_WC = WS_SGOUT + 9 * MiB;
constexpr size_t WS_XB = WS_WC + 1 * MiB;
constexpr size_t WS_RA = WS_XB + 38 * MiB;
constexpr size_t WS_PROJ = WS_RA, WS_LOGA = WS_RA + 108 * MiB, WS_HB = WS_RA;
constexpr size_t WS_RB = WS_RA + 146 * MiB;
constexpr size_t WS_O = WS_RB, WS_Z = WS_RB;
constexpr size_t WS_A2 = WS_RB + 72 * MiB;
constexpr size_t WS_XCH = WS_A2 + 38 * MiB;
constexpr size_t WS_X1 = WS_XCH + 1 * MiB;
constexpr size_t WS_X2 = WS_X1 + 72 * MiB;
constexpr size_t WS_VN = WS_X2 + 72 * MiB;
constexpr size_t WS_STAT = WS_VN + 36 * MiB;
constexpr size_t WS_IMG = WS_STAT + 1 * MiB;
constexpr size_t WS_END = WS_IMG + 37 * MiB;
constexpr int CW_BAR = 4096;
constexpr int CW_QUEUE = 64;
constexpr int CW_TMO = 1;
constexpr int CW_GATE = 8192;
constexpr int CW_LN = 16384, LN_BANK = 32 * 64;

constexpr int RING_BYTES = 139264;
constexpr int LDS_BYTES = 147456;
constexpr int MISC_OFF = LDS_BYTES - 256;

#define GAS __attribute__((address_space(1)))
#define LAS __attribute__((address_space(3)))
typedef unsigned short bf16;
typedef unsigned v4u __attribute__((ext_vector_type(4)));
typedef unsigned v2u __attribute__((ext_vector_type(2)));
typedef float f32x4 __attribute__((ext_vector_type(4)));
typedef short bf16x8 __attribute__((ext_vector_type(8)));
#define RLX_AGENT __ATOMIC_RELAXED, __HIP_MEMORY_SCOPE_AGENT
#define LDS_WAIT() asm volatile("s_waitcnt lgkmcnt(0)" ::: "memory")
#define VM_WAIT() asm volatile("s_waitcnt vmcnt(0)" ::: "memory")
__device__ __forceinline__ unsigned pk2(float lo, float hi) { return pg8::cvt_pk_bf16(lo, hi); }
__device__ __forceinline__ float bf_lo(unsigned w) { return __uint_as_float(w << 16); }
__device__ __forceinline__ float bf_hi(unsigned w) { return __uint_as_float(w & 0xffff0000u); }
__device__ __forceinline__ float bf2f(bf16 b) { return __uint_as_float(((unsigned)b) << 16); }

#define XB_TMO      128
#define XB_XCNT(j)  (256  + 64 * (j))
#define XB_XSUB(j)  (1280 + 64 * (j))
#define XB_XGEN(j)  (2304 + 64 * (j))
#define XB_TOP      3328
#define XB_TOPGEN   3392
#define XCD_BAR_WORDS 3456
#define XB_SPIN_CAP (1u << 22)
__device__ __forceinline__ unsigned xb_ld(unsigned* p)              { return __hip_atomic_load(p, __ATOMIC_RELAXED, __HIP_MEMORY_SCOPE_AGENT); }
__device__ __forceinline__ unsigned xb_add(unsigned* p, unsigned v) { return __hip_atomic_fetch_add(p, v, __ATOMIC_RELAXED, __HIP_MEMORY_SCOPE_AGENT); }
__device__ __forceinline__ unsigned xb_xcc_id() { return (unsigned)__builtin_amdgcn_s_getreg((3 << 11) | 20) & 0xFu; }
#define XB_SPIN(cond, bar) do { unsigned _sp = 0; while (cond) { __builtin_amdgcn_s_sleep(1); \
    if ((++_sp & 255u) == 0u) { if (xb_ld(&(bar)[XB_TMO])) break; if (_sp > XB_SPIN_CAP) { atomicAdd(&(bar)[XB_TMO], 1u); break; } } } } while (0)
struct XcdBarrier { unsigned* bar; unsigned x; volatile LAS unsigned* st; };
__device__ __forceinline__ XcdBarrier xcd_barrier_post(unsigned* bar, volatile LAS unsigned* st) {
    XcdBarrier b; b.bar = bar; b.x = xb_xcc_id(); b.st = st;
    if (threadIdx.x == 0) (void)xb_add(&bar[XB_XCNT(b.x)], 1u);
    return b;
}
__device__ __forceinline__ void xcd_barrier_complete(unsigned* bar, unsigned x, unsigned& nloc, unsigned& nx) {
    const unsigned G = gridDim.x * gridDim.y * gridDim.z;
    unsigned sum, cnt, mine, sp = 0u;
    for (;;) {
        sum = 0u; cnt = 0u; mine = 0u;
#pragma unroll
        for (unsigned j = 0; j < 16; ++j) { const unsigned c = xb_ld(&bar[XB_XCNT(j)]); sum += c; cnt += (c > 0u) ? 1u : 0u; mine = (j == x) ? c : mine; }
        if (sum == G) break;
        __builtin_amdgcn_s_sleep(1);
        if ((++sp & 255u) == 0u) { if (xb_ld(&bar[XB_TMO])) break; if (sp > XB_SPIN_CAP) { atomicAdd(&bar[XB_TMO], 1u); break; } }
    }
    nloc = mine > 0u ? mine : 1u; nx = cnt > 0u ? cnt : 1u;
}
__device__ __forceinline__ void xcd_barrier(const XcdBarrier& b) {
    asm volatile("s_waitcnt vmcnt(0)" ::: "memory");
    __syncthreads();
    if (threadIdx.x == 0) {
        unsigned* bar = b.bar;
        __builtin_amdgcn_s_waitcnt(0);
        unsigned nloc = b.st[0], nx = b.st[1];
        if (nloc == 0u) { xcd_barrier_complete(bar, b.x, nloc, nx); b.st[0] = nloc; b.st[1] = nx; }
        const unsigned old = xb_add(&bar[XB_XSUB(b.x)], 1u);
        const unsigned gen = old / nloc;
        if (old + 1u == (gen + 1u) * nloc) {
            __builtin_amdgcn_fence(__ATOMIC_RELEASE, "agent");
            asm volatile("s_waitcnt vmcnt(0)" ::: "memory");
            const unsigned og = xb_add(&bar[XB_TOP], 1u);
            const unsigned tg = og / nx;
            if (og + 1u == (tg + 1u) * nx) xb_add(&bar[XB_TOPGEN], 1u);
            else XB_SPIN(xb_ld(&bar[XB_TOPGEN]) == tg, bar);
            __builtin_amdgcn_fence(__ATOMIC_ACQUIRE, "agent");
            xb_add(&bar[XB_XGEN(b.x)], 1u);
            asm volatile("s_waitcnt vmcnt(0)" ::: "memory");
        } else {
            XB_SPIN(xb_ld(&bar[XB_XGEN(b.x)]) == gen, bar);
            __builtin_amdgcn_fence(__ATOMIC_ACQUIRE, "agent");
            asm volatile("s_waitcnt vmcnt(0)" ::: "memory");
        }
    }
    __syncthreads();
}

struct Frame {
    LAS unsigned char* lds;
    volatile LAS unsigned* MISC;
    unsigned* ctl;
    int tid, lane, wave, vcu, G;
    const float* in[21];
    float* out;
    unsigned char* ws;
};
__device__ __forceinline__ float wave_sum(float v) {
#pragma unroll
    for (int o = 1; o < 64; o <<= 1) v += __shfl_xor(v, o);
    return v;
}
__device__ __forceinline__ const float* xrow_ptr(const Frame& F, int m) { return m < MP ? F.in[0] + (size_t)m * DM : F.in[1] + (size_t)(m - MP) * DM; }

__device__ __forceinline__ void p0_transpose_item(const float* W, int ldw, int ldk, bf16* WT, int item, int nblk, int lane) {
    const int kb = item / nblk, nb = item - kb * nblk, k0 = 64 * kb, n0 = 64 * nb, q = lane >> 4, c = lane & 15;
    f32x4 v[16];
    const float* src = W + (size_t)(k0 + 16 * q) * ldw + n0 + 4 * c;
#pragma unroll
    for (int i = 0; i < 16; ++i) v[i] = __builtin_nontemporal_load((const f32x4*)(src + (size_t)i * ldw));
#pragma unroll
    for (int j = 0; j < 4; ++j) {
        v4u lo, hi;
        lo.x = pk2(v[0][j], v[1][j]); lo.y = pk2(v[2][j], v[3][j]); lo.z = pk2(v[4][j], v[5][j]); lo.w = pk2(v[6][j], v[7][j]);
        hi.x = pk2(v[8][j], v[9][j]); hi.y = pk2(v[10][j], v[11][j]); hi.z = pk2(v[12][j], v[13][j]); hi.w = pk2(v[14][j], v[15][j]);
        bf16* dst = WT + (size_t)(n0 + 4 * c + j) * ldk + k0 + 16 * q;
        *(v4u*)dst = lo; *(v4u*)(dst + 8) = hi;
    }
}
constexpr int DT_I_WOUT = (DM / 64) * (DM / 64), DT_I_W1 = (DM / 64) * (DFF / 64), DT_I_W2 = (DFF / 64) * (DM / 64), DT_I_SGIN = (DM / 64) * (2 * SGW / 64), DT_I_SGOUT = (SGW / 64) * (DM / 64);
constexpr int DT_NITEMS = DT_I_WOUT + 2 * DT_I_W1 + 2 * DT_I_W2 + DT_I_SGIN + DT_I_SGOUT, DT_NCHUNK = DT_NITEMS / 64;
static_assert(DT_NITEMS % 64 == 0, "deferred transposes: whole chunks");
__device__ __forceinline__ void deferred_transpose_chunk(Frame& F, int chunk) {
    unsigned char* ws = F.ws;
    for (int i = 0; i < 8; ++i) {
        int r = chunk * 64 + F.wave * 8 + i;
        if (r < DT_I_WOUT) { p0_transpose_item(F.in[7], DM, PK2, (bf16*)(ws + WS_WOUT), r, DM / 64, F.lane); continue; } r -= DT_I_WOUT;
        if (r < 2 * DT_I_W1) { const int l = r / DT_I_W1; r -= l * DT_I_W1; p0_transpose_item(F.in[15] + (size_t)l * DM * DFF, DFF, PK2, (bf16*)(ws + WS_W1) + (size_t)l * DFF * PK2, r, DFF / 64, F.lane); continue; } r -= 2 * DT_I_W1;
        if (r < 2 * DT_I_W2) { const int l = r / DT_I_W2; r -= l * DT_I_W2; p0_transpose_item(F.in[16] + (size_t)l * DFF * DM, DM, PK8, (bf16*)(ws + WS_W2) + (size_t)l * DM * PK8, r, DM / 64, F.lane); continue; } r -= 2 * DT_I_W2;
        if (r < DT_I_SGIN) { p0_transpose_item(F.in[8], 2 * SGW, PK2, (bf16*)(ws + WS_SGIN), r, 2 * SGW / 64, F.lane); continue; } r -= DT_I_SGIN;
        p0_transpose_item(F.in[14], DM, PK2, (bf16*)(ws + WS_SGOUT), r, DM / 64, F.lane);
    }
}
__device__ __forceinline__ float logsigmoid_f(float x) { return fminf(x, 0.f) - log1pf(expf(-fabsf(x))); }
__device__ __forceinline__ float logsigmoid_fast(float x) { return fminf(x, 0.f) - __logf(1.0f + __expf(-fabsf(x))); }
__device__ __forceinline__ void p0_prologue(Frame& F) {
    const int gw = F.vcu * NWAVES + F.wave, NGW = F.G * NWAVES;
    unsigned char* ws = F.ws;
    {
        constexpr int I_WIN = (DM / 64) * (NPROJ / 64);
        for (int it = gw; it < I_WIN; it += NGW) p0_transpose_item(F.in[3], WIN_LD, PK2, (bf16*)(ws + WS_WIN), it, NPROJ / 64, F.lane);
    }
    {
        bf16* wc = (bf16*)(ws + WS_WC); const float* wsp = F.in[12];
        for (int i = F.vcu * NTHR + F.tid; i < SGG * SGC * SGC; i += F.G * NTHR) { const int s = i & 127, t = (i >> 7) & 127; wc[i] = (bf16)(pk2(s <= t ? wsp[i] : 0.f, 0.f) & 0xffffu); }
        float* stat = (float*)(ws + WS_STAT);
        for (int i = F.vcu * NTHR + F.tid; i < 2 * M; i += F.G * NTHR) stat[i] = 0.f;
    }
    {
        constexpr int WGP = DM + 4;
        LAS float* wgT = (LAS float*)F.lds;
        for (int idx = F.tid; idx < DM * 4; idx += NTHR) { const int k = idx >> 2, part = idx & 3; const f32x4 w = *(const f32x4*)(F.in[3] + (size_t)k * WIN_LD + NPROJ + 4 * part);
            wgT[(4 * part + 0) * WGP + k] = w.x; wgT[(4 * part + 1) * WGP + k] = w.y; wgT[(4 * part + 2) * WGP + k] = w.z; wgT[(4 * part + 3) * WGP + k] = w.w; }
        __syncthreads();
        const float* wgate = F.in[4]; const float* bgate = F.in[5];
        bf16* xb = (bf16*)(ws + WS_XB); float* loga = (float*)(ws + WS_LOGA);
        const int rows_wg = M / F.G;
        const int r_lo = (F.wave * rows_wg) / NWAVES, r_hi = ((F.wave + 1) * rows_wg) / NWAVES;
        const int lane = F.lane, fr = lane & 15, fq = lane >> 4;
        LAS float* GT = (LAS float*)(F.lds + 16 * WGP * 4);
        {
            const int kw = F.wave * 256, ntile = (rows_wg + 15) >> 4;
            pg8::bf16x8 bh[8], bl[8];
#pragma unroll
            for (int ks = 0; ks < 8; ++ks) { const f32x4 w0 = *(const LAS f32x4*)(wgT + fr * WGP + kw + 32 * ks + 8 * fq), w1 = *(const LAS f32x4*)(wgT + fr * WGP + kw + 32 * ks + 8 * fq + 4);
                const v4u h = (v4u){pk2(w0.x, w0.y), pk2(w0.z, w0.w), pk2(w1.x, w1.y), pk2(w1.z, w1.w)};
                const v4u l = (v4u){pk2(w0.x - bf_lo(h.x), w0.y - bf_hi(h.x)), pk2(w0.z - bf_lo(h.y), w0.w - bf_hi(h.y)), pk2(w1.x - bf_lo(h.z), w1.y - bf_hi(h.z)), pk2(w1.z - bf_lo(h.w), w1.w - bf_hi(h.w))};
                bh[ks] = __builtin_bit_cast(pg8::bf16x8, h); bl[ks] = __builtin_bit_cast(pg8::bf16x8, l); }
            __syncthreads();
            LAS f32x4* PS = (LAS f32x4*)F.lds;
            f32x4 xa[8][2];
            { const int row = fr < rows_wg ? fr : rows_wg - 1; const float* xp = xrow_ptr(F, F.vcu * rows_wg + row) + kw + 8 * fq;
#pragma unroll
              for (int ks = 0; ks < 8; ++ks) { xa[ks][0] = *(const f32x4*)(xp + 32 * ks); xa[ks][1] = *(const f32x4*)(xp + 32 * ks + 4); } }
            for (int rt = 0; rt < ntile; ++rt) {
                const int row = 16 * rt + fr; const bool valid = row < rows_wg; const int m = F.vcu * rows_wg + (valid ? row : rows_wg - 1);
                f32x4 xc[8][2];
#pragma unroll
                for (int ks = 0; ks < 8; ++ks) { xc[ks][0] = xa[ks][0]; xc[ks][1] = xa[ks][1]; }
                if (rt + 1 < ntile) { const int rown = 16 * (rt + 1) + fr; const float* xp = xrow_ptr(F, F.vcu * rows_wg + (rown < rows_wg ? rown : rows_wg - 1)) + kw + 8 * fq;
#pragma unroll
                    for (int ks = 0; ks < 8; ++ks) { xa[ks][0] = *(const f32x4*)(xp + 32 * ks); xa[ks][1] = *(const f32x4*)(xp + 32 * ks + 4); } }
                f32x4 acc = (f32x4){0.f, 0.f, 0.f, 0.f};
                bf16* xo = xb + (size_t)m * PK2 + kw + 8 * fq;
#pragma unroll
                for (int ks = 0; ks < 8; ++ks) { const f32x4 w0 = xc[ks][0], w1 = xc[ks][1];
                    const v4u h = (v4u){pk2(w0.x, w0.y), pk2(w0.z, w0.w), pk2(w1.x, w1.y), pk2(w1.z, w1.w)};
                    const v4u l = (v4u){pk2(w0.x - bf_lo(h.x), w0.y - bf_hi(h.x)), pk2(w0.z - bf_lo(h.y), w0.w - bf_hi(h.y)), pk2(w1.x - bf_lo(h.z), w1.y - bf_hi(h.z)), pk2(w1.z - bf_lo(h.w), w1.w - bf_hi(h.w))};
                    if (valid) *(v4u*)(xo + 32 * ks) = h;
                    const pg8::bf16x8 ah = __builtin_bit_cast(pg8::bf16x8, h), al = __builtin_bit_cast(pg8::bf16x8, l);
                    acc = __builtin_amdgcn_mfma_f32_16x16x32_bf16(ah, bh[ks], acc, 0, 0, 0);
                    acc = __builtin_amdgcn_mfma_f32_16x16x32_bf16(al, bh[ks], acc, 0, 0, 0);
                    acc = __builtin_amdgcn_mfma_f32_16x16x32_bf16(ah, bl[ks], acc, 0, 0, 0); }
                PS[(F.wave * ntile + rt) * 64 + lane] = acc;
            }
            __syncthreads();
            for (int idx = F.tid; idx < rows_wg * 16; idx += NTHR) { const int row = idx >> 4, r = idx & 15, rt = row >> 4, ml = row & 15; float t = 0.f;
#pragma unroll
                for (int w = 0; w < NWAVES; ++w) t += ((const LAS float*)(PS + (w * ntile + rt) * 64 + 16 * (ml >> 2) + r))[ml & 3];
                GT[row * 16 + r] = t; }
        }
        __syncthreads();
        LAS float* WG = (LAS float*)F.lds;
        LAS float* BG = WG + 16 * KD;
        for (int idx = F.tid; idx < 17 * KD / 4; idx += NTHR) *((LAS f32x4*)F.lds + idx) = (idx < 16 * KD / 4) ? *((const f32x4*)wgate + idx) : *((const f32x4*)bgate + (idx - 16 * KD / 4));
        __syncthreads();
        for (int rl = r_lo; rl < r_hi; ++rl) { const int m = F.vcu * rows_wg + rl;
            const f32x4 g0 = *(const LAS f32x4*)(GT + rl * 16), g1 = *(const LAS f32x4*)(GT + rl * 16 + 4), g2 = *(const LAS f32x4*)(GT + rl * 16 + 8), g3 = *(const LAS f32x4*)(GT + rl * 16 + 12);
            const float g[16] = {g0.x, g0.y, g0.z, g0.w, g1.x, g1.y, g1.z, g1.w, g2.x, g2.y, g2.z, g2.w, g3.x, g3.y, g3.z, g3.w};
#pragma unroll
            for (int j = 0; j < 4; ++j) { const int c0 = 4 * lane + 256 * j; f32x4 lg0 = *(const LAS f32x4*)(BG + c0);
#pragma unroll
                for (int r = 0; r < 16; ++r) { const f32x4 w = *(const LAS f32x4*)(WG + r * KD + c0); lg0 += w * g[r]; }
                f32x4 o;
                o.x = logsigmoid_fast(lg0.x) * 0.0625f; o.y = logsigmoid_fast(lg0.y) * 0.0625f; o.z = logsigmoid_fast(lg0.z) * 0.0625f; o.w = logsigmoid_fast(lg0.w) * 0.0625f; *(f32x4*)(loga + (size_t)m * KD + c0) = o;
                asm volatile("" ::: "memory"); }
        }
        __syncthreads();
    }
}

constexpr size_t IMG_QD = 0, IMG_KET = 32768, IMG_P = 65536, IMG_DV = 73728, IMG_BYTES = 74752;
constexpr int PP_QD = 0, PP_KI = 33792, PP_P = 67584, PP_RS = 76800;
constexpr int QD_PITCH = 528, T_PITCH = 144;
__device__ __forceinline__ pg8::bf16x8 as_bf16x8(v4u w) { return __builtin_bit_cast(pg8::bf16x8, w); }
__device__ __forceinline__ void gla_prep_item(Frame& F, int item) {
    const int n = item & 31, h = (item >> 5) & 3, b = item >> 7;
    const bf16* proj = (const bf16*)(F.ws + WS_PROJ); const float* loga = (const float*)(F.ws + WS_LOGA);
    unsigned char* img = F.ws + WS_IMG + (size_t)item * IMG_BYTES;
    LAS unsigned char* L = F.lds;
    const int tid = F.tid, lane = F.lane, w = F.wave, fr = lane & 15, fq = lane >> 4, cp = tid & 63, rg = tid >> 6;
    f32x4 lg[8]; v2u qr[8], kr[8];
    { const size_t R0 = (size_t)b * SEQ + (size_t)n * 64;
#pragma unroll
      for (int s = 0; s < 8; ++s) { const size_t row = R0 + 8 * rg + s;
          lg[s] = *(const f32x4*)(loga + row * KD + h * HK + 4 * cp); qr[s] = *(const v2u*)(proj + row * NPROJ + h * HK + 4 * cp); kr[s] = *(const v2u*)(proj + row * NPROJ + KD + h * HK + 4 * cp); } }
    __syncthreads();
    { f32x4 c = (f32x4){0.f, 0.f, 0.f, 0.f};
#pragma unroll
      for (int s = 0; s < 8; ++s) { c += lg[s]; lg[s] = c; }
      *((LAS f32x4*)(L + PP_RS) + rg * 64 + cp) = c; }
    __syncthreads();
    { f32x4 off = (f32x4){0.f, 0.f, 0.f, 0.f}, tot = (f32x4){0.f, 0.f, 0.f, 0.f};
#pragma unroll
      for (int r = 0; r < 8; ++r) { const f32x4 v = *((const LAS f32x4*)(L + PP_RS) + r * 64 + cp); tot += v; if (r < rg) off += v; }
      f32x4 ei; ei.x = __expf(-tot.x); ei.y = __expf(-tot.y); ei.z = __expf(-tot.z); ei.w = __expf(-tot.w);
      unsigned ke[4][4];
#pragma unroll
      for (int s2 = 0; s2 < 4; ++s2) { f32x4 kev[2]; unsigned qw[4];
#pragma unroll
          for (int u = 0; u < 2; ++u) { const int s = 2 * s2 + u; const f32x4 bb = off + lg[s], tb = tot - bb;
              f32x4 e1, e3; e1.x = __expf(bb.x); e1.y = __expf(bb.y); e1.z = __expf(bb.z); e1.w = __expf(bb.w); e3.x = __expf(tb.x); e3.y = __expf(tb.y); e3.z = __expf(tb.z); e3.w = __expf(tb.w);
              const f32x4 q4 = (f32x4){bf_lo(qr[s].x), bf_hi(qr[s].x), bf_lo(qr[s].y), bf_hi(qr[s].y)}, k4 = (f32x4){bf_lo(kr[s].x), bf_hi(kr[s].x), bf_lo(kr[s].y), bf_hi(kr[s].y)};
              const f32x4 qd = q4 * e1 * 0.0625f; kev[u] = k4 * e3; const f32x4 ki = kev[u] * ei;
              qw[2 * u] = pk2(qd.x, qd.y); qw[2 * u + 1] = pk2(qd.z, qd.w);
              *(LAS v2u*)(L + PP_QD + (8 * rg + s) * QD_PITCH + 8 * cp) = (v2u){qw[2 * u], qw[2 * u + 1]};
              *(LAS v2u*)(L + PP_KI + (8 * rg + s) * QD_PITCH + 8 * cp) = (v2u){pk2(ki.x, ki.y), pk2(ki.z, ki.w)}; }
          *((v4u*)(img + IMG_QD) + s2 * NTHR + tid) = (v4u){qw[0], qw[1], qw[2], qw[3]};
          ke[0][s2] = pk2(kev[0].x, kev[1].x); ke[1][s2] = pk2(kev[0].y, kev[1].y); ke[2][s2] = pk2(kev[0].z, kev[1].z); ke[3][s2] = pk2(kev[0].w, kev[1].w); }
#pragma unroll
      for (int c4 = 0; c4 < 4; ++c4) *((v4u*)(img + IMG_KET) + c4 * NTHR + tid) = (v4u){ke[c4][0], ke[c4][1], ke[c4][2], ke[c4][3]};
      if (rg == 0) { f32x4 dv; dv.x = __expf(tot.x); dv.y = __expf(tot.y); dv.z = __expf(tot.z); dv.w = __expf(tot.w); *((f32x4*)(img + IMG_DV) + cp) = dv; }
    }
    __syncthreads();
    { const int ttw = w >> 1, sp = w & 1;
      f32x4 sc0 = (f32x4){0.f, 0.f, 0.f, 0.f}, sc1 = (f32x4){0.f, 0.f, 0.f, 0.f};
      if (2 * sp <= ttw) {
#pragma unroll
          for (int ks = 0; ks < 8; ++ks) { const pg8::bf16x8 a = *(const LAS pg8::bf16x8*)(L + PP_QD + (16 * ttw + fr) * QD_PITCH + (32 * ks + 8 * fq) * 2);
              const pg8::bf16x8 b0 = *(const LAS pg8::bf16x8*)(L + PP_KI + (16 * (2 * sp) + fr) * QD_PITCH + (32 * ks + 8 * fq) * 2);
              sc0 = __builtin_amdgcn_mfma_f32_16x16x32_bf16(a, b0, sc0, 0, 0, 0);
              if (2 * sp + 1 <= ttw) { const pg8::bf16x8 b1 = *(const LAS pg8::bf16x8*)(L + PP_KI + (16 * (2 * sp + 1) + fr) * QD_PITCH + (32 * ks + 8 * fq) * 2);
                  sc1 = __builtin_amdgcn_mfma_f32_16x16x32_bf16(a, b1, sc1, 0, 0, 0); } } }
#pragma unroll
      for (int r = 0; r < 4; ++r) { const int tl = 4 * fq + r;
          float v0 = sc0[r], v1 = sc1[r];
          if (2 * sp > ttw || (2 * sp == ttw && fr > tl)) v0 = 0.f;
          if (2 * sp + 1 > ttw || (2 * sp + 1 == ttw && fr > tl)) v1 = 0.f;
          *(LAS unsigned short*)(L + PP_P + (16 * ttw + tl) * T_PITCH + (16 * (2 * sp) + fr) * 2) = (unsigned short)(pk2(v0, 0.f) & 0xffffu);
          *(LAS unsigned short*)(L + PP_P + (16 * ttw + tl) * T_PITCH + (16 * (2 * sp + 1) + fr) * 2) = (unsigned short)(pk2(v1, 0.f) & 0xffffu); } }
    __syncthreads();
    *((v4u*)(img + IMG_P) + tid) = *(const LAS v4u*)(L + PP_P + (tid >> 3) * T_PITCH + (tid & 7) * 16);
}
__device__ __forceinline__ void p2a_gla_prep(Frame& F) {
    for (int it = F.vcu; it < NB * NH * (SEQ / 64); it += F.G) gla_prep_item(F, it);
    __syncthreads();
}
constexpr int SC_QD = 0, SC_KET = 33792, SC_VT = 70656, SC_P = 79872, SC_DV = 89088, SC_OX = 90112, SC_END = 106496;
static_assert(SC_END <= MISC_OFF && PP_RS + 8192 <= MISC_OFF, "GLA LDS maps");
__device__ __forceinline__ void gla_prompt_item(Frame& F, int item) {
    const int j = item & 7, h = (item >> 3) & 3, b = item >> 5;
    const bf16* proj = (const bf16*)(F.ws + WS_PROJ); bf16* O = (bf16*)(F.ws + WS_O);
    const unsigned char* img0 = F.ws + WS_IMG + (size_t)((b * NH + h) * (SEQ / 64)) * IMG_BYTES;
    LAS unsigned char* L = F.lds;
    const int tid = F.tid, lane = F.lane, w = F.wave, fr = lane & 15, fq = lane >> 4, cp = tid & 63, rg = tid >> 6;
    const int kh = w >> 2, vt = w & 3;
    f32x4 S[8];
#pragma unroll
    for (int i = 0; i < 8; ++i) S[i] = (f32x4){0.f, 0.f, 0.f, 0.f};
    v4u qdA[4], keA[4], ppA, vrA, qdB[4], keB[4], ppB, vrB; f32x4 dvA = (f32x4){0.f, 0.f, 0.f, 0.f}, dvB = (f32x4){0.f, 0.f, 0.f, 0.f};
#define SC_LOAD(n_, QD_, KE_, PP_, DV_, VR_) do { const unsigned char* im_ = img0 + (size_t)(n_) * IMG_BYTES; \
        _Pragma("unroll") for (int i_ = 0; i_ < 4; ++i_) { QD_[i_] = *((const v4u*)(im_ + IMG_QD) + i_ * NTHR + tid); KE_[i_] = *((const v4u*)(im_ + IMG_KET) + i_ * NTHR + tid); } \
        PP_ = *((const v4u*)(im_ + IMG_P) + tid); if (rg == 0) DV_ = *((const f32x4*)(im_ + IMG_DV) + cp); \
        VR_ = *(const v4u*)(proj + ((size_t)b * SEQ + (size_t)(n_) * 64 + lane) * NPROJ + 2 * KD + h * HV + j * 64 + 8 * w); } while (0)
    SC_LOAD(0, qdA, keA, ppA, dvA, vrA);
    SC_LOAD(1, qdB, keB, ppB, dvB, vrB);
    __syncthreads();
    for (int n = 0; n < SEQ / 64; n += 2) {
#pragma unroll
        for (int s2 = 0; s2 < 4; ++s2) { *(LAS v2u*)(L + SC_QD + (8 * rg + 2 * s2) * QD_PITCH + 8 * cp) = (v2u){qdA[s2].x, qdA[s2].y}; *(LAS v2u*)(L + SC_QD + (8 * rg + 2 * s2 + 1) * QD_PITCH + 8 * cp) = (v2u){qdA[s2].z, qdA[s2].w}; }
#pragma unroll
        for (int c4 = 0; c4 < 4; ++c4) *(LAS v4u*)(L + SC_KET + (4 * cp + c4) * T_PITCH + 16 * rg) = keA[c4];
        *(LAS v4u*)(L + SC_P + (tid >> 3) * T_PITCH + (tid & 7) * 16) = ppA;
        if (rg == 0) *((LAS f32x4*)(L + SC_DV) + cp) = dvA;
        { LAS unsigned short* col = (LAS unsigned short*)(L + SC_VT + (8 * w) * T_PITCH + 2 * lane);
          col[0 * (T_PITCH / 2)] = (unsigned short)(vrA.x & 0xffffu); col[1 * (T_PITCH / 2)] = (unsigned short)(vrA.x >> 16); col[2 * (T_PITCH / 2)] = (unsigned short)(vrA.y & 0xffffu); col[3 * (T_PITCH / 2)] = (unsigned short)(vrA.y >> 16);
          col[4 * (T_PITCH / 2)] = (unsigned short)(vrA.z & 0xffffu); col[5 * (T_PITCH / 2)] = (unsigned short)(vrA.z >> 16); col[6 * (T_PITCH / 2)] = (unsigned short)(vrA.w & 0xffffu); col[7 * (T_PITCH / 2)] = (unsigned short)(vrA.w >> 16); }
        if ((n) + 2 < SEQ / 64) SC_LOAD((n) + 2, qdA, keA, ppA, dvA, vrA);
        __syncthreads();
        { f32x4 Oa[4];
#pragma unroll
        for (int tt = 0; tt < 4; ++tt) Oa[tt] = (f32x4){0.f, 0.f, 0.f, 0.f};
#pragma unroll
        for (int ks = 0; ks < 4; ++ks) {
            const pg8::bf16x8 Bv = as_bf16x8((v4u){pk2(S[2 * ks][0], S[2 * ks][1]), pk2(S[2 * ks][2], S[2 * ks][3]), pk2(S[2 * ks + 1][0], S[2 * ks + 1][1]), pk2(S[2 * ks + 1][2], S[2 * ks + 1][3])});
#pragma unroll
            for (int tt = 0; tt < 4; ++tt) { const v2u lo = *(const LAS v2u*)(L + SC_QD + (16 * tt + fr) * QD_PITCH + (128 * kh + 32 * ks + 4 * fq) * 2), hi = *(const LAS v2u*)(L + SC_QD + (16 * tt + fr) * QD_PITCH + (128 * kh + 32 * ks + 16 + 4 * fq) * 2);
                Oa[tt] = __builtin_amdgcn_mfma_f32_16x16x32_bf16(as_bf16x8((v4u){lo.x, lo.y, hi.x, hi.y}), Bv, Oa[tt], 0, 0, 0); } }
        if (kh == 1) {
#pragma unroll
            for (int tt = 0; tt < 4; ++tt)
#pragma unroll
                for (int r = 0; r < 4; ++r) *(LAS float*)(L + SC_OX + ((vt * 64 + 16 * tt + 4 * fq + r) * 16 + fr) * 4) = Oa[tt][r]; }
        __syncthreads();
        pg8::bf16x8 Vb[2];
#pragma unroll
        for (int k2 = 0; k2 < 2; ++k2) Vb[k2] = *(const LAS pg8::bf16x8*)(L + SC_VT + (16 * vt + fr) * T_PITCH + (32 * k2 + 8 * fq) * 2);
        if (kh == 0) {
#pragma unroll
            for (int tt = 0; tt < 4; ++tt) {
#pragma unroll
                for (int r = 0; r < 4; ++r) Oa[tt][r] += *(const LAS float*)(L + SC_OX + ((vt * 64 + 16 * tt + 4 * fq + r) * 16 + fr) * 4);
#pragma unroll
                for (int k2 = 0; k2 < 2; ++k2) { if (32 * k2 > 16 * tt + 15) continue;
                    const pg8::bf16x8 a = *(const LAS pg8::bf16x8*)(L + SC_P + (16 * tt + fr) * T_PITCH + (32 * k2 + 8 * fq) * 2);
                    Oa[tt] = __builtin_amdgcn_mfma_f32_16x16x32_bf16(a, Vb[k2], Oa[tt], 0, 0, 0); } }
            bf16* op = O + ((size_t)b * SEQ + (size_t)(n) * 64 + 4 * fq) * DM + h * HV + j * 64 + 16 * vt + fr;
#pragma unroll
            for (int tt = 0; tt < 4; ++tt)
#pragma unroll
                for (int r = 0; r < 4; ++r) op[(size_t)(16 * tt + r) * DM] = (bf16)(pk2(Oa[tt][r], 0.f) & 0xffffu); }
#pragma unroll
        for (int kt = 0; kt < 8; ++kt) { const f32x4 d4 = *(const LAS f32x4*)(L + SC_DV + (128 * kh + 16 * kt + 4 * fq) * 4); S[kt] = S[kt] * d4;
#pragma unroll
            for (int k2 = 0; k2 < 2; ++k2) { const pg8::bf16x8 a = *(const LAS pg8::bf16x8*)(L + SC_KET + (128 * kh + 16 * kt + fr) * T_PITCH + (32 * k2 + 8 * fq) * 2);
                S[kt] = __builtin_amdgcn_mfma_f32_16x16x32_bf16(a, Vb[k2], S[kt], 0, 0, 0); } }
        }
        __syncthreads();
#pragma unroll
        for (int s2 = 0; s2 < 4; ++s2) { *(LAS v2u*)(L + SC_QD + (8 * rg + 2 * s2) * QD_PITCH + 8 * cp) = (v2u){qdB[s2].x, qdB[s2].y}; *(LAS v2u*)(L + SC_QD + (8 * rg + 2 * s2 + 1) * QD_PITCH + 8 * cp) = (v2u){qdB[s2].z, qdB[s2].w}; }
#pragma unroll
        for (int c4 = 0; c4 < 4; ++c4) *(LAS v4u*)(L + SC_KET + (4 * cp + c4) * T_PITCH + 16 * rg) = keB[c4];
        *(LAS v4u*)(L + SC_P + (tid >> 3) * T_PITCH + (tid & 7) * 16) = ppB;
        if (rg == 0) *((LAS f32x4*)(L + SC_DV) + cp) = dvB;
        { LAS unsigned short* col = (LAS unsigned short*)(L + SC_VT + (8 * w) * T_PITCH + 2 * lane);
          col[0 * (T_PITCH / 2)] = (unsigned short)(vrB.x & 0xffffu); col[1 * (T_PITCH / 2)] = (unsigned short)(vrB.x >> 16); col[2 * (T_PITCH / 2)] = (unsigned short)(vrB.y & 0xffffu); col[3 * (T_PITCH / 2)] = (unsigned short)(vrB.y >> 16);
          col[4 * (T_PITCH / 2)] = (unsigned short)(vrB.z & 0xffffu); col[5 * (T_PITCH / 2)] = (unsigned short)(vrB.z >> 16); col[6 * (T_PITCH / 2)] = (unsigned short)(vrB.w & 0xffffu); col[7 * (T_PITCH / 2)] = (unsigned short)(vrB.w >> 16); }
        if ((n + 1) + 2 < SEQ / 64) SC_LOAD((n + 1) + 2, qdB, keB, ppB, dvB, vrB);
        __syncthreads();
        { f32x4 Oa[4];
#pragma unroll
        for (int tt = 0; tt < 4; ++tt) Oa[tt] = (f32x4){0.f, 0.f, 0.f, 0.f};
#pragma unroll
        for (int ks = 0; ks < 4; ++ks) {
            const pg8::bf16x8 Bv = as_bf16x8((v4u){pk2(S[2 * ks][0], S[2 * ks][1]), pk2(S[2 * ks][2], S[2 * ks][3]), pk2(S[2 * ks + 1][0], S[2 * ks + 1][1]), pk2(S[2 * ks + 1][2], S[2 * ks + 1][3])});
#pragma unroll
            for (int tt = 0; tt < 4; ++tt) { const v2u lo = *(const LAS v2u*)(L + SC_QD + (16 * tt + fr) * QD_PITCH + (128 * kh + 32 * ks + 4 * fq) * 2), hi = *(const LAS v2u*)(L + SC_QD + (16 * tt + fr) * QD_PITCH + (128 * kh + 32 * ks + 16 + 4 * fq) * 2);
                Oa[tt] = __builtin_amdgcn_mfma_f32_16x16x32_bf16(as_bf16x8((v4u){lo.x, lo.y, hi.x, hi.y}), Bv, Oa[tt], 0, 0, 0); } }
        if (kh == 1) {
#pragma unroll
            for (int tt = 0; tt < 4; ++tt)
#pragma unroll
                for (int r = 0; r < 4; ++r) *(LAS float*)(L + SC_OX + ((vt * 64 + 16 * tt + 4 * fq + r) * 16 + fr) * 4) = Oa[tt][r]; }
        __syncthreads();
        pg8::bf16x8 Vb[2];
#pragma unroll
        for (int k2 = 0; k2 < 2; ++k2) Vb[k2] = *(const LAS pg8::bf16x8*)(L + SC_VT + (16 * vt + fr) * T_PITCH + (32 * k2 + 8 * fq) * 2);
        if (kh == 0) {
#pragma unroll
            for (int tt = 0; tt < 4; ++tt) {
#pragma unroll
                for (int r = 0; r < 4; ++r) Oa[tt][r] += *(const LAS float*)(L + SC_OX + ((vt * 64 + 16 * tt + 4 * fq + r) * 16 + fr) * 4);
#pragma unroll
                for (int k2 = 0; k2 < 2; ++k2) { if (32 * k2 > 16 * tt + 15) continue;
                    const pg8::bf16x8 a = *(const LAS pg8::bf16x8*)(L + SC_P + (16 * tt + fr) * T_PITCH + (32 * k2 + 8 * fq) * 2);
                    Oa[tt] = __builtin_amdgcn_mfma_f32_16x16x32_bf16(a, Vb[k2], Oa[tt], 0, 0, 0); } }
            bf16* op = O + ((size_t)b * SEQ + (size_t)(n + 1) * 64 + 4 * fq) * DM + h * HV + j * 64 + 16 * vt + fr;
#pragma unroll
            for (int tt = 0; tt < 4; ++tt)
#pragma unroll
                for (int r = 0; r < 4; ++r) op[(size_t)(16 * tt + r) * DM] = (bf16)(pk2(Oa[tt][r], 0.f) & 0xffffu); }
#pragma unroll
        for (int kt = 0; kt < 8; ++kt) { const f32x4 d4 = *(const LAS f32x4*)(L + SC_DV + (128 * kh + 16 * kt + 4 * fq) * 4); S[kt] = S[kt] * d4;
#pragma unroll
            for (int k2 = 0; k2 < 2; ++k2) { const pg8::bf16x8 a = *(const LAS pg8::bf16x8*)(L + SC_KET + (128 * kh + 16 * kt + fr) * T_PITCH + (32 * k2 + 8 * fq) * 2);
                S[kt] = __builtin_amdgcn_mfma_f32_16x16x32_bf16(a, Vb[k2], S[kt], 0, 0, 0); } }
        }
        __syncthreads();
    }
#undef SC_LOAD
    { float* SP = F.out + OUT_SP + ((size_t)(b * NH + h) * HK + 128 * kh + 4 * fq) * HV + j * 64 + 16 * vt + fr;
#pragma unroll
      for (int kt = 0; kt < 8; ++kt)
#pragma unroll
          for (int r = 0; r < 4; ++r) SP[(size_t)(16 * kt + r) * HV] = S[kt][r]; }
}
__device__ __forceinline__ void gla_sample_item(Frame& F, int item) {
    const int h = item & 3, b = item >> 2;
    const bf16* proj = (const bf16*)(F.ws + WS_PROJ); const float* loga = (const float*)(F.ws + WS_LOGA); bf16* O = (bf16*)(F.ws + WS_O);
    LAS float* AT = (LAS float*)F.lds;
    LAS float* KT = AT + 256 * 8;
    LAS float* QT = KT + 256 * 8;
    LAS float* VV = QT + 256 * 8;
    LAS float* RED = VV + 8 * 512;
    const size_t r0 = (size_t)MP + (size_t)b * DT;
    const int c4 = F.tid & 127, kg = F.tid >> 7;
    const f32x4* S0 = (const f32x4*)(F.in[2] + (size_t)(b * NH + h) * HK * HV) + c4;
    f32x4* S1 = (f32x4*)(F.out + OUT_SS + (size_t)(b * NH + h) * HK * HV) + c4;
    f32x4 s[8];
#pragma unroll
    for (int u = 0; u < 8; ++u) s[u] = __builtin_nontemporal_load(S0 + (size_t)(kg * 64 + u) * 128);
    for (int idx = F.tid; idx < 8 * 256; idx += NTHR) { const int t = idx >> 8, k = idx & 255; const size_t row = r0 + t;
        AT[k * 8 + t] = __expf(loga[row * KD + h * HK + k]); KT[k * 8 + t] = bf2f(proj[row * NPROJ + KD + h * HK + k]); QT[k * 8 + t] = bf2f(proj[row * NPROJ + h * HK + k]) * 0.0625f; }
    for (int idx = F.tid; idx < 8 * 512; idx += NTHR) { const int t = idx >> 9, v = idx & 511; VV[idx] = bf2f(proj[(r0 + t) * NPROJ + 2 * KD + h * HV + v]); }
    __syncthreads();
    f32x4 vv[8], oa[8];
#pragma unroll
    for (int t = 0; t < 8; ++t) { vv[t] = *(const LAS f32x4*)(VV + t * 512 + 4 * c4); oa[t] = (f32x4){0.f, 0.f, 0.f, 0.f}; }
#define GLA_S_ROW(u_, k_, REFILL) do { const int k = (k_); \
            const f32x4 a0 = *(const LAS f32x4*)(AT + k * 8), a1 = *(const LAS f32x4*)(AT + k * 8 + 4), k0 = *(const LAS f32x4*)(KT + k * 8), k1 = *(const LAS f32x4*)(KT + k * 8 + 4), q0 = *(const LAS f32x4*)(QT + k * 8), q1 = *(const LAS f32x4*)(QT + k * 8 + 4); \
            f32x4 x = s[u_]; \
            x = x * a0.x + vv[0] * k0.x; oa[0] += x * q0.x; \
            x = x * a0.y + vv[1] * k0.y; oa[1] += x * q0.y; \
            x = x * a0.z + vv[2] * k0.z; oa[2] += x * q0.z; \
            x = x * a0.w + vv[3] * k0.w; oa[3] += x * q0.w; \
            x = x * a1.x + vv[4] * k1.x; oa[4] += x * q1.x; \
            x = x * a1.y + vv[5] * k1.y; oa[5] += x * q1.y; \
            x = x * a1.z + vv[6] * k1.z; oa[6] += x * q1.z; \
            x = x * a1.w + vv[7] * k1.w; oa[7] += x * q1.w; \
            __builtin_nontemporal_store(x, S1 + (size_t)k * 128); \
            if (REFILL) s[u_] = __builtin_nontemporal_load(S0 + (size_t)(k + 8) * 128); \
            asm volatile("" ::: "memory"); } while (0)
#pragma unroll 1
    for (int kb = 0; kb < 56; kb += 8) {
#pragma unroll
        for (int u = 0; u < 8; ++u) GLA_S_ROW(u, kg * 64 + kb + u, true);
    }
#pragma unroll
    for (int u = 0; u < 8; ++u) GLA_S_ROW(u, kg * 64 + 56 + u, false);
#undef GLA_S_ROW
#pragma unroll
    for (int t = 0; t < 8; ++t) *(LAS f32x4*)(RED + (kg * 8 + t) * 512 + 4 * c4) = oa[t];
    __syncthreads();
    for (int idx = F.tid; idx < 8 * 128; idx += NTHR) { const int t = idx >> 7, c = idx & 127;
        const f32x4 r = *(const LAS f32x4*)(RED + (0 * 8 + t) * 512 + 4 * c) + *(const LAS f32x4*)(RED + (1 * 8 + t) * 512 + 4 * c) + *(const LAS f32x4*)(RED + (2 * 8 + t) * 512 + 4 * c) + *(const LAS f32x4*)(RED + (3 * 8 + t) * 512 + 4 * c);
        v2u rb; rb.x = pk2(r.x, r.y); rb.y = pk2(r.z, r.w); *(v2u*)(O + (r0 + t) * DM + h * HV + 4 * c) = rb; }
    __syncthreads();
}
__device__ __forceinline__ void p2_gla(Frame& F, int qslot) {
    constexpr int NPI = NB * NH * 8, NSI = DB * NH;
    if ((int)blockIdx.x < NPI) { const int x = (int)blockIdx.x & 7, m = (int)blockIdx.x >> 3;
        gla_prompt_item(F, ((2 * x + (m & 1)) << 3) | (m >> 1));
        __syncthreads();
        pg9::Gemm g{(const bf16*)(F.ws + WS_XB), (const bf16*)(F.ws + WS_WIN) + (size_t)NQKV * PK2, M, NPROJ - NQKV, DM, PK2, PK2};
        pg9::ListOrder S{(int)blockIdx.x, NPI, (M / pg9::BMR) * ((NPROJ - NQKV) / pg9::BNC), M / pg9::BMR};
        pg9::EpiBf16<0> E{(bf16*)(F.ws + WS_PROJ) + NQKV, NPROJ, nullptr};
        pg9::gemm_phase<pg9::EpiBf16<0>, true, pg9::ListOrder>(F.lds, g, S, E);
        __syncthreads(); }
    for (;;) {
        __syncthreads();
        if (F.tid == 0) F.MISC[16] = __hip_atomic_fetch_add(F.ctl + CW_QUEUE + 64 * qslot, 1u, RLX_AGENT);
        __syncthreads();
        const int it = (int)F.MISC[16];
        if (it >= NSI + DT_NCHUNK) break;
        if (it < NSI) gla_sample_item(F, it); else deferred_transpose_chunk(F, it - NSI);
    }
    __syncthreads();
}

__device__ __forceinline__ void gate_rows(Frame& F, int row_lo, int nrows) {
    const bf16* O = (const bf16*)(F.ws + WS_O); const bf16* proj = (const bf16*)(F.ws + WS_PROJ); bf16* A2 = (bf16*)(F.ws + WS_A2); const float* ng = F.in[6];
    const int lane = F.lane; const bool b5 = lane & 32, b4 = lane & 16;
    f32x4 g4[8];
#pragma unroll
    for (int i = 0; i < 8; ++i) g4[i] = *((const f32x4*)ng + lane + 64 * i);
    const int r_lo = (F.wave * nrows) / NWAVES, r_hi = ((F.wave + 1) * nrows) / NWAVES;
    for (int rr = r_lo; rr < r_hi; rr += 2) {
        v2u ow[2][8], rw[2][8];
#pragma unroll
        for (int q = 0; q < 2; ++q) { const int m = row_lo + ((rr + q < r_hi) ? rr + q : r_hi - 1);
#pragma unroll
            for (int i = 0; i < 8; ++i) { ow[q][i] = *((const v2u*)(O + (size_t)m * DM) + lane + 64 * i); rw[q][i] = *((const v2u*)(proj + (size_t)m * NPROJ + 2 * KD + 2048) + lane + 64 * i); } }
#pragma unroll
        for (int q = 0; q < 2; ++q) { const int m = row_lo + ((rr + q < r_hi) ? rr + q : r_hi - 1);
            f32x4 v[8]; float hs[4];
#pragma unroll
            for (int i = 0; i < 8; ++i) v[i] = (f32x4){bf_lo(ow[q][i].x), bf_hi(ow[q][i].x), bf_lo(ow[q][i].y), bf_hi(ow[q][i].y)};
#pragma unroll
            for (int h = 0; h < 4; ++h) { const f32x4 a = v[2 * h], c = v[2 * h + 1]; hs[h] = (a.x * a.x + a.y * a.y) + (a.z * a.z + a.w * a.w) + (c.x * c.x + c.y * c.y) + (c.z * c.z + c.w * c.w); }
            float t2[2], t1;
#pragma unroll
            for (int i = 0; i < 2; ++i) { const float keep = b5 ? hs[i + 2] : hs[i], send = b5 ? hs[i] : hs[i + 2]; t2[i] = keep + __shfl_xor(send, 32); }
            { const float keep = b4 ? t2[1] : t2[0], send = b4 ? t2[0] : t2[1]; t1 = keep + __shfl_xor(send, 16); }
            t1 += __shfl_xor(t1, 8); t1 += __shfl_xor(t1, 4); t1 += __shfl_xor(t1, 2); t1 += __shfl_xor(t1, 1);
            float ss[4];
#pragma unroll
            for (int h = 0; h < 4; ++h) ss[h] = 1.0f / sqrtf(__int_as_float(__builtin_amdgcn_readlane(__float_as_int(t1), 16 * (h & 1) + 32 * (h >> 1))) * (1.0f / HV) + HN_EPS);
            v2u* o8 = (v2u*)(A2 + (size_t)m * PK2) + lane;
#pragma unroll
            for (int i = 0; i < 8; ++i) { const v2u rwv = rw[q][i];
                const float r0 = bf_lo(rwv.x), r1 = bf_hi(rwv.x), r2 = bf_lo(rwv.y), r3 = bf_hi(rwv.y); const float sc = ss[i >> 1];
                const float y0 = v[i].x * sc * g4[i].x * (r0 / (1.f + __expf(-r0))), y1 = v[i].y * sc * g4[i].y * (r1 / (1.f + __expf(-r1))), y2 = v[i].z * sc * g4[i].z * (r2 / (1.f + __expf(-r2))), y3 = v[i].w * sc * g4[i].w * (r3 / (1.f + __expf(-r3)));
                v2u w; w.x = pk2(y0, y1); w.y = pk2(y2, y3); o8[64 * i] = w; } }
    }
}
__device__ __forceinline__ void gate_panel_and_wait(Frame& F, int pm, int pn, unsigned* cnt) {
    gate_rows(F, pm * 288 + pn * 36, 36);
    asm volatile("s_waitcnt vmcnt(0)" ::: "memory");
    __syncthreads();
    if (F.tid == 0) {
        __builtin_amdgcn_fence(__ATOMIC_RELEASE, "agent");
        asm volatile("s_waitcnt vmcnt(0)" ::: "memory");
        __hip_atomic_fetch_add(cnt + 64 * pm, 1u, RLX_AGENT);
        unsigned sp = 0u;
        while (__hip_atomic_load(cnt + 64 * pm, RLX_AGENT) < 8u) { __builtin_amdgcn_s_sleep(2); if (++sp > (1u << 22)) { __hip_atomic_store(F.ctl + CW_TMO, 1u, RLX_AGENT); break; } }
        __builtin_amdgcn_fence(__ATOMIC_ACQUIRE, "agent");
        asm volatile("s_waitcnt vmcnt(0)" ::: "memory");
    }
    __syncthreads();
}

__device__ __forceinline__ void ln_rows(Frame& F, const float* in, const float* gam, const float* bet, float* outf, bf16* outb) {
    const int gw = F.vcu * NWAVES + F.wave, NGW = F.G * NWAVES;
    for (int m = gw; m < M; m += NGW) {
        const f32x4* xr = (const f32x4*)(in + (size_t)m * DM) + F.lane;
        f32x4 v[8]; float s = 0.f;
#pragma unroll
        for (int i = 0; i < 8; ++i) { v[i] = xr[64 * i]; s += (v[i].x + v[i].y) + (v[i].z + v[i].w); }
        const float mean = wave_sum(s) * (1.f / DM); float s2 = 0.f;
#pragma unroll
        for (int i = 0; i < 8; ++i) { v[i] = v[i] - mean; s2 += (v[i].x * v[i].x + v[i].y * v[i].y) + (v[i].z * v[i].z + v[i].w * v[i].w); }
        const float rstd = 1.f / sqrtf(wave_sum(s2) * (1.f / DM) + LN_EPS);
#pragma unroll
        for (int i = 0; i < 8; ++i) { const f32x4 g4 = *((const f32x4*)gam + F.lane + 64 * i), b4 = *((const f32x4*)bet + F.lane + 64 * i); const f32x4 y = v[i] * rstd * g4 + b4;
            if (outf) *((f32x4*)(outf + (size_t)m * DM) + F.lane + 64 * i) = y;
            if (outb) { v2u w; w.x = pk2(y.x, y.y); w.y = pk2(y.z, y.w); *((v2u*)(outb + (size_t)m * DM) + F.lane + 64 * i) = w; } }
    }
}
__device__ __forceinline__ void p10_vln(Frame& F) {
    const int gw = F.vcu * NWAVES + F.wave, NGW = F.G * NWAVES;
    const bf16* Z = (const bf16*)(F.ws + WS_Z); bf16* VN = (bf16*)(F.ws + WS_VN); const float* gam = F.in[10]; const float* bet = F.in[11];
    for (int m = gw; m < M; m += NGW) {
        const v2u* zr = (const v2u*)(Z + (size_t)m * (2 * SGW) + SGW) + F.lane;
        f32x4 v[8]; float s = 0.f;
#pragma unroll
        for (int i = 0; i < 8; ++i) { const v2u w = zr[64 * i]; v[i] = (f32x4){bf_lo(w.x), bf_hi(w.x), bf_lo(w.y), bf_hi(w.y)}; s += (v[i].x + v[i].y) + (v[i].z + v[i].w); }
        const float mean = wave_sum(s) * (1.f / SGW); float s2 = 0.f;
#pragma unroll
        for (int i = 0; i < 8; ++i) { v[i] = v[i] - mean; s2 += (v[i].x * v[i].x + v[i].y * v[i].y) + (v[i].z * v[i].z + v[i].w * v[i].w); }
        const float rstd = 1.f / sqrtf(wave_sum(s2) * (1.f / SGW) + LN_EPS);
#pragma unroll
        for (int i = 0; i < 8; ++i) { const f32x4 g4 = *((const f32x4*)gam + F.lane + 64 * i), b4 = *((const f32x4*)bet + F.lane + 64 * i); const f32x4 y = v[i] * rstd * g4 + b4;
            if (m >= MP) *((f32x4*)(F.out + OUT_SGV + (size_t)(m - MP) * SGW) + F.lane + 64 * i) = y;
            v2u w; w.x = pk2(y.x, y.y); w.y = pk2(y.z, y.w); *((v2u*)(VN + (size_t)m * SGW) + F.lane + 64 * i) = w; }
    }
}

constexpr int MIX_PITCH = 272;
__device__ __forceinline__ void mix_prompt_item(Frame& F, int item, bool load_w) {
    const int g = item & 7, ci = item >> 3; const int R0 = ci * SGC;
    const bf16* Z = (const bf16*)(F.ws + WS_Z); const bf16* Wc = (const bf16*)(F.ws + WS_WC); bf16* A2 = (bf16*)(F.ws + WS_A2); const float* stat = (const float*)(F.ws + WS_STAT);
    LAS unsigned char* WL = F.lds;
    LAS unsigned char* VT = F.lds + 128 * MIX_PITCH;
    LAS float* RS = (LAS float*)(F.lds + 128 * MIX_PITCH + 256 * MIX_PITCH);
    const int s_lo = F.lane >> 3, ch_lo = F.lane & 7;
    float sm = 0.f, sq = 0.f; v4u wq[4];
    if (F.tid < SGC) { sm = stat[2 * (size_t)(R0 + F.tid)]; sq = stat[2 * (size_t)(R0 + F.tid) + 1]; }
    if (load_w) {
#pragma unroll
        for (int i = 0; i < 4; ++i) { const int idx = F.tid + NTHR * i, t = idx >> 4, ch = idx & 15; wq[i] = *(const v4u*)(Wc + ((size_t)(g * SGC + t)) * SGC + ch * 8); } }
    v4u vr[8];
#pragma unroll
    for (int i = 0; i < 8; ++i) { const int s = 8 * (F.wave + 8 * (i & 1)) + s_lo, ch = 8 * (i >> 1) + ch_lo;
        vr[i] = *(const v4u*)(Z + (size_t)(R0 + s) * (2 * SGW) + SGW + g * SGD + ch * 8); }
    __syncthreads();
    if (F.tid < SGC) { const float mean = sm * (1.f / SGW), var = fmaxf(sq * (1.f / SGW) - mean * mean, 0.f);
        RS[2 * F.tid] = mean; RS[2 * F.tid + 1] = 1.f / sqrtf(var + LN_EPS); }
    if (load_w) {
#pragma unroll
        for (int i = 0; i < 4; ++i) { const int idx = F.tid + NTHR * i, t = idx >> 4, ch = idx & 15; *(LAS v4u*)(WL + t * MIX_PITCH + ch * 16) = wq[i]; } }
    __syncthreads();
#pragma unroll
    for (int i = 0; i < 8; ++i) { const int sh = F.wave + 8 * (i & 1), s = 8 * sh + s_lo, ch = 8 * (i >> 1) + ch_lo; const v4u w = vr[i];
        const float mean = RS[2 * s], rstd = RS[2 * s + 1];
        const f32x4 ga = *(const f32x4*)(F.in[10] + g * SGD + ch * 8), gb = *(const f32x4*)(F.in[10] + g * SGD + ch * 8 + 4), ba = *(const f32x4*)(F.in[11] + g * SGD + ch * 8), bb = *(const f32x4*)(F.in[11] + g * SGD + ch * 8 + 4);
        LAS unsigned short* col = (LAS unsigned short*)(VT + (size_t)(8 * ch) * MIX_PITCH + 16 * (sh ^ ch_lo) + 2 * s_lo);
        col[0 * (MIX_PITCH / 2)] = (unsigned short)(pk2((bf_lo(w.x) - mean) * rstd * ga.x + ba.x, 0.f) & 0xffffu); col[1 * (MIX_PITCH / 2)] = (unsigned short)(pk2((bf_hi(w.x) - mean) * rstd * ga.y + ba.y, 0.f) & 0xffffu);
        col[2 * (MIX_PITCH / 2)] = (unsigned short)(pk2((bf_lo(w.y) - mean) * rstd * ga.z + ba.z, 0.f) & 0xffffu); col[3 * (MIX_PITCH / 2)] = (unsigned short)(pk2((bf_hi(w.y) - mean) * rstd * ga.w + ba.w, 0.f) & 0xffffu);
        col[4 * (MIX_PITCH / 2)] = (unsigned short)(pk2((bf_lo(w.z) - mean) * rstd * gb.x + bb.x, 0.f) & 0xffffu); col[5 * (MIX_PITCH / 2)] = (unsigned short)(pk2((bf_hi(w.z) - mean) * rstd * gb.y + bb.y, 0.f) & 0xffffu);
        col[6 * (MIX_PITCH / 2)] = (unsigned short)(pk2((bf_lo(w.w) - mean) * rstd * gb.z + bb.z, 0.f) & 0xffffu); col[7 * (MIX_PITCH / 2)] = (unsigned short)(pk2((bf_hi(w.w) - mean) * rstd * gb.w + bb.w, 0.f) & 0xffffu); }
    __syncthreads();
    const int dg = F.wave & 3, th = F.wave >> 2, fr = F.lane & 15, fq = F.lane >> 4;
    f32x4 acc[4][4];
#pragma unroll
    for (int a = 0; a < 4; ++a)
#pragma unroll
        for (int j = 0; j < 4; ++j) acc[a][j] = (f32x4){0.f, 0.f, 0.f, 0.f};
#pragma unroll
    for (int ks = 0; ks < 4; ++ks) {
        bf16x8 af[4];
#pragma unroll
        for (int j = 0; j < 4; ++j) { const int d = 64 * dg + 16 * (fr >> 2) + 4 * j + (fr & 3);
            af[j] = *(const LAS bf16x8*)(VT + (size_t)d * MIX_PITCH + 16 * ((4 * ks + fq) ^ ((d >> 3) & 7))); }
#pragma unroll
        for (int a = 0; a < 4; ++a) { const int tt = th + 2 * a; if (2 * ks > tt) continue;
            const bf16x8 bw = *(const LAS bf16x8*)(WL + (size_t)(16 * tt + fr) * MIX_PITCH + (32 * ks + 8 * fq) * 2);
#pragma unroll
            for (int j = 0; j < 4; ++j) acc[a][j] = __builtin_amdgcn_mfma_f32_16x16x32_bf16(af[j], bw, acc[a][j], 0, 0, 0); }
    }
    const float* bsp = F.in[13] + g * SGC;
#pragma unroll
    for (int a = 0; a < 4; ++a) { const int t = 16 * (th + 2 * a) + fr; const float bb = bsp[t]; const size_t row = (size_t)R0 + t; const int col = g * SGD + 64 * dg + 16 * fq;
        const v4u u0 = *(const v4u*)(Z + row * (2 * SGW) + col), u1 = *(const v4u*)(Z + row * (2 * SGW) + col + 8);
        const f32x4 m0 = acc[a][0] + bb, m1 = acc[a][1] + bb, m2 = acc[a][2] + bb, m3 = acc[a][3] + bb;
        v4u o0, o1;
        o0.x = pk2(bf_lo(u0.x) * m0.x, bf_hi(u0.x) * m0.y); o0.y = pk2(bf_lo(u0.y) * m0.z, bf_hi(u0.y) * m0.w);
        o0.z = pk2(bf_lo(u0.z) * m1.x, bf_hi(u0.z) * m1.y); o0.w = pk2(bf_lo(u0.w) * m1.z, bf_hi(u0.w) * m1.w);
        o1.x = pk2(bf_lo(u1.x) * m2.x, bf_hi(u1.x) * m2.y); o1.y = pk2(bf_lo(u1.y) * m2.z, bf_hi(u1.y) * m2.w);
        o1.z = pk2(bf_lo(u1.z) * m3.x, bf_hi(u1.z) * m3.y); o1.w = pk2(bf_lo(u1.w) * m3.z, bf_hi(u1.w) * m3.w);
        *(v4u*)(A2 + row * PK2 + col) = o0; *(v4u*)(A2 + row * PK2 + col + 8) = o1; }
}
#define MIX_LDS_BARRIER() do { asm volatile("s_waitcnt lgkmcnt(0)" ::: "memory"); __builtin_amdgcn_s_barrier(); asm volatile("" ::: "memory"); } while (0)
__device__ __forceinline__ void mix_load_v(Frame& F, const bf16* Z, int R0, int g, v4u (&vr)[8]) {
    const int s_lo = F.lane >> 3, ch_lo = F.lane & 7;
#pragma unroll
    for (int i = 0; i < 8; ++i) { const int s = 8 * (F.wave + 8 * (i & 1)) + s_lo, ch = 8 * (i >> 1) + ch_lo;
        vr[i] = *(const v4u*)(Z + (size_t)(R0 + s) * (2 * SGW) + SGW + g * SGD + ch * 8); }
}
__device__ __forceinline__ void mix_load_u(Frame& F, const bf16* Z, int R0, int g, v4u (&u)[4][2]) {
    const int dg = F.wave & 3, th = F.wave >> 2, fr = F.lane & 15, fq = F.lane >> 4;
#pragma unroll
    for (int a = 0; a < 4; ++a) { const size_t row = (size_t)R0 + 16 * (th + 2 * a) + fr; const int col = g * SGD + 64 * dg + 16 * fq;
        u[a][0] = *(const v4u*)(Z + row * (2 * SGW) + col); u[a][1] = *(const v4u*)(Z + row * (2 * SGW) + col + 8); }
}
__device__ __forceinline__ void mix_transpose(Frame& F, int g, const v4u (&vr)[8], LAS unsigned char* VT, LAS const float* RS) {
    const int s_lo = F.lane >> 3, ch_lo = F.lane & 7;
#pragma unroll
    for (int i = 0; i < 8; ++i) { const int sh = F.wave + 8 * (i & 1), s = 8 * sh + s_lo, ch = 8 * (i >> 1) + ch_lo; const v4u w = vr[i];
        const float mean = RS[2 * s], rstd = RS[2 * s + 1];
        const f32x4 ga = *(const f32x4*)(F.in[10] + g * SGD + ch * 8), gb = *(const f32x4*)(F.in[10] + g * SGD + ch * 8 + 4), ba = *(const f32x4*)(F.in[11] + g * SGD + ch * 8), bb = *(const f32x4*)(F.in[11] + g * SGD + ch * 8 + 4);
        LAS unsigned short* col = (LAS unsigned short*)(VT + (size_t)(8 * ch) * MIX_PITCH + 16 * (sh ^ ch_lo) + 2 * s_lo);
        col[0 * (MIX_PITCH / 2)] = (unsigned short)(pk2((bf_lo(w.x) - mean) * rstd * ga.x + ba.x, 0.f) & 0xffffu); col[1 * (MIX_PITCH / 2)] = (unsigned short)(pk2((bf_hi(w.x) - mean) * rstd * ga.y + ba.y, 0.f) & 0xffffu);
        col[2 * (MIX_PITCH / 2)] = (unsigned short)(pk2((bf_lo(w.y) - mean) * rstd * ga.z + ba.z, 0.f) & 0xffffu); col[3 * (MIX_PITCH / 2)] = (unsigned short)(pk2((bf_hi(w.y) - mean) * rstd * ga.w + ba.w, 0.f) & 0xffffu);
        col[4 * (MIX_PITCH / 2)] = (unsigned short)(pk2((bf_lo(w.z) - mean) * rstd * gb.x + bb.x, 0.f) & 0xffffu); col[5 * (MIX_PITCH / 2)] = (unsigned short)(pk2((bf_hi(w.z) - mean) * rstd * gb.y + bb.y, 0.f) & 0xffffu);
        col[6 * (MIX_PITCH / 2)] = (unsigned short)(pk2((bf_lo(w.w) - mean) * rstd * gb.z + bb.z, 0.f) & 0xffffu); col[7 * (MIX_PITCH / 2)] = (unsigned short)(pk2((bf_hi(w.w) - mean) * rstd * gb.w + bb.w, 0.f) & 0xffffu); }
}
__device__ __forceinline__ void mix_mma_epi(Frame& F, int R0, int g, const v4u (&u)[4][2], LAS const unsigned char* WL, LAS const unsigned char* VT) {
    bf16* A2 = (bf16*)(F.ws + WS_A2);
    const int dg = F.wave & 3, th = F.wave >> 2, fr = F.lane & 15, fq = F.lane >> 4;
    f32x4 acc[4][4];
#pragma unroll
    for (int a = 0; a < 4; ++a)
#pragma unroll
        for (int j = 0; j < 4; ++j) acc[a][j] = (f32x4){0.f, 0.f, 0.f, 0.f};
#pragma unroll
    for (int ks = 0; ks < 4; ++ks) {
        bf16x8 af[4];
#pragma unroll
        for (int j = 0; j < 4; ++j) { const int d = 64 * dg + 16 * (fr >> 2) + 4 * j + (fr & 3);
            af[j] = *(const LAS bf16x8*)(VT + (size_t)d * MIX_PITCH + 16 * ((4 * ks + fq) ^ ((d >> 3) & 7))); }
#pragma unroll
        for (int a = 0; a < 4; ++a) { const int tt = th + 2 * a; if (2 * ks > tt) continue;
            const bf16x8 bw = *(const LAS bf16x8*)(WL + (size_t)(16 * tt + fr) * MIX_PITCH + (32 * ks + 8 * fq) * 2);
#pragma unroll
            for (int j = 0; j < 4; ++j) acc[a][j] = __builtin_amdgcn_mfma_f32_16x16x32_bf16(af[j], bw, acc[a][j], 0, 0, 0); }
    }
    const float* bsp = F.in[13] + g * SGC;
#pragma unroll
    for (int a = 0; a < 4; ++a) { const int t = 16 * (th + 2 * a) + fr; const float bb = bsp[t]; const size_t row = (size_t)R0 + t; const int col = g * SGD + 64 * dg + 16 * fq;
        const v4u u0 = u[a][0], u1 = u[a][1];
        const f32x4 m0 = acc[a][0] + bb, m1 = acc[a][1] + bb, m2 = acc[a][2] + bb, m3 = acc[a][3] + bb;
        v4u o0, o1;
        o0.x = pk2(bf_lo(u0.x) * m0.x, bf_hi(u0.x) * m0.y); o0.y = pk2(bf_lo(u0.y) * m0.z, bf_hi(u0.y) * m0.w);
        o0.z = pk2(bf_lo(u0.z) * m1.x, bf_hi(u0.z) * m1.y); o0.w = pk2(bf_lo(u0.w) * m1.z, bf_hi(u0.w) * m1.w);
        o1.x = pk2(bf_lo(u1.x) * m2.x, bf_hi(u1.x) * m2.y); o1.y = pk2(bf_lo(u1.y) * m2.z, bf_hi(u1.y) * m2.w);
        o1.z = pk2(bf_lo(u1.z) * m3.x, bf_hi(u1.z) * m3.y); o1.w = pk2(bf_lo(u1.w) * m3.z, bf_hi(u1.w) * m3.w);
        *(v4u*)(A2 + row * PK2 + col) = o0; *(v4u*)(A2 + row * PK2 + col + 8) = o1; }
}
struct MixS { unsigned v[8], u[8]; float st, wv, bv; float2 gam, bet; };
__device__ __forceinline__ void mix_sample_load(Frame& F, int hi, MixS& S) {
    const int g = (hi >> 1) & 7, b = hi >> 4; const size_t r0 = (size_t)MP + (size_t)b * DT; const int col = g * SGD + 128 * (hi & 1) + 2 * F.lane;
    const bf16* Z = (const bf16*)(F.ws + WS_Z); const float* stat = (const float*)(F.ws + WS_STAT);
#pragma unroll
    for (int s = 0; s < 8; ++s) { S.v[s] = *(const unsigned*)(Z + (r0 + s) * (2 * SGW) + SGW + col); S.u[s] = *(const unsigned*)(Z + (r0 + s) * (2 * SGW) + col); }
    S.st = stat[2 * r0 + (F.lane & 15)];
    S.wv = F.in[12][(size_t)g * SGC * SGC + (F.lane >> 3) * SGC + (F.lane & 7)];
    S.bv = F.in[13][g * SGC + (F.lane & 7)];
    S.gam = *(const float2*)(F.in[10] + col); S.bet = *(const float2*)(F.in[11] + col);
}
#define MIX_RDL(x, l) __int_as_float(__builtin_amdgcn_readlane(__float_as_int(x), (l)))
__device__ __forceinline__ void mix_sample_compute(Frame& F, int hi, const MixS& S) {
    const int g = (hi >> 1) & 7, b = hi >> 4; const size_t r0 = (size_t)MP + (size_t)b * DT; const int col = g * SGD + 128 * (hi & 1) + 2 * F.lane;
    bf16* A2 = (bf16*)(F.ws + WS_A2);
    const float wr = bf2f((bf16)(pk2(S.wv, 0.f) & 0xffffu));
    float v0[8], v1[8];
#pragma unroll
    for (int s = 0; s < 8; ++s) { const float sm = MIX_RDL(S.st, 2 * s), sq = MIX_RDL(S.st, 2 * s + 1);
        const float mean = sm * (1.f / SGW), rstd = 1.f / sqrtf(fmaxf(sq * (1.f / SGW) - mean * mean, 0.f) + LN_EPS);
        const float y0 = (bf_lo(S.v[s]) - mean) * rstd * S.gam.x + S.bet.x, y1 = (bf_hi(S.v[s]) - mean) * rstd * S.gam.y + S.bet.y;
        *(float2*)(F.out + OUT_SGV + (size_t)(b * DT + s) * SGW + col) = make_float2(y0, y1);
        const unsigned rb = pk2(y0, y1); v0[s] = bf_lo(rb); v1[s] = bf_hi(rb); }
#pragma unroll
    for (int t = 0; t < 8; ++t) { float m0 = 0.f, m1 = 0.f;
#pragma unroll
        for (int s = 0; s < 8; ++s) if (s <= t) { const float w = MIX_RDL(wr, 8 * t + s); m0 += v0[s] * w; m1 += v1[s] * w; }
        const float bb = MIX_RDL(S.bv, t); m0 += bb; m1 += bb;
        *(unsigned*)(A2 + (r0 + t) * PK2 + col) = pk2(bf_lo(S.u[t]) * m0, bf_hi(S.u[t]) * m1); }
}
__device__ __forceinline__ void mix_prompt_pair(Frame& F, int itA, int itB) {
    const int g = itA & 7; const int R0A = (itA >> 3) * SGC, R0B = (itB >> 3) * SGC;
    const bf16* Z = (const bf16*)(F.ws + WS_Z); const bf16* Wc = (const bf16*)(F.ws + WS_WC); const float* stat = (const float*)(F.ws + WS_STAT);
    LAS unsigned char* WL = F.lds; LAS unsigned char* VT = F.lds + 128 * MIX_PITCH;
    LAS float* RS = (LAS float*)(F.lds + 128 * MIX_PITCH + 256 * MIX_PITCH);
    const int hi = F.vcu * NWAVES + F.wave;
    float sm = 0.f, sq = 0.f; v4u wq[4]; MixS S;
    mix_sample_load(F, hi, S);
    if (F.tid < 2 * SGC) { const size_t r = (F.tid < SGC) ? (size_t)(R0A + F.tid) : (size_t)(R0B + F.tid - SGC); sm = stat[2 * r]; sq = stat[2 * r + 1]; }
#pragma unroll
    for (int i = 0; i < 4; ++i) { const int idx = F.tid + NTHR * i, t = idx >> 4, ch = idx & 15; wq[i] = *(const v4u*)(Wc + ((size_t)(g * SGC + t)) * SGC + ch * 8); }
    v4u vA[8], vB[8], uA[4][2], uB[4][2];
    mix_load_v(F, Z, R0A, g, vA); mix_load_u(F, Z, R0A, g, uA); mix_load_v(F, Z, R0B, g, vB);
    mix_sample_compute(F, hi, S);
    MIX_LDS_BARRIER();
    if (F.tid < 2 * SGC) { const float mean = sm * (1.f / SGW), var = fmaxf(sq * (1.f / SGW) - mean * mean, 0.f);
        RS[2 * F.tid] = mean; RS[2 * F.tid + 1] = 1.f / sqrtf(var + LN_EPS); }
#pragma unroll
    for (int i = 0; i < 4; ++i) { const int idx = F.tid + NTHR * i, t = idx >> 4, ch = idx & 15; *(LAS v4u*)(WL + t * MIX_PITCH + ch * 16) = wq[i]; }
    MIX_LDS_BARRIER();
    mix_transpose(F, g, vA, VT, RS);
    mix_load_u(F, Z, R0B, g, uB);
    MIX_LDS_BARRIER();
    mix_mma_epi(F, R0A, g, uA, WL, VT);
    MIX_LDS_BARRIER();
    mix_transpose(F, g, vB, VT, RS + 2 * SGC);
    MIX_LDS_BARRIER();
    mix_mma_epi(F, R0B, g, uB, WL, VT);
}
__device__ __forceinline__ void p11_mix(Frame& F) {
    constexpr int NPI = (MP / SGC) * SGG, NSH = 2 * DB * SGG;
    if (2 * F.G == NPI && F.G * NWAVES == NSH) mix_prompt_pair(F, F.vcu, F.vcu + F.G);
    else {
        for (int it = F.vcu; it < NPI; it += F.G) mix_prompt_item(F, it, it == F.vcu || (F.G & 7) != 0);
        const int gw = F.vcu * NWAVES + F.wave, NGW = F.G * NWAVES;
        for (int hi = gw; hi < NSH; hi += NGW) { MixS S; mix_sample_load(F, hi, S); mix_sample_compute(F, hi, S); }
    }
    __syncthreads();
}

struct Args { const float* in[21]; float* out; unsigned char* ws; int ph_lo, ph_hi, coop, pad; };
__global__ void __launch_bounds__(NTHR, 2) fwd_kernel(Args args) {
    extern __shared__ __attribute__((aligned(16))) unsigned char lds[];
    Frame F;
    F.lds = (LAS unsigned char*)lds;
    F.MISC = (volatile LAS unsigned*)(F.lds + MISC_OFF);
    F.tid = threadIdx.x; F.lane = F.tid & 63; F.wave = __builtin_amdgcn_readfirstlane(F.tid >> 6);
    F.G = gridDim.x; { const int bx = blockIdx.x; F.vcu = (F.G % 8 == 0) ? (bx % 8) * (F.G / 8) + bx / 8 : bx; }
#pragma unroll
    for (int i = 0; i < 21; ++i) F.in[i] = args.in[i];
    F.out = args.out; F.ws = args.ws; F.ctl = (unsigned*)(args.ws + WS_CTL);
    if (F.tid < 64) F.MISC[F.tid] = 0u;
    __syncthreads();
    XcdBarrier bar; bar.bar = F.ctl + CW_BAR; bar.x = 0; bar.st = nullptr;
    if (args.coop) bar = xcd_barrier_post(F.ctl + CW_BAR, F.MISC + 8);
    unsigned char* ws = F.ws;
    bf16* XB = (bf16*)(ws + WS_XB); bf16* A2 = (bf16*)(ws + WS_A2); bf16* HB = (bf16*)(ws + WS_HB);
    LAS unsigned char* ring = F.lds;

    const int lo = args.ph_lo, hi = args.ph_hi;
#define IN(k) (lo <= (k) && (k) < hi)
#define AGAIN(k) (IN(k) && (((PROBE_MASK) >> (k)) & 1))
#define SEAM(k) do { if (IN(k) && IN((k) + 1)) xcd_barrier(bar); } while (0)
#define GEMM_LN_B(INST, Amat, Bmat, Kdim, GAM, BET, OUTF, OUTB) { pg9::Gemm g{Amat, Bmat, M, DM, Kdim, (Kdim) + 64, (Kdim) + 64}; pg9::Order S; S.init(M, DM, F.G, (int)blockIdx.x); \
        pg9::PanelStats st{(unsigned*)(ws + WS_XCH), F.ctl + CW_LN + (INST) * LN_BANK, F.ctl + CW_TMO, LN_EPS}; pg9::EpiLn E{XB, PK2, ALPHA, GAM, BET, OUTF, OUTB, PK2, st}; \
        pg9::gemm_phase<pg9::EpiLn, false>(ring, g, S, E); }
#define GEMM_LN(k, INST, Amat, Bmat, Kdim, GAM, BET, OUTF, OUTB) if (IN(k)) GEMM_LN_B(INST, Amat, Bmat, Kdim, GAM, BET, OUTF, OUTB) SEAM(k)
#define GEMM_UP_B(l) { pg9::Gemm g{XB, (const bf16*)(ws + WS_W1) + (size_t)(l) * DFF * PK2, M, DFF, DM, PK2, PK2}; pg9::Order S; S.init(M, DFF, F.G, (int)blockIdx.x); pg9::EpiBf16<2> E{HB, PK8, nullptr}; \
        pg9::gemm_phase<pg9::EpiBf16<2>>(ring, g, S, E); }
#define GEMM_UP(k, l) if (IN(k)) GEMM_UP_B(l) if (AGAIN(k)) GEMM_UP_B(l) SEAM(k)
#define GEMM_IN_B { pg9::Gemm g{XB, (const bf16*)(ws + WS_WIN), M, NQKV, DM, PK2, PK2}; pg9::Order S; S.init(M, NQKV, F.G, (int)blockIdx.x); pg9::EpiBf16<0> E{(bf16*)(ws + WS_PROJ), NPROJ, nullptr}; \
        pg9::gemm_phase<pg9::EpiBf16<0>>(ring, g, S, E); }
#define GEMM_SG_B { pg9::Gemm g{XB, (const bf16*)(ws + WS_SGIN), M, 2 * SGW, DM, PK2, PK2}; pg9::Order S; S.init(M, 2 * SGW, F.G, (int)blockIdx.x); pg9::EpiSg E{(bf16*)(ws + WS_Z), 2 * SGW, F.in[9], (float*)(ws + WS_STAT)}; \
        pg9::gemm_phase<pg9::EpiSg>(ring, g, S, E); }
    if (IN(0)) p0_prologue(F); if (AGAIN(0)) p0_prologue(F);
    SEAM(0);
    if (IN(1)) GEMM_IN_B if (AGAIN(1)) GEMM_IN_B
    SEAM(1);
    if (IN(2)) p2a_gla_prep(F);
    SEAM(2);
    if (IN(3)) p2_gla(F, 0); if (AGAIN(3)) p2_gla(F, 1);
    SEAM(3);
    if (IN(4) && F.G == 256) {
        const int c = (int)blockIdx.x, wgid = (c & 7) * 32 + (c >> 3), pm0 = (wgid >> 6) * 8 + (wgid & 7), pn0 = (wgid & 63) >> 3;
        gate_panel_and_wait(F, pm0, pn0, F.ctl + CW_GATE); }
    GEMM_LN(4, 0, A2, (const bf16*)(ws + WS_WOUT), DM, F.in[17], F.in[18], (float*)nullptr, XB);
    GEMM_UP(5, 0);
    GEMM_LN(6, 1, HB, (const bf16*)(ws + WS_W2), DFF, F.in[19], F.in[20], (float*)nullptr, XB);
    if (IN(7)) GEMM_SG_B
    SEAM(7);
    if (IN(8)) p11_mix(F); if (AGAIN(8)) p11_mix(F);
    SEAM(8);
    GEMM_LN(9, 2, A2, (const bf16*)(ws + WS_SGOUT), SGW, F.in[17] + DM, F.in[18] + DM, (float*)nullptr, XB);
    GEMM_UP(10, 1);
    GEMM_LN(11, 3, HB, (const bf16*)(ws + WS_W2) + (size_t)DM * PK8, DFF, F.in[19] + DM, F.in[20] + DM, F.out + OUT_Y, (bf16*)nullptr);
#undef IN
#undef AGAIN
#undef SEAM
}

extern "C" void kernel_launch(void* const* d_in, const int* in_sizes, int n_in, void* d_out, int out_size, void* d_ws, size_t ws_size, hipStream_t stream) {
    static int grid = 0;
    if (grid == 0) {
        if (n_in != 21 || (size_t)out_size != OUT_END || ws_size < WS_END) { fprintf(stderr, "kernel_launch: unexpected shapes: n_in %d out %d ws %zu (need %zu)\n", n_in, out_size, ws_size, (size_t)WS_END); grid = -1; return; }
        int dev = 0, cus = 0, per_cu = 0;
        if (hipGetDevice(&dev) != hipSuccess || hipDeviceGetAttribute(&cus, hipDeviceAttributeMultiprocessorCount, dev) != hipSuccess) { fprintf(stderr, "kernel_launch: device query failed\n"); grid = -1; return; }
        if (hipFuncSetAttribute((const void*)fwd_kernel, hipFuncAttributeMaxDynamicSharedMemorySize, LDS_BYTES) != hipSuccess) { fprintf(stderr, "kernel_launch: hipFuncSetAttribute failed\n"); grid = -1; return; }
        if (hipOccupancyMaxActiveBlocksPerMultiprocessor(&per_cu, (const void*)fwd_kernel, NTHR, LDS_BYTES) != hipSuccess || per_cu < 1) { fprintf(stderr, "kernel_launch: occupancy query says %d blocks per CU\n", per_cu); per_cu = 1; }
        (void)hipGetLastError();
        grid = cus * 1;
    }
    if (grid < 0) return;
    if (hipMemsetAsync((char*)d_ws + WS_CTL, 0, CTL_ZERO_BYTES, stream) != hipSuccess) { fprintf(stderr, "kernel_launch: memset failed\n"); return; }
    Args a{};
    for (int i = 0; i < 21; ++i) a.in[i] = (const float*)d_in[i];
    a.out = (float*)d_out; a.ws = (unsigned char*)d_ws;
    if (N_LAUNCHES == 1) {
        a.ph_lo = 0; a.ph_hi = NPHASE; a.coop = 1;
        void* kargs[] = {&a};
        hipError_t e = hipLaunchCooperativeKernel((const void*)fwd_kernel, dim3(grid), dim3(NTHR), kargs, LDS_BYTES, stream);
        if (e != hipSuccess) fprintf(stderr, "kernel_launch: cooperative launch failed: %s (grid %d)\n", hipGetErrorString(e), grid);
    } else {
        for (int ph = 0; ph < NPHASE; ++ph) {
            a.ph_lo = ph; a.ph_hi = ph + 1; a.coop = 0;
            hipLaunchKernelGGL(fwd_kernel, dim3(grid), dim3(NTHR), LDS_BYTES, stream, a);
            const hipError_t le = hipPeekAtLastError();
            if (le != hipSuccess) { fprintf(stderr, "kernel_launch: launch %d failed: %s\n", ph, hipGetErrorName(le)); break; }
        }
    }
}
```

```cpp
#include <hip/hip_runtime.h>
#include <hip/hip_cooperative_groups.h>
#include <cstdio>
#include <cstdint>
namespace cg = cooperative_groups;

#ifndef PROBE_MASK
#define PROBE_MASK 0
#endif
#ifndef MK_N_LAUNCHES
#define MK_N_LAUNCHES 1
#endif

namespace pg8 {
#define PG8_LAS __attribute__((address_space(3)))
typedef unsigned short bf16_t;
typedef short bf16x8 __attribute__((ext_vector_type(8)));
typedef float f32x4 __attribute__((ext_vector_type(4)));
typedef float f32x2 __attribute__((ext_vector_type(2)));
typedef unsigned u32x4 __attribute__((ext_vector_type(4)));
constexpr int BM = 256, BK = 64, HALF = 128, HTB = HALF * BK * 2, STAGE_BYTES = 8 * HTB, NXCD = 8, WGM = 8;

__host__ __device__ __forceinline__ int lds_byte(int r, int c) { const int st = (r >> 4) * 2 + (c >> 5), rr = r & 15, cc = c & 31, ob = rr * 64 + cc * 2; return st * 1024 + (ob ^ (((ob >> 9) & 1) << 5)); }
__host__ __device__ __forceinline__ void stage_rc(int b, int& R, int& C) { const int st = b / 1024, sb = b % 1024, swz = sb ^ (((sb >> 9) & 1) << 5); R = (st >> 1) * 16 + swz / 64; C = (st & 1) * 32 + (swz % 64) / 2; }
__host__ __device__ __forceinline__ int perm32(int rho) { const int n = rho >> 4, i = rho & 15; return 8 * (i >> 2) + 4 * n + (i & 3); }

struct Unit { int pm, pn; };
struct Gemm { const bf16_t* A; const bf16_t* Bt; int M, N, K; };

struct StaticOrder {
    int nM, nN, nwg, G, c;
    __host__ __device__ void init(int M, int N, int G_, int c_) { nM = M / BM; nN = N / BM; nwg = nM * nN; G = G_; c = c_; }
    __host__ __device__ bool next(int i, Unit& u) const {
        const long L = (long)i * G + c; if (L >= nwg) return false;
        int wgid = (int)L; { const int q = nwg / NXCD, r = nwg % NXCD, xcd = wgid % NXCD, off = wgid / NXCD; wgid = (xcd < r ? xcd * (q + 1) : r * (q + 1) + (xcd - r) * q) + off; }
        const int nig = WGM * nN, gid = wgid / nig, fm = gid * WGM, gsz = (nM - fm) < WGM ? (nM - fm) : WGM;
        u.pm = fm + ((wgid % nig) % gsz); u.pn = (wgid % nig) / gsz; return true;
    }
    __device__ __forceinline__ void a_ready(const Unit&) const {}
    __device__ __forceinline__ void done(const Unit&) const {}
};

__device__ __forceinline__ unsigned cvt_pk_bf16(float lo, float hi) { unsigned r; asm volatile("v_cvt_pk_bf16_f32 %0, %1, %2" : "=v"(r) : "v"(lo), "v"(hi)); return r; }
__device__ __forceinline__ f32x2 gelu_pk(f32x2 v) {
    const f32x2 av = __builtin_elementwise_abs(v), d = av * 0.2316418882f + 1.0f;
    f32x2 t; t.x = __builtin_amdgcn_rcpf(d.x); t.y = __builtin_amdgcn_rcpf(d.y);
    f32x2 q = t * 0.5307027145f + (-0.7265760135f); q = q * t + 0.7107068705f; q = q * t + (-0.142248368f); q = q * t + 0.127414796f; q = q * t;
    const f32x2 s = (v * v) * (-0.72134752044f);
    f32x2 e; e.x = __builtin_amdgcn_exp2f(s.x); e.y = __builtin_amdgcn_exp2f(s.y);
    const f32x2 m = v * (q * e), r = v - m;
    f32x2 o; o.x = v.x < 0.f ? m.x : r.x; o.y = v.y < 0.f ? m.y : r.y; return o;
}

template <int ACT  > struct EpiBf16 {
    static constexpr bool PERM = true, AFTER_DRAIN = false;
    bf16_t* O; int ldc; const float* bias;
    __device__ __forceinline__ void operator()(const f32x4 (&acc)[2][2][4][2], const Unit& u, int wr, int wc, int fr, int fq) const {
        const int row0 = u.pm * BM + wr * 64 + fr; const int col0 = u.pn * BM + wc * 32 + 8 * fq;
        f32x4 bv[2][2];
#pragma unroll
        for (int bj = 0; bj < 2; ++bj)
#pragma unroll
            for (int n = 0; n < 2; ++n) bv[bj][n] = (ACT == 1) ? *(const f32x4*)(bias + col0 + bj * HALF + 4 * n) : (f32x4){0.f, 0.f, 0.f, 0.f};
#pragma unroll
        for (int ai = 0; ai < 2; ++ai)
#pragma unroll
            for (int m = 0; m < 4; ++m) { bf16_t* rowp = O + (size_t)(row0 + ai * HALF + m * 16) * ldc + col0;
#pragma unroll
                for (int bj = 0; bj < 2; ++bj) { f32x4 v0 = acc[ai][bj][m][0] + bv[bj][0], v1 = acc[ai][bj][m][1] + bv[bj][1];
                    if (ACT == 1) { f32x2 a = gelu_pk((f32x2){v0[0], v0[1]}), b = gelu_pk((f32x2){v0[2], v0[3]}), c = gelu_pk((f32x2){v1[0], v1[1]}), d = gelu_pk((f32x2){v1[2], v1[3]});
                        v0 = (f32x4){a.x, a.y, b.x, b.y}; v1 = (f32x4){c.x, c.y, d.x, d.y}; }
                    if (ACT == 2) {
#pragma unroll
                        for (int j = 0; j < 4; ++j) { const float p = fmaxf(v0[j], 0.f), q = fmaxf(v1[j], 0.f); v0[j] = p * p; v1[j] = q * q; } }
                    u32x4 w; w.x = cvt_pk_bf16(v0[0], v0[1]); w.y = cvt_pk_bf16(v0[2], v0[3]); w.z = cvt_pk_bf16(v1[0], v1[1]); w.w = cvt_pk_bf16(v1[2], v1[3]);
                    *(u32x4*)(rowp + bj * HALF) = w; } }
    }
};
struct EpiRes {
    static constexpr bool PERM = false, AFTER_DRAIN = false;
    float* out; int ldc; const float* resA; const float* resB; int split; float alpha;
    __device__ __forceinline__ void operator()(const f32x4 (&acc)[2][2][4][2], const Unit& u, int wr, int wc, int fr, int fq) const {
        const int row0 = u.pm * BM + wr * 64 + fr, col0 = u.pn * BM + wc * 32 + 4 * fq;
#pragma unroll
        for (int ai = 0; ai < 2; ++ai)
#pragma unroll
            for (int m = 0; m < 4; ++m) { const int row = row0 + ai * HALF + m * 16;
                const float* rp = (row < split ? resA + (size_t)row * ldc : resB + (size_t)(row - split) * ldc) + col0; float* op = out + (size_t)row * ldc + col0;
#pragma unroll
                for (int bj = 0; bj < 2; ++bj)
#pragma unroll
                    for (int n = 0; n < 2; ++n) { const f32x4 rv = *(const f32x4*)(rp + bj * HALF + n * 16); *(f32x4*)(op + bj * HALF + n * 16) = acc[ai][bj][m][n] + rv * alpha; } }
    }
};

template <class Epi, class Sched, bool ALIGN_EPI = false, bool SP2 = false>
__device__ __forceinline__ void gemm_phase(PG8_LAS unsigned char* lds, const Gemm g, const Sched& S, const Epi& E) {
    const int tid = threadIdx.x, wid = __builtin_amdgcn_readfirstlane(tid >> 6), lane = tid & 63, wr = wid >> 2, wc = wid & 3, fr = lane & 15, fq = lane >> 4;
    const int K = g.K, nt = K / BK;
    unsigned voffA[2], voffB[2];
#pragma unroll
    for (int i = 0; i < 2; ++i) { int R, C; stage_rc(tid * 16 + i * 8192, R, C); const int Rb = Epi::PERM ? ((R & ~31) + perm32(R & 31)) : R;
        voffA[i] = (unsigned)(R * K + C) * 2u; voffB[i] = (unsigned)(Rb * K + C) * 2u; }
    const size_t kstep = (size_t)(BK * 2);
    const size_t hstep = (size_t)HALF * K * 2;
    const size_t tstep = 2 * hstep;
    const unsigned ldsw = (unsigned)wid * 1024u;
    const int aoff = lds_byte(wr * 64 + fr, fq * 8), boff = lds_byte(wc * 32 + fr, fq * 8);
#define PG8_SA(b, h) (((b) * 2 + (h)) * HTB)
#define PG8_SB(b, h) ((4 + (b) * 2 + (h)) * HTB)
#define PG8_STAGE(bufoff, gbase, voff) do { _Pragma("unroll") for (int _i = 0; _i < 2; ++_i) \
        __builtin_amdgcn_global_load_lds((const unsigned*)((const char*)(gbase) + (voff)[_i]), (PG8_LAS unsigned*)(lds + (bufoff) + ldsw + _i * 8192), 16, 0, 0); } while (0)
#define PG8_LDA(dst, b, h) do { _Pragma("unroll") for (int m = 0; m < 4; ++m) _Pragma("unroll") for (int k = 0; k < 2; ++k) dst[m][k] = *(const PG8_LAS bf16x8*)(lds + PG8_SA(b, h) + aoff + m * 2048 + k * 1024); } while (0)
#define PG8_LDB(dst, b, h) do { _Pragma("unroll") for (int n = 0; n < 2; ++n) _Pragma("unroll") for (int k = 0; k < 2; ++k) dst[n][k] = *(const PG8_LAS bf16x8*)(lds + PG8_SB(b, h) + boff + n * 2048 + k * 1024); } while (0)
#define PG8_MMA(ai, bj, At, Bt) do { __builtin_amdgcn_s_setprio(1); _Pragma("unroll") for (int m = 0; m < 4; ++m) _Pragma("unroll") for (int n = 0; n < 2; ++n) _Pragma("unroll") for (int k = 0; k < 2; ++k) \
        acc[ai][bj][m][n] = __builtin_amdgcn_mfma_f32_16x16x32_bf16(Bt[n][k], At[m][k], acc[ai][bj][m][n], 0, 0, 0); __builtin_amdgcn_s_setprio(0); } while (0)
#define PG8_WAIT_V(n) asm volatile("s_waitcnt vmcnt(" #n ")" ::: "memory")
#define PG8_WAIT_L(n) asm volatile("s_waitcnt lgkmcnt(" #n ")" ::: "memory")
#define PG8_BAR __builtin_amdgcn_s_barrier()
#define PG8_SCHED __builtin_amdgcn_sched_barrier(0)
    Unit cur, nxt; int ui = 0;
    if (!S.next(0, cur)) return;
    f32x4 acc[2][2][4][2];
#pragma unroll
    for (int a = 0; a < 2; ++a)
#pragma unroll
        for (int b = 0; b < 2; ++b)
#pragma unroll
            for (int m = 0; m < 4; ++m)
#pragma unroll
                for (int n = 0; n < 2; ++n) acc[a][b][m][n] = (f32x4){0.f, 0.f, 0.f, 0.f};
    bf16x8 At[4][2], B0[2][2], B1[2][2];
    const char* cA = (const char*)g.A + (size_t)cur.pm * tstep; const char* cB = (const char*)g.Bt + (size_t)cur.pn * tstep;
    S.a_ready(cur);
    if constexpr (SP2) {
        PG8_STAGE(PG8_SB(0, 0), cB, voffB); PG8_STAGE(PG8_SB(0, 1), cB + hstep, voffB); PG8_STAGE(PG8_SA(0, 0), cA, voffA); PG8_STAGE(PG8_SA(0, 1), cA + hstep, voffA);
        if (wr == 1) PG8_BAR;
        PG8_WAIT_V(2); PG8_BAR;
        PG8_STAGE(PG8_SB(1, 0), cB + kstep, voffB); PG8_STAGE(PG8_SA(1, 0), cA + kstep, voffA); PG8_STAGE(PG8_SB(1, 1), cB + hstep + kstep, voffB);
        PG8_WAIT_V(6); PG8_BAR;
    } else {
        PG8_STAGE(PG8_SB(0, 0), cB, voffB); PG8_STAGE(PG8_SA(0, 0), cA, voffA); PG8_STAGE(PG8_SB(0, 1), cB + hstep, voffB); PG8_STAGE(PG8_SA(0, 1), cA + hstep, voffA);
        if (wr == 1) PG8_BAR;
        PG8_WAIT_V(4); PG8_BAR;
        PG8_STAGE(PG8_SB(1, 0), cB + kstep, voffB); PG8_STAGE(PG8_SA(1, 0), cA + kstep, voffA); PG8_STAGE(PG8_SB(1, 1), cB + hstep + kstep, voffB);
        PG8_WAIT_V(6); PG8_BAR;
    }
    for (;;) {
        const bool has_next = S.next(ui + 1, nxt);
        const char* nA = has_next ? (const char*)g.A + (size_t)nxt.pm * tstep : cA; const char* nB = has_next ? (const char*)g.Bt + (size_t)nxt.pn * tstep : cB;
        for (int t = 0; t < nt; t += 2) {
            const bool last = (t == nt - 2);
            const char* a1 = cA + (size_t)(t + 1) * kstep;
            const char* a2 = last ? nA : cA + (size_t)(t + 2) * kstep; const char* b2 = last ? nB : cB + (size_t)(t + 2) * kstep;
            const char* a3 = a2 + kstep; const char* b3 = b2 + kstep;
            if (last && has_next) S.a_ready(nxt);
            if constexpr (SP2) {
            PG8_LDB(B0, 0, 0); PG8_LDB(B1, 0, 1); PG8_SCHED; PG8_LDA(At, 0, 0); PG8_STAGE(PG8_SA(1, 1), a1 + hstep, voffA);
            PG8_WAIT_V(8); PG8_WAIT_L(0); PG8_BAR; PG8_MMA(0, 0, At, B0); PG8_MMA(0, 1, At, B1); PG8_BAR; PG8_SCHED;
            PG8_LDA(At, 0, 1); PG8_STAGE(PG8_SB(0, 0), b2, voffB); PG8_STAGE(PG8_SB(0, 1), b2 + hstep, voffB); PG8_STAGE(PG8_SA(0, 0), a2, voffA);
            PG8_WAIT_V(8); PG8_WAIT_L(0); PG8_BAR; PG8_MMA(1, 0, At, B0); PG8_MMA(1, 1, At, B1); PG8_BAR; PG8_SCHED;
            PG8_LDB(B0, 1, 0); PG8_LDB(B1, 1, 1); PG8_SCHED; PG8_LDA(At, 1, 0); PG8_STAGE(PG8_SA(0, 1), a2 + hstep, voffA);
            PG8_WAIT_V(8); PG8_WAIT_L(0); PG8_BAR; PG8_MMA(0, 0, At, B0); PG8_MMA(0, 1, At, B1); PG8_BAR; PG8_SCHED;
            PG8_LDA(At, 1, 1); PG8_STAGE(PG8_SB(1, 0), b3, voffB); PG8_STAGE(PG8_SB(1, 1), b3 + hstep, voffB); PG8_STAGE(PG8_SA(1, 0), a3, voffA);
            PG8_WAIT_V(8); PG8_WAIT_L(0); PG8_BAR; PG8_MMA(1, 0, At, B0); PG8_MMA(1, 1, At, B1); PG8_BAR; PG8_SCHED;
            } else {
            PG8_LDB(B0, 0, 0); PG8_SCHED; PG8_LDA(At, 0, 0); PG8_STAGE(PG8_SA(1, 1), a1 + hstep, voffA);
            PG8_WAIT_L(8); PG8_BAR; PG8_WAIT_L(0); PG8_MMA(0, 0, At, B0); PG8_BAR; PG8_SCHED;
            PG8_LDB(B1, 0, 1); PG8_STAGE(PG8_SB(0, 0), b2, voffB);
            PG8_BAR; PG8_WAIT_L(0); PG8_MMA(0, 1, At, B1); PG8_BAR;
            PG8_LDA(At, 0, 1); PG8_STAGE(PG8_SA(0, 0), a2, voffA);
            PG8_BAR; PG8_WAIT_L(0); PG8_MMA(1, 0, At, B0); PG8_BAR; PG8_SCHED;
            PG8_STAGE(PG8_SB(0, 1), b2 + hstep, voffB);
            PG8_WAIT_V(6); PG8_BAR; PG8_MMA(1, 1, At, B1); PG8_BAR;
            PG8_LDB(B0, 1, 0); PG8_SCHED; PG8_LDA(At, 1, 0); PG8_STAGE(PG8_SA(0, 1), a2 + hstep, voffA);
            PG8_WAIT_L(8); PG8_BAR; PG8_WAIT_L(0); PG8_MMA(0, 0, At, B0); PG8_BAR; PG8_SCHED;
            PG8_LDB(B1, 1, 1); PG8_STAGE(PG8_SB(1, 0), b3, voffB);
            PG8_BAR; PG8_WAIT_L(0); PG8_MMA(0, 1, At, B1); PG8_BAR;
            PG8_LDA(At, 1, 1); PG8_STAGE(PG8_SA(1, 0), a3, voffA);
            PG8_BAR; PG8_WAIT_L(0); PG8_MMA(1, 0, At, B0); PG8_BAR; PG8_SCHED;
            PG8_STAGE(PG8_SB(1, 1), b3 + hstep, voffB);
            PG8_WAIT_V(6); PG8_BAR; PG8_MMA(1, 1, At, B1); PG8_BAR;
            }
        }
        if constexpr (ALIGN_EPI) { if (wr == 0) PG8_BAR; }
        E(acc, cur, wr, wc, fr, fq); S.done(cur);
        if (!has_next) break;
#pragma unroll
        for (int a = 0; a < 2; ++a)
#pragma unroll
            for (int b = 0; b < 2; ++b)
#pragma unroll
                for (int m = 0; m < 4; ++m)
#pragma unroll
                    for (int n = 0; n < 2; ++n) acc[a][b][m][n] = (f32x4){0.f, 0.f, 0.f, 0.f};
        cur = nxt; cA = nA; cB = nB; ++ui;
        if constexpr (ALIGN_EPI) { if (wr == 1) PG8_BAR; }
    }
    PG8_WAIT_V(0);
    if constexpr (!ALIGN_EPI) { if (wr == 0) PG8_BAR; }
    PG8_BAR;
#undef PG8_SA
#undef PG8_SB
#undef PG8_STAGE
#undef PG8_LDA
#undef PG8_LDB
#undef PG8_MMA
#undef PG8_WAIT_V
#undef PG8_WAIT_L
#undef PG8_BAR
#undef PG8_SCHED
}
}

namespace pg9 {
using pg8::bf16_t; using pg8::bf16x8; using pg8::f32x4; using pg8::f32x2; using pg8::u32x4; using pg8::stage_rc; using pg8::lds_byte; using pg8::perm32; using pg8::cvt_pk_bf16; using pg8::gelu_pk;
constexpr int BMR = 288, BNC = 256, BK = 64, THIRD = 96, HALF = 128, ATB = THIRD * BK * 2, BHB = HALF * BK * 2, NXCD = 8, WGM = 8;
constexpr int STAGE_BYTES = 6 * ATB + 4 * BHB;
__device__ __forceinline__ void st16_wt(void* p, u32x4 v) { asm volatile("global_store_dwordx4 %0, %1, off sc1\n\ts_nop 2" :: "v"(p), "v"(v) : "memory"); }
struct Unit { int pm, pn; };
struct Gemm { const bf16_t* A; const bf16_t* Bt; int M, N, K, lda, ldb; };
struct Order {
    int nM, nN, nwg, G, c;
    __host__ __device__ void init(int M, int N, int G_, int c_) { nM = M / BMR; nN = N / BNC; nwg = nM * nN; G = G_; c = c_; }
    __host__ __device__ bool next(int i, Unit& u) const {
        const long L = (long)i * G + c; if (L >= nwg) return false;
        int wgid = (int)L; { const int q = nwg / NXCD, r = nwg % NXCD, xcd = wgid % NXCD, off = wgid / NXCD; wgid = (xcd < r ? xcd * (q + 1) : r * (q + 1) + (xcd - r) * q) + off; }
        const int nig = WGM * nN, gid = wgid / nig, fm = gid * WGM, gsz = (nM - fm) < WGM ? (nM - fm) : WGM;
        u.pm = fm + ((wgid % nig) % gsz); u.pn = (wgid % nig) / gsz; return true;
    }
};
template <int ACT  > struct EpiBf16 {
    static constexpr bool PERM = true, AFTER_DRAIN = false, INIT_ACC = false;
    bf16_t* O; int ldc; const float* bias;
    __device__ __forceinline__ void operator()(const f32x4 (&acc)[3][2][3][2], const Unit& u, int wr, int wc, int fr, int fq) const {
        const int row0 = u.pm * BMR + wr * 48 + fr; const int col0 = u.pn * BNC + wc * 32 + 8 * fq;
        f32x4 bv[2][2];
#pragma unroll
        for (int bj = 0; bj < 2; ++bj)
#pragma unroll
            for (int n = 0; n < 2; ++n) bv[bj][n] = (ACT == 1) ? *(const f32x4*)(bias + col0 + bj * HALF + 4 * n) : (f32x4){0.f, 0.f, 0.f, 0.f};
#pragma unroll
        for (int ai = 0; ai < 3; ++ai)
#pragma unroll
            for (int m = 0; m < 3; ++m) { bf16_t* rowp = O + (size_t)(row0 + ai * THIRD + m * 16) * ldc + col0;
#pragma unroll
                for (int bj = 0; bj < 2; ++bj) { f32x4 v0 = acc[ai][bj][m][0] + bv[bj][0], v1 = acc[ai][bj][m][1] + bv[bj][1];
                    if (ACT == 1) { f32x2 a = gelu_pk((f32x2){v0[0], v0[1]}), b = gelu_pk((f32x2){v0[2], v0[3]}), c = gelu_pk((f32x2){v1[0], v1[1]}), d = gelu_pk((f32x2){v1[2], v1[3]});
                        v0 = (f32x4){a.x, a.y, b.x, b.y}; v1 = (f32x4){c.x, c.y, d.x, d.y}; }
                    if (ACT == 2) {
#pragma unroll
                        for (int j = 0; j < 4; ++j) { const float p = fmaxf(v0[j], 0.f), q = fmaxf(v1[j], 0.f); v0[j] = p * p; v1[j] = q * q; } }
                    u32x4 w; w.x = cvt_pk_bf16(v0[0], v0[1]); w.y = cvt_pk_bf16(v0[2], v0[3]); w.z = cvt_pk_bf16(v1[0], v1[1]); w.w = cvt_pk_bf16(v1[2], v1[3]);
                    st16_wt(rowp + bj * HALF, w); } }
    }
};
struct EpiRes {
    static constexpr bool PERM = false, AFTER_DRAIN = false, INIT_ACC = false;
    float* out; int ldc; const float* resA; const float* resB; int split; float alpha;
    __device__ __forceinline__ void operator()(const f32x4 (&acc)[3][2][3][2], const Unit& u, int wr, int wc, int fr, int fq) const {
        const int row0 = u.pm * BMR + wr * 48 + fr, col0 = u.pn * BNC + wc * 32 + 4 * fq;
#pragma unroll
        for (int ai = 0; ai < 3; ++ai)
#pragma unroll
            for (int m = 0; m < 3; ++m) { const int row = row0 + ai * THIRD + m * 16;
                const float* rp = (row < split ? resA + (size_t)row * ldc : resB + (size_t)(row - split) * ldc) + col0; float* op = out + (size_t)row * ldc + col0;
#pragma unroll
                for (int bj = 0; bj < 2; ++bj)
#pragma unroll
                    for (int n = 0; n < 2; ++n) { const f32x4 rv = *(const f32x4*)(rp + bj * HALF + n * 16); *(f32x4*)(op + bj * HALF + n * 16) = acc[ai][bj][m][n] + rv * alpha; } }
    }
};

struct EpiSg {
    static constexpr bool PERM = true, AFTER_DRAIN = false, INIT_ACC = false;
    bf16_t* O; int ldc; const float* bias; float* stat;
    __device__ __forceinline__ void operator()(const f32x4 (&acc)[3][2][3][2], const Unit& u, int wr, int wc, int fr, int fq) const {
        const int row0 = u.pm * BMR + wr * 48 + fr; const int col0 = u.pn * BNC + wc * 32 + 8 * fq;
        f32x4 bv[2][2];
#pragma unroll
        for (int bj = 0; bj < 2; ++bj)
#pragma unroll
            for (int n = 0; n < 2; ++n) bv[bj][n] = *(const f32x4*)(bias + col0 + bj * HALF + 4 * n);
        const bool vhalf = u.pn >= 8;
#pragma unroll
        for (int ai = 0; ai < 3; ++ai)
#pragma unroll
            for (int m = 0; m < 3; ++m) { const int row = row0 + ai * THIRD + m * 16; bf16_t* rowp = O + (size_t)row * ldc + col0; float s = 0.f, q = 0.f;
#pragma unroll
                for (int bj = 0; bj < 2; ++bj) { f32x4 v0 = acc[ai][bj][m][0] + bv[bj][0], v1 = acc[ai][bj][m][1] + bv[bj][1];
                    { f32x2 a = gelu_pk((f32x2){v0[0], v0[1]}), b = gelu_pk((f32x2){v0[2], v0[3]}), c = gelu_pk((f32x2){v1[0], v1[1]}), d = gelu_pk((f32x2){v1[2], v1[3]});
                        v0 = (f32x4){a.x, a.y, b.x, b.y}; v1 = (f32x4){c.x, c.y, d.x, d.y}; }
                    s += ((v0[0] + v0[1]) + (v0[2] + v0[3])) + ((v1[0] + v1[1]) + (v1[2] + v1[3]));
                    q += ((v0[0] * v0[0] + v0[1] * v0[1]) + (v0[2] * v0[2] + v0[3] * v0[3])) + ((v1[0] * v1[0] + v1[1] * v1[1]) + (v1[2] * v1[2] + v1[3] * v1[3]));
                    u32x4 w; w.x = cvt_pk_bf16(v0[0], v0[1]); w.y = cvt_pk_bf16(v0[2], v0[3]); w.z = cvt_pk_bf16(v1[0], v1[1]); w.w = cvt_pk_bf16(v1[2], v1[3]);
                    st16_wt(rowp + bj * HALF, w); }
                if (vhalf) { s += __shfl_xor(s, 16); s += __shfl_xor(s, 32); q += __shfl_xor(q, 16); q += __shfl_xor(q, 32);
                    if (fq == 0) { (void)__hip_atomic_fetch_add(stat + 2 * (size_t)row, s, __ATOMIC_RELAXED, __HIP_MEMORY_SCOPE_AGENT); (void)__hip_atomic_fetch_add(stat + 2 * (size_t)row + 1, q, __ATOMIC_RELAXED, __HIP_MEMORY_SCOPE_AGENT); } } }
    }
};

struct PanelStats {
    unsigned* xbuf; unsigned* cnt; unsigned* tmo; float eps;
    __device__ __forceinline__ void run(const f32x4 (&v)[3][2][3][2], const Unit& u, int wr, int wc, int fr, int fq, PG8_LAS unsigned char* lds, int wid, int lane) const {
        PG8_LAS f32x2* P = (PG8_LAS f32x2*)lds;
        PG8_LAS f32x2* St = (PG8_LAS f32x2*)(lds + 9216);
#pragma unroll
        for (int ai = 0; ai < 3; ++ai)
#pragma unroll
            for (int m = 0; m < 3; ++m) {
                float s = 0.f;
#pragma unroll
                for (int bj = 0; bj < 2; ++bj)
#pragma unroll
                    for (int n = 0; n < 2; ++n) { const f32x4 x = v[ai][bj][m][n]; s += (x[0] + x[1]) + (x[2] + x[3]); }
                s += __shfl_xor(s, 16); s += __shfl_xor(s, 32);
                const float mw = s * (1.0f / 64.0f); float q = 0.f;
#pragma unroll
                for (int bj = 0; bj < 2; ++bj)
#pragma unroll
                    for (int n = 0; n < 2; ++n) { const f32x4 d = v[ai][bj][m][n] - mw; q += (d[0] * d[0] + d[1] * d[1]) + (d[2] * d[2] + d[3] * d[3]); }
                q += __shfl_xor(q, 16); q += __shfl_xor(q, 32);
                if (fq == 0) P[(ai * THIRD + wr * 48 + m * 16 + fr) * 4 + wc] = (f32x2){mw, q};
            }
        asm volatile("s_waitcnt lgkmcnt(0)" ::: "memory"); __builtin_amdgcn_s_barrier(); asm volatile("" ::: "memory");
        const int row = wid * 64 + lane;
        if (row < BMR) {
            const f32x2 a = P[row * 4 + 0], b = P[row * 4 + 1], c = P[row * 4 + 2], d = P[row * 4 + 3];
            const float mt = (a.x + b.x + c.x + d.x) * 0.25f;
            const float da = a.x - mt, db = b.x - mt, dc = c.x - mt, dd = d.x - mt;
            const float m2 = (a.y + b.y) + (c.y + d.y) + 64.0f * ((da * da + db * db) + (dc * dc + dd * dd));
            unsigned long long* slot = (unsigned long long*)xbuf + ((size_t)(u.pm * BMR + row) * 8 + u.pn);
            __hip_atomic_store(slot, ((unsigned long long)__float_as_uint(m2) << 32) | __float_as_uint(mt), __ATOMIC_RELAXED, __HIP_MEMORY_SCOPE_AGENT);
        }
        asm volatile("s_waitcnt vmcnt(0)" ::: "memory");
        if (lane == 0) __hip_atomic_fetch_add(cnt + 64 * u.pm, 1u, __ATOMIC_RELAXED, __HIP_MEMORY_SCOPE_AGENT);
        if (wid == 0) {
            unsigned sp = 0u;
            for (;;) {
                if ((unsigned)__builtin_amdgcn_readfirstlane(__hip_atomic_load(cnt + 64 * u.pm, __ATOMIC_RELAXED, __HIP_MEMORY_SCOPE_AGENT)) >= 64u) break;
                __builtin_amdgcn_s_sleep(2);
                if (++sp > (1u << 22)) { if (lane == 0) __hip_atomic_store(tmo, 1u, __ATOMIC_RELAXED, __HIP_MEMORY_SCOPE_AGENT); break; }
            }
            __builtin_amdgcn_fence(__ATOMIC_ACQUIRE, "agent");
        }
        asm volatile("s_waitcnt vmcnt(0) lgkmcnt(0)" ::: "memory"); __builtin_amdgcn_s_barrier(); asm volatile("" ::: "memory");
        if (row < BMR) {
            const unsigned long long* slot = (const unsigned long long*)xbuf + (size_t)(u.pm * BMR + row) * 8; float mt[8], m2[8]; float ms = 0.f;
#pragma unroll
            for (int t = 0; t < 8; ++t) { const unsigned long long w = __hip_atomic_load(slot + t, __ATOMIC_RELAXED, __HIP_MEMORY_SCOPE_AGENT); mt[t] = __uint_as_float((unsigned)w); m2[t] = __uint_as_float((unsigned)(w >> 32)); ms += mt[t]; }
            const float mean = ms * 0.125f; float q = 0.f;
#pragma unroll
            for (int t = 0; t < 8; ++t) { const float dm = mt[t] - mean; q += m2[t] + 256.0f * dm * dm; }
            St[row] = (f32x2){mean, 1.0f / sqrtf(q * (1.0f / 2048.0f) + eps)};
        }
        asm volatile("s_waitcnt lgkmcnt(0)" ::: "memory"); __builtin_amdgcn_s_barrier(); asm volatile("" ::: "memory");
    }
};
struct EpiLn {
    static constexpr bool PERM = true, AFTER_DRAIN = true, INIT_ACC = true;
    const bf16_t* res; int ldr; float alpha;
    const float* gam; const float* bet; float* outf; bf16_t* outb; int ldb16;
    PanelStats st;
    __device__ __forceinline__ void init_load(u32x4 (&rw)[3][3][2], const Unit& u, int wr, int wc, int fr, int fq) const {
        const int row0 = u.pm * BMR + wr * 48 + fr, col0 = u.pn * BNC + wc * 32 + 8 * fq;
#pragma unroll
        for (int ai = 0; ai < 3; ++ai)
#pragma unroll
            for (int m = 0; m < 3; ++m)
#pragma unroll
                for (int bj = 0; bj < 2; ++bj) rw[ai][m][bj] = *(const u32x4*)(res + (size_t)(row0 + ai * THIRD + m * 16) * ldr + col0 + bj * HALF);
    }
    __device__ __forceinline__ void init_acc(f32x4 (&acc)[3][2][3][2], const u32x4 (&rw)[3][3][2]) const {
#pragma unroll
        for (int ai = 0; ai < 3; ++ai)
#pragma unroll
            for (int m = 0; m < 3; ++m)
#pragma unroll
                for (int bj = 0; bj < 2; ++bj) { const u32x4 w = rw[ai][m][bj];
                    acc[ai][bj][m][0] = (f32x4){__uint_as_float(w.x << 16), __uint_as_float(w.x & 0xffff0000u), __uint_as_float(w.y << 16), __uint_as_float(w.y & 0xffff0000u)} * alpha;
                    acc[ai][bj][m][1] = (f32x4){__uint_as_float(w.z << 16), __uint_as_float(w.z & 0xffff0000u), __uint_as_float(w.w << 16), __uint_as_float(w.w & 0xffff0000u)} * alpha; }
    }
    __device__ __forceinline__ void fused(f32x4 (&acc)[3][2][3][2], const Unit& u, int wr, int wc, int fr, int fq, PG8_LAS unsigned char* lds, int wid, int lane) const {
        const PG8_LAS f32x2* St = (const PG8_LAS f32x2*)(lds + 9216);
        const int row0 = u.pm * BMR + wr * 48 + fr, col0 = u.pn * BNC + wc * 32 + 8 * fq;
        st.run(acc, u, wr, wc, fr, fq, lds, wid, lane);
#pragma unroll
        for (int bj = 0; bj < 2; ++bj) {
            const f32x4 g0 = *(const f32x4*)(gam + col0 + bj * HALF), g1 = *(const f32x4*)(gam + col0 + bj * HALF + 4), b0 = *(const f32x4*)(bet + col0 + bj * HALF), b1 = *(const f32x4*)(bet + col0 + bj * HALF + 4);
#pragma unroll
            for (int ai = 0; ai < 3; ++ai)
#pragma unroll
                for (int m = 0; m < 3; ++m) { const int rl = ai * THIRD + wr * 48 + m * 16 + fr; const f32x2 sr = St[rl]; const size_t off = (size_t)(u.pm * BMR + rl) * 2048 + col0 + bj * HALF;
                    const f32x4 y0 = (acc[ai][bj][m][0] - sr.x) * sr.y * g0 + b0, y1 = (acc[ai][bj][m][1] - sr.x) * sr.y * g1 + b1;
                    if (outf) { *(f32x4*)(outf + off) = y0; *(f32x4*)(outf + off + 4) = y1; }
                    if (outb) { u32x4 w; w.x = cvt_pk_bf16(y0[0], y0[1]); w.y = cvt_pk_bf16(y0[2], y0[3]); w.z = cvt_pk_bf16(y1[0], y1[1]); w.w = cvt_pk_bf16(y1[2], y1[3]); st16_wt(outb + (size_t)(u.pm * BMR + rl) * ldb16 + col0 + bj * HALF, w); }
                    asm volatile("" ::: "memory"); }
        }
    }
};

struct ListOrder { int first, stride, total, nM;
    __host__ __device__ bool next(int i, Unit& u) const { const int id = first + i * stride; if (id >= total) return false; u.pm = id % nM; u.pn = id / nM; return true; } };

template <class Epi, bool ALIGN_EPI = true, class Sched = Order>
__device__ __forceinline__ void gemm_phase(PG8_LAS unsigned char* lds, const Gemm g, const Sched& S, const Epi& E) {
    const int tid = threadIdx.x, wid = __builtin_amdgcn_readfirstlane(tid >> 6), lane = tid & 63, wr = wid >> 2, wc = wid & 3, fr = lane & 15, fq = lane >> 4;
    const int K = g.K, nt = K / BK;
    const int lda = g.lda, ldb = g.ldb;
    unsigned voffA0, voffA1, voffB[2];
    { int R, C; stage_rc((wid & 3) * 1024 + lane * 16, R, C); voffA0 = (unsigned)(R * lda + C) * 2u; stage_rc((wid + 4) * 1024 + lane * 16, R, C); voffA1 = (unsigned)(R * lda + C) * 2u; }
#pragma unroll
    for (int i = 0; i < 2; ++i) { int R, C; stage_rc(tid * 16 + i * 8192, R, C); const int Rb = Epi::PERM ? ((R & ~31) + perm32(R & 31)) : R; voffB[i] = (unsigned)(Rb * ldb + C) * 2u; }
    const size_t kstep = (size_t)(BK * 2);
    const size_t thstep = (size_t)THIRD * lda * 2, hstep = (size_t)HALF * ldb * 2;
    const size_t tstepA = 3 * thstep, tstepB = 2 * hstep;
    const unsigned ldsw = (unsigned)wid * 1024u;
    const int aoff = lds_byte(wr * 48 + fr, fq * 8), boff = lds_byte(wc * 32 + fr, fq * 8);
#define PG9_SA(b, a) (((b) * 3 + (a)) * ATB)
#define PG9_SB(b, h) (6 * ATB + ((b) * 2 + (h)) * BHB)
#define PG9_GLDS(gp, lp) __builtin_amdgcn_global_load_lds((const unsigned*)(gp), (PG8_LAS unsigned*)(lp), 16, 0, 0)
#define PG9_STAGE_A(slot, gbase) do { if (wr == 0) PG9_GLDS((const char*)(gbase) + voffA0, lds + (slot) + ldsw); PG9_GLDS((const char*)(gbase) + voffA1, lds + (slot) + ldsw + 4096); } while (0)
#define PG9_STAGE_B(slot, gbase) do { PG9_GLDS((const char*)(gbase) + voffB[0], lds + (slot) + ldsw); PG9_GLDS((const char*)(gbase) + voffB[1], lds + (slot) + ldsw + 8192); } while (0)
#define PG9_LDA(dst, b, a) do { _Pragma("unroll") for (int m = 0; m < 3; ++m) _Pragma("unroll") for (int k = 0; k < 2; ++k) dst[m][k] = *(const PG8_LAS bf16x8*)(lds + PG9_SA(b, a) + aoff + m * 2048 + k * 1024); } while (0)
#define PG9_LDB(dst, b, h) do { _Pragma("unroll") for (int n = 0; n < 2; ++n) _Pragma("unroll") for (int k = 0; k < 2; ++k) dst[n][k] = *(const PG8_LAS bf16x8*)(lds + PG9_SB(b, h) + boff + n * 2048 + k * 1024); } while (0)
#define PG9_MMA(ai, bj, At, Bt) do { _Pragma("unroll") for (int m = 0; m < 3; ++m) _Pragma("unroll") for (int n = 0; n < 2; ++n) _Pragma("unroll") for (int k = 0; k < 2; ++k) \
        acc[ai][bj][m][n] = __builtin_amdgcn_mfma_f32_16x16x32_bf16(Bt[n][k], At[m][k], acc[ai][bj][m][n], 0, 0, 0); } while (0)
#define PG9_MMA2(ai) do { __builtin_amdgcn_s_setprio(1); PG9_MMA(ai, 0, At, B0); PG9_MMA(ai, 1, At, B1); __builtin_amdgcn_s_setprio(0); } while (0)
#define PG9_WAIT_V2(a, b) do { if (wr == 0) asm volatile("s_waitcnt vmcnt(" #a ")" ::: "memory"); else asm volatile("s_waitcnt vmcnt(" #b ")" ::: "memory"); } while (0)
#define PG9_WAIT_L0 asm volatile("s_waitcnt lgkmcnt(0)" ::: "memory")
#define PG9_BAR __builtin_amdgcn_s_barrier()
#define PG9_SCHED __builtin_amdgcn_sched_barrier(0)
    Unit cur, nxt; int ui = 0;
    if (!S.next(0, cur)) return;
    f32x4 acc[3][2][3][2];
    u32x4 rinit[3][3][2];
    if constexpr (Epi::INIT_ACC) E.init_load(rinit, cur, wr, wc, fr, fq);
    else {
#pragma unroll
    for (int a = 0; a < 3; ++a)
#pragma unroll
        for (int b = 0; b < 2; ++b)
#pragma unroll
            for (int m = 0; m < 3; ++m)
#pragma unroll
                for (int n = 0; n < 2; ++n) acc[a][b][m][n] = (f32x4){0.f, 0.f, 0.f, 0.f};
    }
    bf16x8 At[3][2], B0[2][2], B1[2][2];
    const char* cA = (const char*)g.A + (size_t)cur.pm * tstepA; const char* cB = (const char*)g.Bt + (size_t)cur.pn * tstepB;
    PG9_STAGE_B(PG9_SB(0, 0), cB); PG9_STAGE_B(PG9_SB(0, 1), cB + hstep); PG9_STAGE_A(PG9_SA(0, 0), cA); PG9_STAGE_A(PG9_SA(0, 1), cA + thstep); PG9_STAGE_A(PG9_SA(0, 2), cA + 2 * thstep);
    if constexpr (Epi::INIT_ACC) { PG9_SCHED; E.init_acc(acc, rinit); PG9_SCHED; }
    if (wr == 1) PG9_BAR;
    PG9_WAIT_V2(4, 2); PG9_BAR;
    PG9_STAGE_B(PG9_SB(1, 0), cB + kstep); PG9_STAGE_B(PG9_SB(1, 1), cB + hstep + kstep); PG9_STAGE_A(PG9_SA(1, 0), cA + kstep); PG9_STAGE_A(PG9_SA(1, 1), cA + thstep + kstep);
    PG9_WAIT_V2(8, 6); PG9_BAR;
    for (;;) {
        const bool has_next = S.next(ui + 1, nxt);
        const char* nA = has_next ? (const char*)g.A + (size_t)nxt.pm * tstepA : cA; const char* nB = has_next ? (const char*)g.Bt + (size_t)nxt.pn * tstepB : cB;
        for (int t = 0; t < nt; t += 2) {
            const bool last = (t == nt - 2);
            const char* a1 = cA + (size_t)(t + 1) * kstep;
            const char* a2 = last ? nA : cA + (size_t)(t + 2) * kstep; const char* b2 = last ? nB : cB + (size_t)(t + 2) * kstep;
            const char* a3 = a2 + kstep; const char* b3 = b2 + kstep;
            PG9_LDB(B0, 0, 0); PG9_LDB(B1, 0, 1); PG9_SCHED; PG9_LDA(At, 0, 0); PG9_STAGE_A(PG9_SA(1, 2), a1 + 2 * thstep);
            PG9_WAIT_V2(12, 8); PG9_WAIT_L0; PG9_BAR; PG9_MMA2(0); PG9_BAR; PG9_SCHED;
            PG9_LDA(At, 0, 1); PG9_STAGE_B(PG9_SB(0, 0), b2); PG9_STAGE_B(PG9_SB(0, 1), b2 + hstep);
            PG9_WAIT_V2(14, 11); PG9_WAIT_L0; PG9_BAR; PG9_MMA2(1); PG9_BAR; PG9_SCHED;
            PG9_LDA(At, 0, 2); PG9_STAGE_A(PG9_SA(0, 0), a2); PG9_STAGE_A(PG9_SA(0, 1), a2 + thstep);
            PG9_WAIT_V2(12, 8); PG9_WAIT_L0; PG9_BAR; PG9_MMA2(2); PG9_BAR; PG9_SCHED;
            PG9_LDB(B0, 1, 0); PG9_LDB(B1, 1, 1); PG9_SCHED; PG9_LDA(At, 1, 0); PG9_STAGE_A(PG9_SA(0, 2), a2 + 2 * thstep);
            PG9_WAIT_V2(12, 8); PG9_WAIT_L0; PG9_BAR; PG9_MMA2(0); PG9_BAR; PG9_SCHED;
            PG9_LDA(At, 1, 1); PG9_STAGE_B(PG9_SB(1, 0), b3); PG9_STAGE_B(PG9_SB(1, 1), b3 + hstep);
            PG9_WAIT_V2(14, 11); PG9_WAIT_L0; PG9_BAR; PG9_MMA2(1); PG9_BAR; PG9_SCHED;
            PG9_LDA(At, 1, 2); PG9_STAGE_A(PG9_SA(1, 0), a3); PG9_STAGE_A(PG9_SA(1, 1), a3 + thstep);
            PG9_WAIT_V2(12, 8); PG9_WAIT_L0; PG9_BAR; PG9_MMA2(2); PG9_BAR; PG9_SCHED;
        }
        if constexpr (ALIGN_EPI) { if (wr == 0) PG9_BAR; }
        if constexpr (!Epi::AFTER_DRAIN) E(acc, cur, wr, wc, fr, fq);
        if (!has_next) break;
#pragma unroll
        for (int a = 0; a < 3; ++a)
#pragma unroll
            for (int b = 0; b < 2; ++b)
#pragma unroll
                for (int m = 0; m < 3; ++m)
#pragma unroll
                    for (int n = 0; n < 2; ++n) acc[a][b][m][n] = (f32x4){0.f, 0.f, 0.f, 0.f};
        cur = nxt; cA = nA; cB = nB; ++ui;
        if constexpr (ALIGN_EPI) { if (wr == 1) PG9_BAR; }
    }
    asm volatile("s_waitcnt vmcnt(0)" ::: "memory");
    if constexpr (!ALIGN_EPI) { if (wr == 0) PG9_BAR; }
    PG9_BAR;
    if constexpr (Epi::AFTER_DRAIN) E.fused(acc, cur, wr, wc, fr, fq, lds, wid, lane);
#undef PG9_SA
#undef PG9_SB
#undef PG9_GLDS
#undef PG9_STAGE_A
#undef PG9_STAGE_B
#undef PG9_LDA
#undef PG9_LDB
#undef PG9_MMA
#undef PG9_MMA2
#undef PG9_WAIT_V2
#undef PG9_WAIT_L0
#undef PG9_BAR
#undef PG9_SCHED
}
}

constexpr int NWAVES = 8, NTHR = NWAVES * 64;
constexpr int N_LAUNCHES = MK_N_LAUNCHES;
constexpr int NPHASE = 12;
constexpr int DM = 2048, MP = 8192, MS = 1024, M = MP + MS;
constexpr int SEQ = 2048, NB = 4, DB = 128, DT = 8;
constexpr int NH = 4, HK = 256, HV = 512, KD = 1024, RANK = 16;
constexpr int NPROJ = 6144, NQKV = 4096, RG_WGS = 86, WIN_LD = 6160, DFF = 8192, SGW = 2048, SGG = 8, SGC = 128, SGD = 256;
constexpr int PK2 = DM + 64, PK8 = DFF + 64;
constexpr float ALPHA = 1.41421356237309515f;
constexpr float LN_EPS = 1e-5f, HN_EPS = 1e-6f;
constexpr size_t OUT_Y = 0, OUT_SP = (size_t)M * DM, OUT_SS = OUT_SP + (size_t)NB * NH * HK * HV, OUT_SGV = OUT_SS + (size_t)DB * NH * HK * HV, OUT_END = OUT_SGV + (size_t)MS * SGW;

constexpr size_t MiB = 1u << 20;
constexpr size_t WS_CTL = 0, CTL_ZERO_BYTES = 1 * MiB;
constexpr size_t WS_WIN = 1 * MiB;
constexpr size_t WS_WOUT = WS_WIN + 25 * MiB;
constexpr size_t WS_W1 = WS_WOUT + 9 * MiB;
constexpr size_t WS_W2 = WS_W1 + 66 * MiB;
constexpr size_t WS_SGIN = WS_W2 + 65 * MiB;
constexpr size_t WS_SGOUT = WS_SGIN + 17 * MiB;
constexpr size_t WS_WC = WS_SGOUT + 9 * MiB;
constexpr size_t WS_XB = WS_WC + 1 * MiB;
constexpr size_t WS_RA = WS_XB + 38 * MiB;
constexpr size_t WS_PROJ = WS_RA, WS_LOGA = WS_RA + 108 * MiB, WS_HB = WS_RA;
constexpr size_t WS_RB = WS_RA + 146 * MiB;
constexpr size_t WS_O = WS_RB, WS_Z = WS_RB;
constexpr size_t WS_A2 = WS_RB + 72 * MiB;
constexpr size_t WS_XCH = WS_A2 + 38 * MiB;
constexpr size_t WS_X1 = WS_XCH + 1 * MiB;
constexpr size_t WS_X2 = WS_X1 + 72 * MiB;
constexpr size_t WS_VN = WS_X2 + 72 * MiB;
constexpr size_t WS_STAT = WS_VN + 36 * MiB;
constexpr size_t WS_IMG = WS_STAT + 1 * MiB;
constexpr size_t WS_END = WS_IMG + 37 * MiB;
constexpr int CW_BAR = 4096;
constexpr int CW_QUEUE = 64;
constexpr int CW_TMO = 1;
constexpr int CW_GATE = 8192;
constexpr int CW_LN = 16384, LN_BANK = 32 * 64;

constexpr int RING_BYTES = 139264;
constexpr int LDS_BYTES = 147456;
constexpr int MISC_OFF = LDS_BYTES - 256;

#define GAS __attribute__((address_space(1)))
#define LAS __attribute__((address_space(3)))
typedef unsigned short bf16;
typedef unsigned v4u __attribute__((ext_vector_type(4)));
typedef unsigned v2u __attribute__((ext_vector_type(2)));
typedef float f32x4 __attribute__((ext_vector_type(4)));
typedef short bf16x8 __attribute__((ext_vector_type(8)));
#define RLX_AGENT __ATOMIC_RELAXED, __HIP_MEMORY_SCOPE_AGENT
#define LDS_WAIT() asm volatile("s_waitcnt lgkmcnt(0)" ::: "memory")
#define VM_WAIT() asm volatile("s_waitcnt vmcnt(0)" ::: "memory")
__device__ __forceinline__ unsigned pk2(float lo, float hi) { return pg8::cvt_pk_bf16(lo, hi); }
__device__ __forceinline__ float bf_lo(unsigned w) { return __uint_as_float(w << 16); }
__device__ __forceinline__ float bf_hi(unsigned w) { return __uint_as_float(w & 0xffff0000u); }
__device__ __forceinline__ float bf2f(bf16 b) { return __uint_as_float(((unsigned)b) << 16); }

#define XB_TMO      128
#define XB_XCNT(j)  (256  + 64 * (j))
#define XB_XSUB(j)  (1280 + 64 * (j))
#define XB_XGEN(j)  (2304 + 64 * (j))
#define XB_TOP      3328
#define XB_TOPGEN   3392
#define XCD_BAR_WORDS 3456
#define XB_SPIN_CAP (1u << 22)
__device__ __forceinline__ unsigned xb_ld(unsigned* p)              { return __hip_atomic_load(p, __ATOMIC_RELAXED, __HIP_MEMORY_SCOPE_AGENT); }
__device__ __forceinline__ unsigned xb_add(unsigned* p, unsigned v) { return __hip_atomic_fetch_add(p, v, __ATOMIC_RELAXED, __HIP_MEMORY_SCOPE_AGENT); }
__device__ __forceinline__ unsigned xb_xcc_id() { return (unsigned)__builtin_amdgcn_s_getreg((3 << 11) | 20) & 0xFu; }
#define XB_SPIN(cond, bar) do { unsigned _sp = 0; while (cond) { __builtin_amdgcn_s_sleep(1); \
    if ((++_sp & 255u) == 0u) { if (xb_ld(&(bar)[XB_TMO])) break; if (_sp > XB_SPIN_CAP) { atomicAdd(&(bar)[XB_TMO], 1u); break; } } } } while (0)
struct XcdBarrier { unsigned* bar; unsigned x; volatile LAS unsigned* st; };
__device__ __forceinline__ XcdBarrier xcd_barrier_post(unsigned* bar, volatile LAS unsigned* st) {
    XcdBarrier b; b.bar = bar; b.x = xb_xcc_id(); b.st = st;
    if (threadIdx.x == 0) (void)xb_add(&bar[XB_XCNT(b.x)], 1u);
    return b;
}
__device__ __forceinline__ void xcd_barrier_complete(unsigned* bar, unsigned x, unsigned& nloc, unsigned& nx) {
    const unsigned G = gridDim.x * gridDim.y * gridDim.z;
    unsigned sum, cnt, mine, sp = 0u;
    for (;;) {
        sum = 0u; cnt = 0u; mine = 0u;
#pragma unroll
        for (unsigned j = 0; j < 16; ++j) { const unsigned c = xb_ld(&bar[XB_XCNT(j)]); sum += c; cnt += (c > 0u) ? 1u : 0u; mine = (j == x) ? c : mine; }
        if (sum == G) break;
        __builtin_amdgcn_s_sleep(1);
        if ((++sp & 255u) == 0u) { if (xb_ld(&bar[XB_TMO])) break; if (sp > XB_SPIN_CAP) { atomicAdd(&bar[XB_TMO], 1u); break; } }
    }
    nloc = mine > 0u ? mine : 1u; nx = cnt > 0u ? cnt : 1u;
}
__device__ __forceinline__ void xcd_barrier(const XcdBarrier& b) {
    asm volatile("s_waitcnt vmcnt(0)" ::: "memory");
    __syncthreads();
    if (threadIdx.x == 0) {
        unsigned* bar = b.bar;
        __builtin_amdgcn_s_waitcnt(0);
        unsigned nloc = b.st[0], nx = b.st[1];
        if (nloc == 0u) { xcd_barrier_complete(bar, b.x, nloc, nx); b.st[0] = nloc; b.st[1] = nx; }
        const unsigned old = xb_add(&bar[XB_XSUB(b.x)], 1u);
        const unsigned gen = old / nloc;
        if (old + 1u == (gen + 1u) * nloc) {
            __builtin_amdgcn_fence(__ATOMIC_RELEASE, "agent");
            asm volatile("s_waitcnt vmcnt(0)" ::: "memory");
            const unsigned og = xb_add(&bar[XB_TOP], 1u);
            const unsigned tg = og / nx;
            if (og + 1u == (tg + 1u) * nx) xb_add(&bar[XB_TOPGEN], 1u);
            else XB_SPIN(xb_ld(&bar[XB_TOPGEN]) == tg, bar);
            __builtin_amdgcn_fence(__ATOMIC_ACQUIRE, "agent");
            xb_add(&bar[XB_XGEN(b.x)], 1u);
            asm volatile("s_waitcnt vmcnt(0)" ::: "memory");
        } else {
            XB_SPIN(xb_ld(&bar[XB_XGEN(b.x)]) == gen, bar);
            __builtin_amdgcn_fence(__ATOMIC_ACQUIRE, "agent");
            asm volatile("s_waitcnt vmcnt(0)" ::: "memory");
        }
    }
    __syncthreads();
}

struct Frame {
    LAS unsigned char* lds;
    volatile LAS unsigned* MISC;
    unsigned* ctl;
    int tid, lane, wave, vcu, G;
    const float* in[21];
    float* out;
    unsigned char* ws;
};
__device__ __forceinline__ float wave_sum(float v) {
#pragma unroll
    for (int o = 1; o < 64; o <<= 1) v += __shfl_xor(v, o);
    return v;
}
__device__ __forceinline__ const float* xrow_ptr(const Frame& F, int m) { return m < MP ? F.in[0] + (size_t)m * DM : F.in[1] + (size_t)(m - MP) * DM; }

__device__ __forceinline__ void p0_transpose_item(const float* W, int ldw, int ldk, bf16* WT, int item, int nblk, int lane) {
    const int kb = item / nblk, nb = item - kb * nblk, k0 = 64 * kb, n0 = 64 * nb, q = lane >> 4, c = lane & 15;
    f32x4 v[16];
    const float* src = W + (size_t)(k0 + 16 * q) * ldw + n0 + 4 * c;
#pragma unroll
    for (int i = 0; i < 16; ++i) v[i] = __builtin_nontemporal_load((const f32x4*)(src + (size_t)i * ldw));
#pragma unroll
    for (int j = 0; j < 4; ++j) {
        v4u lo, hi;
        lo.x = pk2(v[0][j], v[1][j]); lo.y = pk2(v[2][j], v[3][j]); lo.z = pk2(v[4][j], v[5][j]); lo.w = pk2(v[6][j], v[7][j]);
        hi.x = pk2(v[8][j], v[9][j]); hi.y = pk2(v[10][j], v[11][j]); hi.z = pk2(v[12][j], v[13][j]); hi.w = pk2(v[14][j], v[15][j]);
        bf16* dst = WT + (size_t)(n0 + 4 * c + j) * ldk + k0 + 16 * q;
        *(v4u*)dst = lo; *(v4u*)(dst + 8) = hi;
    }
}
constexpr int DT_I_WOUT = (DM / 64) * (DM / 64), DT_I_W1 = (DM / 64) * (DFF / 64), DT_I_W2 = (DFF / 64) * (DM / 64), DT_I_SGIN = (DM / 64) * (2 * SGW / 64), DT_I_SGOUT = (SGW / 64) * (DM / 64);
constexpr int DT_NITEMS = DT_I_WOUT + 2 * DT_I_W1 + 2 * DT_I_W2 + DT_I_SGIN + DT_I_SGOUT, DT_NCHUNK = DT_NITEMS / 64;
static_assert(DT_NITEMS % 64 == 0, "deferred transposes: whole chunks");
__device__ __forceinline__ void deferred_transpose_chunk(Frame& F, int chunk) {
    unsigned char* ws = F.ws;
    for (int i = 0; i < 8; ++i) {
        int r = chunk * 64 + F.wave * 8 + i;
        if (r < DT_I_WOUT) { p0_transpose_item(F.in[7], DM, PK2, (bf16*)(ws + WS_WOUT), r, DM / 64, F.lane); continue; } r -= DT_I_WOUT;
        if (r < 2 * DT_I_W1) { const int l = r / DT_I_W1; r -= l * DT_I_W1; p0_transpose_item(F.in[15] + (size_t)l * DM * DFF, DFF, PK2, (bf16*)(ws + WS_W1) + (size_t)l * DFF * PK2, r, DFF / 64, F.lane); continue; } r -= 2 * DT_I_W1;
        if (r < 2 * DT_I_W2) { const int l = r / DT_I_W2; r -= l * DT_I_W2; p0_transpose_item(F.in[16] + (size_t)l * DFF * DM, DM, PK8, (bf16*)(ws + WS_W2) + (size_t)l * DM * PK8, r, DM / 64, F.lane); continue; } r -= 2 * DT_I_W2;
        if (r < DT_I_SGIN) { p0_transpose_item(F.in[8], 2 * SGW, PK2, (bf16*)(ws + WS_SGIN), r, 2 * SGW / 64, F.lane); continue; } r -= DT_I_SGIN;
        p0_transpose_item(F.in[14], DM, PK2, (bf16*)(ws + WS_SGOUT), r, DM / 64, F.lane);
    }
}
__device__ __forceinline__ float logsigmoid_f(float x) { return fminf(x, 0.f) - log1pf(expf(-fabsf(x))); }
__device__ __forceinline__ float logsigmoid_fast(float x) { return fminf(x, 0.f) - __logf(1.0f + __expf(-fabsf(x))); }
__device__ __forceinline__ void p0_prologue(Frame& F) {
    const int gw = F.vcu * NWAVES + F.wave, NGW = F.G * NWAVES;
    unsigned char* ws = F.ws;
    {
        constexpr int I_WIN = (DM / 64) * (NPROJ / 64);
        for (int it = gw; it < I_WIN; it += NGW) p0_transpose_item(F.in[3], WIN_LD, PK2, (bf16*)(ws + WS_WIN), it, NPROJ / 64, F.lane);
    }
    {
        bf16* wc = (bf16*)(ws + WS_WC); const float* wsp = F.in[12];
        for (int i = F.vcu * NTHR + F.tid; i < SGG * SGC * SGC; i += F.G * NTHR) { const int s = i & 127, t = (i >> 7) & 127; wc[i] = (bf16)(pk2(s <= t ? wsp[i] : 0.f, 0.f) & 0xffffu); }
        float* stat = (float*)(ws + WS_STAT);
        for (int i = F.vcu * NTHR + F.tid; i < 2 * M; i += F.G * NTHR) stat[i] = 0.f;
    }
    {
        constexpr int WGP = DM + 4;
        LAS float* wgT = (LAS float*)F.lds;
        for (int idx = F.tid; idx < DM * 4; idx += NTHR) { const int k = idx >> 2, part = idx & 3; const f32x4 w = *(const f32x4*)(F.in[3] + (size_t)k * WIN_LD + NPROJ + 4 * part);
            wgT[(4 * part + 0) * WGP + k] = w.x; wgT[(4 * part + 1) * WGP + k] = w.y; wgT[(4 * part + 2) * WGP + k] = w.z; wgT[(4 * part + 3) * WGP + k] = w.w; }
        __syncthreads();
        const float* wgate = F.in[4]; const float* bgate = F.in[5];
        bf16* xb = (bf16*)(ws + WS_XB); float* loga = (float*)(ws + WS_LOGA);
        const int rows_wg = M / F.G;
        const int r_lo = (F.wave * rows_wg) / NWAVES, r_hi = ((F.wave + 1) * rows_wg) / NWAVES;
        const int lane = F.lane, fr = lane & 15, fq = lane >> 4;
        LAS float* GT = (LAS float*)(F.lds + 16 * WGP * 4);
        {
            const int kw = F.wave * 256, ntile = (rows_wg + 15) >> 4;
            pg8::bf16x8 bh[8], bl[8];
#pragma unroll
            for (int ks = 0; ks < 8; ++ks) { const f32x4 w0 = *(const LAS f32x4*)(wgT + fr * WGP + kw + 32 * ks + 8 * fq), w1 = *(const LAS f32x4*)(wgT + fr * WGP + kw + 32 * ks + 8 * fq + 4);
                const v4u h = (v4u){pk2(w0.x, w0.y), pk2(w0.z, w0.w), pk2(w1.x, w1.y), pk2(w1.z, w1.w)};
                const v4u l = (v4u){pk2(w0.x - bf_lo(h.x), w0.y - bf_hi(h.x)), pk2(w0.z - bf_lo(h.y), w0.w - bf_hi(h.y)), pk2(w1.x - bf_lo(h.z), w1.y - bf_hi(h.z)), pk2(w1.z - bf_lo(h.w), w1.w - bf_hi(h.w))};
                bh[ks] = __builtin_bit_cast(pg8::bf16x8, h); bl[ks] = __builtin_bit_cast(pg8::bf16x8, l); }
            __syncthreads();
            LAS f32x4* PS = (LAS f32x4*)F.lds;
            f32x4 xa[8][2];
            { const int row = fr < rows_wg ? fr : rows_wg - 1; const float* xp = xrow_ptr(F, F.vcu * rows_wg + row) + kw + 8 * fq;
#pragma unroll
              for (int ks = 0; ks < 8; ++ks) { xa[ks][0] = *(const f32x4*)(xp + 32 * ks); xa[ks][1] = *(const f32x4*)(xp + 32 * ks + 4); } }
            for (int rt = 0; rt < ntile; ++rt) {
                const int row = 16 * rt + fr; const bool valid = row < rows_wg; const int m = F.vcu * rows_wg + (valid ? row : rows_wg - 1);
                f32x4 xc[8][2];
#pragma unroll
                for (int ks = 0; ks < 8; ++ks) { xc[ks][0] = xa[ks][0]; xc[ks][1] = xa[ks][1]; }
                if (rt + 1 < ntile) { const int rown = 16 * (rt + 1) + fr; const float* xp = xrow_ptr(F, F.vcu * rows_wg + (rown < rows_wg ? rown : rows_wg - 1)) + kw + 8 * fq;
#pragma unroll
                    for (int ks = 0; ks < 8; ++ks) { xa[ks][0] = *(const f32x4*)(xp + 32 * ks); xa[ks][1] = *(const f32x4*)(xp + 32 * ks + 4); } }
                f32x4 acc = (f32x4){0.f, 0.f, 0.f, 0.f};
                bf16* xo = xb + (size_t)m * PK2 + kw + 8 * fq;
#pragma unroll
                for (int ks = 0; ks < 8; ++ks) { const f32x4 w0 = xc[ks][0], w1 = xc[ks][1];
                    const v4u h = (v4u){pk2(w0.x, w0.y), pk2(w0.z, w0.w), pk2(w1.x, w1.y), pk2(w1.z, w1.w)};
                    const v4u l = (v4u){pk2(w0.x - bf_lo(h.x), w0.y - bf_hi(h.x)), pk2(w0.z - bf_lo(h.y), w0.w - bf_hi(h.y)), pk2(w1.x - bf_lo(h.z), w1.y - bf_hi(h.z)), pk2(w1.z - bf_lo(h.w), w1.w - bf_hi(h.w))};
                    if (valid) *(v4u*)(xo + 32 * ks) = h;
                    const pg8::bf16x8 ah = __builtin_bit_cast(pg8::bf16x8, h), al = __builtin_bit_cast(pg8::bf16x8, l);
                    acc = __builtin_amdgcn_mfma_f32_16x16x32_bf16(ah, bh[ks], acc, 0, 0, 0);
                    acc = __builtin_amdgcn_mfma_f32_16x16x32_bf16(al, bh[ks], acc, 0, 0, 0);
                    acc = __builtin_amdgcn_mfma_f32_16x16x32_bf16(ah, bl[ks], acc, 0, 0, 0); }
                PS[(F.wave * ntile + rt) * 64 + lane] = acc;
            }
            __syncthreads();
            for (int idx = F.tid; idx < rows_wg * 16; idx += NTHR) { const int row = idx >> 4, r = idx & 15, rt = row >> 4, ml = row & 15; float t = 0.f;
#pragma unroll
                for (int w = 0; w < NWAVES; ++w) t += ((const LAS float*)(PS + (w * ntile + rt) * 64 + 16 * (ml >> 2) + r))[ml & 3];
                GT[row * 16 + r] = t; }
        }
        __syncthreads();
        LAS float* WG = (LAS float*)F.lds;
        LAS float* BG = WG + 16 * KD;
        for (int idx = F.tid; idx < 17 * KD / 4; idx += NTHR) *((LAS f32x4*)F.lds + idx) = (idx < 16 * KD / 4) ? *((const f32x4*)wgate + idx) : *((const f32x4*)bgate + (idx - 16 * KD / 4));
        __syncthreads();
        for (int rl = r_lo; rl < r_hi; ++rl) { const int m = F.vcu * rows_wg + rl;
            const f32x4 g0 = *(const LAS f32x4*)(GT + rl * 16), g1 = *(const LAS f32x4*)(GT + rl * 16 + 4), g2 = *(const LAS f32x4*)(GT + rl * 16 + 8), g3 = *(const LAS f32x4*)(GT + rl * 16 + 12);
            const float g[16] = {g0.x, g0.y, g0.z, g0.w, g1.x, g1.y, g1.z, g1.w, g2.x, g2.y, g2.z, g2.w, g3.x, g3.y, g3.z, g3.w};
#pragma unroll
            for (int j = 0; j < 4; ++j) { const int c0 = 4 * lane + 256 * j; f32x4 lg0 = *(const LAS f32x4*)(BG + c0);
#pragma unroll
                for (int r = 0; r < 16; ++r) { const f32x4 w = *(const LAS f32x4*)(WG + r * KD + c0); lg0 += w * g[r]; }
                f32x4 o;
                o.x = logsigmoid_fast(lg0.x) * 0.0625f; o.y = logsigmoid_fast(lg0.y) * 0.0625f; o.z = logsigmoid_fast(lg0.z) * 0.0625f; o.w = logsigmoid_fast(lg0.w) * 0.0625f; *(f32x4*)(loga + (size_t)m * KD + c0) = o;
                asm volatile("" ::: "memory"); }
        }
        __syncthreads();
    }
}

constexpr size_t IMG_QD = 0, IMG_KET = 32768, IMG_P = 65536, IMG_DV = 73728, IMG_BYTES = 74752;
constexpr int PP_QD = 0, PP_KI = 33792, PP_P = 67584, PP_RS = 76800;
constexpr int QD_PITCH = 528, T_PITCH = 144;
__device__ __forceinline__ pg8::bf16x8 as_bf16x8(v4u w) { return __builtin_bit_cast(pg8::bf16x8, w); }
__device__ __forceinline__ void gla_prep_item(Frame& F, int item) {
    const int n = item & 31, h = (item >> 5) & 3, b = item >> 7;
    const bf16* proj = (const bf16*)(F.ws + WS_PROJ); const float* loga = (const float*)(F.ws + WS_LOGA);
    unsigned char* img = F.ws + WS_IMG + (size_t)item * IMG_BYTES;
    LAS unsigned char* L = F.lds;
    const int tid = F.tid, lane = F.lane, w = F.wave, fr = lane & 15, fq = lane >> 4, cp = tid & 63, rg = tid >> 6;
    f32x4 lg[8]; v2u qr[8], kr[8];
    { const size_t R0 = (size_t)b * SEQ + (size_t)n * 64;
#pragma unroll
      for (int s = 0; s < 8; ++s) { const size_t row = R0 + 8 * rg + s;
          lg[s] = *(const f32x4*)(loga + row * KD + h * HK + 4 * cp); qr[s] = *(const v2u*)(proj + row * NPROJ + h * HK + 4 * cp); kr[s] = *(const v2u*)(proj + row * NPROJ + KD + h * HK + 4 * cp); } }
    __syncthreads();
    { f32x4 c = (f32x4){0.f, 0.f, 0.f, 0.f};
#pragma unroll
      for (int s = 0; s < 8; ++s) { c += lg[s]; lg[s] = c; }
      *((LAS f32x4*)(L + PP_RS) + rg * 64 + cp) = c; }
    __syncthreads();
    { f32x4 off = (f32x4){0.f, 0.f, 0.f, 0.f}, tot = (f32x4){0.f, 0.f, 0.f, 0.f};
#pragma unroll
      for (int r = 0; r < 8; ++r) { const f32x4 v = *((const LAS f32x4*)(L + PP_RS) + r * 64 + cp); tot += v; if (r < rg) off += v; }
      f32x4 ei; ei.x = __expf(-tot.x); ei.y = __expf(-tot.y); ei.z = __expf(-tot.z); ei.w = __expf(-tot.w);
      unsigned ke[4][4];
#pragma unroll
      for (int s2 = 0; s2 < 4; ++s2) { f32x4 kev[2]; unsigned qw[4];
#pragma unroll
          for (int u = 0; u < 2; ++u) { const int s = 2 * s2 + u; const f32x4 bb = off + lg[s], tb = tot - bb;
              f32x4 e1, e3; e1.x = __expf(bb.x); e1.y = __expf(bb.y); e1.z = __expf(bb.z); e1.w = __expf(bb.w); e3.x = __expf(tb.x); e3.y = __expf(tb.y); e3.z = __expf(tb.z); e3.w = __expf(tb.w);
              const f32x4 q4 = (f32x4){bf_lo(qr[s].x), bf_hi(qr[s].x), bf_lo(qr[s].y), bf_hi(qr[s].y)}, k4 = (f32x4){bf_lo(kr[s].x), bf_hi(kr[s].x), bf_lo(kr[s].y), bf_hi(kr[s].y)};
              const f32x4 qd = q4 * e1 * 0.0625f; kev[u] = k4 * e3; const f32x4 ki = kev[u] * ei;
              qw[2 * u] = pk2(qd.x, qd.y); qw[2 * u + 1] = pk2(qd.z, qd.w);
              *(LAS v2u*)(L + PP_QD + (8 * rg + s) * QD_PITCH + 8 * cp) = (v2u){qw[2 * u], qw[2 * u + 1]};
              *(LAS v2u*)(L + PP_KI + (8 * rg + s) * QD_PITCH + 8 * cp) = (v2u){pk2(ki.x, ki.y), pk2(ki.z, ki.w)}; }
          *((v4u*)(img + IMG_QD) + s2 * NTHR + tid) = (v4u){qw[0], qw[1], qw[2], qw[3]};
          ke[0][s2] = pk2(kev[0].x, kev[1].x); ke[1][s2] = pk2(kev[0].y, kev[1].y); ke[2][s2] = pk2(kev[0].z, kev[1].z); ke[3][s2] = pk2(kev[0].w, kev[1].w); }
#pragma unroll
      for (int c4 = 0; c4 < 4; ++c4) *((v4u*)(img + IMG_KET) + c4 * NTHR + tid) = (v4u){ke[c4][0], ke[c4][1], ke[c4][2], ke[c4][3]};
      if (rg == 0) { f32x4 dv; dv.x = __expf(tot.x); dv.y = __expf(tot.y); dv.z = __expf(tot.z); dv.w = __expf(tot.w); *((f32x4*)(img + IMG_DV) + cp) = dv; }
    }
    __syncthreads();
    { const int ttw = w >> 1, sp = w & 1;
      f32x4 sc0 = (f32x4){0.f, 0.f, 0.f, 0.f}, sc1 = (f32x4){0.f, 0.f, 0.f, 0.f};
      if (2 * sp <= ttw) {
#pragma unroll
          for (int ks = 0; ks < 8; ++ks) { const pg8::bf16x8 a = *(const LAS pg8::bf16x8*)(L + PP_QD + (16 * ttw + fr) * QD_PITCH + (32 * ks + 8 * fq) * 2);
              const pg8::bf16x8 b0 = *(const LAS pg8::bf16x8*)(L + PP_KI + (16 * (2 * sp) + fr) * QD_PITCH + (32 * ks + 8 * fq) * 2);
              sc0 = __builtin_amdgcn_mfma_f32_16x16x32_bf16(a, b0, sc0, 0, 0, 0);
              if (2 * sp + 1 <= ttw) { const pg8::bf16x8 b1 = *(const LAS pg8::bf16x8*)(L + PP_KI + (16 * (2 * sp + 1) + fr) * QD_PITCH + (32 * ks + 8 * fq) * 2);
                  sc1 = __builtin_amdgcn_mfma_f32_16x16x32_bf16(a, b1, sc1, 0, 0, 0); } } }
#pragma unroll
      for (int r = 0; r < 4; ++r) { const int tl = 4 * fq + r;
          float v0 = sc0[r], v1 = sc1[r];
          if (2 * sp > ttw || (2 * sp == ttw && fr > tl)) v0 = 0.f;
          if (2 * sp + 1 > ttw || (2 * sp + 1 == ttw && fr > tl)) v1 = 0.f;
          *(LAS unsigned short*)(L + PP_P + (16 * ttw + tl) * T_PITCH + (16 * (2 * sp) + fr) * 2) = (unsigned short)(pk2(v0, 0.f) & 0xffffu);
          *(LAS unsigned short*)(L + PP_P + (16 * ttw + tl) * T_PITCH + (16 * (2 * sp + 1) + fr) * 2) = (unsigned short)(pk2(v1, 0.f) & 0xffffu); } }
    __syncthreads();
    *((v4u*)(img + IMG_P) + tid) = *(const LAS v4u*)(L + PP_P + (tid >> 3) * T_PITCH + (tid & 7) * 16);
}
__device__ __forceinline__ void p2a_gla_prep(Frame& F) {
    for (int it = F.vcu; it < NB * NH * (SEQ / 64); it += F.G) gla_prep_item(F, it);
    __syncthreads();
}
constexpr int SC_QD = 0, SC_KET = 33792, SC_VT = 70656, SC_P = 79872, SC_DV = 89088, SC_OX = 90112, SC_END = 106496;
static_assert(SC_END <= MISC_OFF && PP_RS + 8192 <= MISC_OFF, "GLA LDS maps");
__device__ __forceinline__ void gla_prompt_item(Frame& F, int item) {
    const int j = item & 7, h = (item >> 3) & 3, b = item >> 5;
    const bf16* proj = (const bf16*)(F.ws + WS_PROJ); bf16* O = (bf16*)(F.ws + WS_O);
    const unsigned char* img0 = F.ws + WS_IMG + (size_t)((b * NH + h) * (SEQ / 64)) * IMG_BYTES;
    LAS unsigned char* L = F.lds;
    const int tid = F.tid, lane = F.lane, w = F.wave, fr = lane & 15, fq = lane >> 4, cp = tid & 63, rg = tid >> 6;
    const int kh = w >> 2, vt = w & 3;
    f32x4 S[8];
#pragma unroll
    for (int i = 0; i < 8; ++i) S[i] = (f32x4){0.f, 0.f, 0.f, 0.f};
    v4u qdA[4], keA[4], ppA, vrA, qdB[4], keB[4], ppB, vrB; f32x4 dvA = (f32x4){0.f, 0.f, 0.f, 0.f}, dvB = (f32x4){0.f, 0.f, 0.f, 0.f};
#define SC_LOAD(n_, QD_, KE_, PP_, DV_, VR_) do { const unsigned char* im_ = img0 + (size_t)(n_) * IMG_BYTES; \
        _Pragma("unroll") for (int i_ = 0; i_ < 4; ++i_) { QD_[i_] = *((const v4u*)(im_ + IMG_QD) + i_ * NTHR + tid); KE_[i_] = *((const v4u*)(im_ + IMG_KET) + i_ * NTHR + tid); } \
        PP_ = *((const v4u*)(im_ + IMG_P) + tid); if (rg == 0) DV_ = *((const f32x4*)(im_ + IMG_DV) + cp); \
        VR_ = *(const v4u*)(proj + ((size_t)b * SEQ + (size_t)(n_) * 64 + lane) * NPROJ + 2 * KD + h * HV + j * 64 + 8 * w); } while (0)
    SC_LOAD(0, qdA, keA, ppA, dvA, vrA);
    SC_LOAD(1, qdB, keB, ppB, dvB, vrB);
    __syncthreads();
    for (int n = 0; n < SEQ / 64; n += 2) {
#pragma unroll
        for (int s2 = 0; s2 < 4; ++s2) { *(LAS v2u*)(L + SC_QD + (8 * rg + 2 * s2) * QD_PITCH + 8 * cp) = (v2u){qdA[s2].x, qdA[s2].y}; *(LAS v2u*)(L + SC_QD + (8 * rg + 2 * s2 + 1) * QD_PITCH + 8 * cp) = (v2u){qdA[s2].z, qdA[s2].w}; }
#pragma unroll
        for (int c4 = 0; c4 < 4; ++c4) *(LAS v4u*)(L + SC_KET + (4 * cp + c4) * T_PITCH + 16 * rg) = keA[c4];
        *(LAS v4u*)(L + SC_P + (tid >> 3) * T_PITCH + (tid & 7) * 16) = ppA;
        if (rg == 0) *((LAS f32x4*)(L + SC_DV) + cp) = dvA;
        { LAS unsigned short* col = (LAS unsigned short*)(L + SC_VT + (8 * w) * T_PITCH + 2 * lane);
          col[0 * (T_PITCH / 2)] = (unsigned short)(vrA.x & 0xffffu); col[1 * (T_PITCH / 2)] = (unsigned short)(vrA.x >> 16); col[2 * (T_PITCH / 2)] = (unsigned short)(vrA.y & 0xffffu); col[3 * (T_PITCH / 2)] = (unsigned short)(vrA.y >> 16);
          col[4 * (T_PITCH / 2)] = (unsigned short)(vrA.z & 0xffffu); col[5 * (T_PITCH / 2)] = (unsigned short)(vrA.z >> 16); col[6 * (T_PITCH / 2)] = (unsigned short)(vrA.w & 0xffffu); col[7 * (T_PITCH / 2)] = (unsigned short)(vrA.w >> 16); }
        if ((n) + 2 < SEQ / 64) SC_LOAD((n) + 2, qdA, keA, ppA, dvA, vrA);
        __syncthreads();
        { f32x4 Oa[4];
#pragma unroll
        for (int tt = 0; tt < 4; ++tt) Oa[tt] = (f32x4){0.f, 0.f, 0.f, 0.f};
#pragma unroll
        for (int ks = 0; ks < 4; ++ks) {
            const pg8::bf16x8 Bv = as_bf16x8((v4u){pk2(S[2 * ks][0], S[2 * ks][1]), pk2(S[2 * ks][2], S[2 * ks][3]), pk2(S[2 * ks + 1][0], S[2 * ks + 1][1]), pk2(S[2 * ks + 1][2], S[2 * ks + 1][3])});
#pragma unroll
            for (int tt = 0; tt < 4; ++tt) { const v2u lo = *(const LAS v2u*)(L + SC_QD + (16 * tt + fr) * QD_PITCH + (128 * kh + 32 * ks + 4 * fq) * 2), hi = *(const LAS v2u*)(L + SC_QD + (16 * tt + fr) * QD_PITCH + (128 * kh + 32 * ks + 16 + 4 * fq) * 2);
                Oa[tt] = __builtin_amdgcn_mfma_f32_16x16x32_bf16(as_bf16x8((v4u){lo.x, lo.y, hi.x, hi.y}), Bv, Oa[tt], 0, 0, 0); } }
        if (kh == 1) {
#pragma unroll
            for (int tt = 0; tt < 4; ++tt)
#pragma unroll
                for (int r = 0; r < 4; ++r) *(LAS float*)(L + SC_OX + ((vt * 64 + 16 * tt + 4 * fq + r) * 16 + fr) * 4) = Oa[tt][r]; }
        __syncthreads();
        pg8::bf16x8 Vb[2];
#pragma unroll
        for (int k2 = 0; k2 < 2; ++k2) Vb[k2] = *(const LAS pg8::bf16x8*)(L + SC_VT + (16 * vt + fr) * T_PITCH + (32 * k2 + 8 * fq) * 2);
        if (kh == 0) {
#pragma unroll
            for (int tt = 0; tt < 4; ++tt) {
#pragma unroll
                for (int r = 0; r < 4; ++r) Oa[tt][r] += *(const LAS float*)(L + SC_OX + ((vt * 64 + 16 * tt + 4 * fq + r) * 16 + fr) * 4);
#pragma unroll
                for (int k2 = 0; k2 < 2; ++k2) { if (32 * k2 > 16 * tt + 15) continue;
                    const pg8::bf16x8 a = *(const LAS pg8::bf16x8*)(L + SC_P + (16 * tt + fr) * T_PITCH + (32 * k2 + 8 * fq) * 2);
                    Oa[tt] = __builtin_amdgcn_mfma_f32_16x16x32_bf16(a, Vb[k2], Oa[tt], 0, 0, 0); } }
            bf16* op = O + ((size_t)b * SEQ + (size_t)(n) * 64 + 4 * fq) * DM + h * HV + j * 64 + 16 * vt + fr;
#pragma unroll
            for (int tt = 0; tt < 4; ++tt)
#pragma unroll
                for (int r = 0; r < 4; ++r) op[(size_t)(16 * tt + r) * DM] = (bf16)(pk2(Oa[tt][r], 0.f) & 0xffffu); }
#pragma unroll
        for (int kt = 0; kt < 8; ++kt) { const f32x4 d4 = *(const LAS f32x4*)(L + SC_DV + (128 * kh + 16 * kt + 4 * fq) * 4); S[kt] = S[kt] * d4;
#pragma unroll
            for (int k2 = 0; k2 < 2; ++k2) { const pg8::bf16x8 a = *(const LAS pg8::bf16x8*)(L + SC_KET + (128 * kh + 16 * kt + fr) * T_PITCH + (32 * k2 + 8 * fq) * 2);
                S[kt] = __builtin_amdgcn_mfma_f32_16x16x32_bf16(a, Vb[k2], S[kt], 0, 0, 0); } }
        }
        __syncthreads();
#pragma unroll
        for (int s2 = 0; s2 < 4; ++s2) { *(LAS v2u*)(L + SC_QD + (8 * rg + 2 * s2) * QD_PITCH + 8 * cp) = (v2u){qdB[s2].x, qdB[s2].y}; *(LAS v2u*)(L + SC_QD + (8 * rg + 2 * s2 + 1) * QD_PITCH + 8 * cp) = (v2u){qdB[s2].z, qdB[s2].w}; }
#pragma unroll
        for (int c4 = 0; c4 < 4; ++c4) *(LAS v4u*)(L + SC_KET + (4 * cp + c4) * T_PITCH + 16 * rg) = keB[c4];
        *(LAS v4u*)(L + SC_P + (tid >> 3) * T_PITCH + (tid & 7) * 16) = ppB;
        if (rg == 0) *((LAS f32x4*)(L + SC_DV) + cp) = dvB;
        { LAS unsigned short* col = (LAS unsigned short*)(L + SC_VT + (8 * w) * T_PITCH + 2 * lane);
          col[0 * (T_PITCH / 2)] = (unsigned short)(vrB.x & 0xffffu); col[1 * (T_PITCH / 2)] = (unsigned short)(vrB.x >> 16); col[2 * (T_PITCH / 2)] = (unsigned short)(vrB.y & 0xffffu); col[3 * (T_PITCH / 2)] = (unsigned short)(vrB.y >> 16);
          col[4 * (T_PITCH / 2)] = (unsigned short)(vrB.z & 0xffffu); col[5 * (T_PITCH / 2)] = (unsigned short)(vrB.z >> 16); col[6 * (T_PITCH / 2)] = (unsigned short)(vrB.w & 0xffffu); col[7 * (T_PITCH / 2)] = (unsigned short)(vrB.w >> 16); }
        if ((n + 1) + 2 < SEQ / 64) SC_LOAD((n + 1) + 2, qdB, keB, ppB, dvB, vrB);
        __syncthreads();
        { f32x4 Oa[4];
#pragma unroll
        for (int tt = 0; tt < 4; ++tt) Oa[tt] = (f32x4){0.f, 0.f, 0.f, 0.f};
#pragma unroll
        for (int ks = 0; ks < 4; ++ks) {
            const pg8::bf16x8 Bv = as_bf16x8((v4u){pk2(S[2 * ks][0], S[2 * ks][1]), pk2(S[2 * ks][2], S[2 * ks][3]), pk2(S[2 * ks + 1][0], S[2 * ks + 1][1]), pk2(S[2 * ks + 1][2], S[2 * ks + 1][3])});
#pragma unroll
            for (int tt = 0; tt < 4; ++tt) { const v2u lo = *(const LAS v2u*)(L + SC_QD + (16 * tt + fr) * QD_PITCH + (128 * kh + 32 * ks + 4 * fq) * 2), hi = *(const LAS v2u*)(L + SC_QD + (16 * tt + fr) * QD_PITCH + (128 * kh + 32 * ks + 16 + 4 * fq) * 2);
                Oa[tt] = __builtin_amdgcn_mfma_f32_16x16x32_bf16(as_bf16x8((v4u){lo.x, lo.y, hi.x, hi.y}), Bv, Oa[tt], 0, 0, 0); } }
        if (kh == 1) {
#pragma unroll
            for (int tt = 0; tt < 4; ++tt)
#pragma unroll
                for (int r = 0; r < 4; ++r) *(LAS float*)(L + SC_OX + ((vt * 64 + 16 * tt + 4 * fq + r) * 16 + fr) * 4) = Oa[tt][r]; }
        __syncthreads();
        pg8::bf16x8 Vb[2];
#pragma unroll
        for (int k2 = 0; k2 < 2; ++k2) Vb[k2] = *(const LAS pg8::bf16x8*)(L + SC_VT + (16 * vt + fr) * T_PITCH + (32 * k2 + 8 * fq) * 2);
        if (kh == 0) {
#pragma unroll
            for (int tt = 0; tt < 4; ++tt) {
#pragma unroll
                for (int r = 0; r < 4; ++r) Oa[tt][r] += *(const LAS float*)(L + SC_OX + ((vt * 64 + 16 * tt + 4 * fq + r) * 16 + fr) * 4);
#pragma unroll
                for (int k2 = 0; k2 < 2; ++k2) { if (32 * k2 > 16 * tt + 15) continue;
                    const pg8::bf16x8 a = *(const LAS pg8::bf16x8*)(L + SC_P + (16 * tt + fr) * T_PITCH + (32 * k2 + 8 * fq) * 2);
                    Oa[tt] = __builtin_amdgcn_mfma_f32_16x16x32_bf16(a, Vb[k2], Oa[tt], 0, 0, 0); } }
            bf16* op = O + ((size_t)b * SEQ + (size_t)(n + 1) * 64 + 4 * fq) * DM + h * HV + j * 64 + 16 * vt + fr;
#pragma unroll
            for (int tt = 0; tt < 4; ++tt)
#pragma unroll
                for (int r = 0; r < 4; ++r) op[(size_t)(16 * tt + r) * DM] = (bf16)(pk2(Oa[tt][r], 0.f) & 0xffffu); }
#pragma unroll
        for (int kt = 0; kt < 8; ++kt) { const f32x4 d4 = *(const LAS f32x4*)(L + SC_DV + (128 * kh + 16 * kt + 4 * fq) * 4); S[kt] = S[kt] * d4;
#pragma unroll
            for (int k2 = 0; k2 < 2; ++k2) { const pg8::bf16x8 a = *(const LAS pg8::bf16x8*)(L + SC_KET + (128 * kh + 16 * kt + fr) * T_PITCH + (32 * k2 + 8 * fq) * 2);
                S[kt] = __builtin_amdgcn_mfma_f32_16x16x32_bf16(a, Vb[k2], S[kt], 0, 0, 0); } }
        }
        __syncthreads();
    }
#undef SC_LOAD
    { float* SP = F.out + OUT_SP + ((size_t)(b * NH + h) * HK + 128 * kh + 4 * fq) * HV + j * 64 + 16 * vt + fr;
#pragma unroll
      for (int kt = 0; kt < 8; ++kt)
#pragma unroll
          for (int r = 0; r < 4; ++r) SP[(size_t)(16 * kt + r) * HV] = S[kt][r]; }
}
__device__ __forceinline__ void gla_sample_item(Frame& F, int item) {
    const int h = item & 3, b = item >> 2;
    const bf16* proj = (const bf16*)(F.ws + WS_PROJ); const float* loga = (const float*)(F.ws + WS_LOGA); bf16* O = (bf16*)(F.ws + WS_O);
    LAS float* AT = (LAS float*)F.lds;
    LAS float* KT = AT + 256 * 8;
    LAS float* QT = KT + 256 * 8;
    LAS float* VV = QT + 256 * 8;
    LAS float* RED = VV + 8 * 512;
    const size_t r0 = (size_t)MP + (size_t)b * DT;
    const int c4 = F.tid & 127, kg = F.tid >> 7;
    const f32x4* S0 = (const f32x4*)(F.in[2] + (size_t)(b * NH + h) * HK * HV) + c4;
    f32x4* S1 = (f32x4*)(F.out + OUT_SS + (size_t)(b * NH + h) * HK * HV) + c4;
    f32x4 s[8];
#pragma unroll
    for (int u = 0; u < 8; ++u) s[u] = __builtin_nontemporal_load(S0 + (size_t)(kg * 64 + u) * 128);
    for (int idx = F.tid; idx < 8 * 256; idx += NTHR) { const int t = idx >> 8, k = idx & 255; const size_t row = r0 + t;
        AT[k * 8 + t] = __expf(loga[row * KD + h * HK + k]); KT[k * 8 + t] = bf2f(proj[row * NPROJ + KD + h * HK + k]); QT[k * 8 + t] = bf2f(proj[row * NPROJ + h * HK + k]) * 0.0625f; }
    for (int idx = F.tid; idx < 8 * 512; idx += NTHR) { const int t = idx >> 9, v = idx & 511; VV[idx] = bf2f(proj[(r0 + t) * NPROJ + 2 * KD + h * HV + v]); }
    __syncthreads();
    f32x4 vv[8], oa[8];
#pragma unroll
    for (int t = 0; t < 8; ++t) { vv[t] = *(const LAS f32x4*)(VV + t * 512 + 4 * c4); oa[t] = (f32x4){0.f, 0.f, 0.f, 0.f}; }
#define GLA_S_ROW(u_, k_, REFILL) do { const int k = (k_); \
            const f32x4 a0 = *(const LAS f32x4*)(AT + k * 8), a1 = *(const LAS f32x4*)(AT + k * 8 + 4), k0 = *(const LAS f32x4*)(KT + k * 8), k1 = *(const LAS f32x4*)(KT + k * 8 + 4), q0 = *(const LAS f32x4*)(QT + k * 8), q1 = *(const LAS f32x4*)(QT + k * 8 + 4); \
            f32x4 x = s[u_]; \
            x = x * a0.x + vv[0] * k0.x; oa[0] += x * q0.x; \
            x = x * a0.y + vv[1] * k0.y; oa[1] += x * q0.y; \
            x = x * a0.z + vv[2] * k0.z; oa[2] += x * q0.z; \
            x = x * a0.w + vv[3] * k0.w; oa[3] += x * q0.w; \
            x = x * a1.x + vv[4] * k1.x; oa[4] += x * q1.x; \
            x = x * a1.y + vv[5] * k1.y; oa[5] += x * q1.y; \
            x = x * a1.z + vv[6] * k1.z; oa[6] += x * q1.z; \
            x = x * a1.w + vv[7] * k1.w; oa[7] += x * q1.w; \
            __builtin_nontemporal_store(x, S1 + (size_t)k * 128); \
            if (REFILL) s[u_] = __builtin_nontemporal_load(S0 + (size_t)(k + 8) * 128); \
            asm volatile("" ::: "memory"); } while (0)
#pragma unroll 1
    for (int kb = 0; kb < 56; kb += 8) {
#pragma unroll
        for (int u = 0; u < 8; ++u) GLA_S_ROW(u, kg * 64 + kb + u, true);
    }
#pragma unroll
    for (int u = 0; u < 8; ++u) GLA_S_ROW(u, kg * 64 + 56 + u, false);
#undef GLA_S_ROW
#pragma unroll
    for (int t = 0; t < 8; ++t) *(LAS f32x4*)(RED + (kg * 8 + t) * 512 + 4 * c4) = oa[t];
    __syncthreads();
    for (int idx = F.tid; idx < 8 * 128; idx += NTHR) { const int t = idx >> 7, c = idx & 127;
        const f32x4 r = *(const LAS f32x4*)(RED + (0 * 8 + t) * 512 + 4 * c) + *(const LAS f32x4*)(RED + (1 * 8 + t) * 512 + 4 * c) + *(const LAS f32x4*)(RED + (2 * 8 + t) * 512 + 4 * c) + *(const LAS f32x4*)(RED + (3 * 8 + t) * 512 + 4 * c);
        v2u rb; rb.x = pk2(r.x, r.y); rb.y = pk2(r.z, r.w); *(v2u*)(O + (r0 + t) * DM + h * HV + 4 * c) = rb; }
    __syncthreads();
}
__device__ __forceinline__ void p2_gla(Frame& F, int qslot) {
    constexpr int NPI = NB * NH * 8, NSI = DB * NH;
    if ((int)blockIdx.x < NPI) { const int x = (int)blockIdx.x & 7, m = (int)blockIdx.x >> 3;
        gla_prompt_item(F, ((2 * x + (m & 1)) << 3) | (m >> 1));
        __syncthreads();
        pg9::Gemm g{(const bf16*)(F.ws + WS_XB), (const bf16*)(F.ws + WS_WIN) + (size_t)NQKV * PK2, M, NPROJ - NQKV, DM, PK2, PK2};
        pg9::ListOrder S{(int)blockIdx.x, NPI, (M / pg9::BMR) * ((NPROJ - NQKV) / pg9::BNC), M / pg9::BMR};
        pg9::EpiBf16<0> E{(bf16*)(F.ws + WS_PROJ) + NQKV, NPROJ, nullptr};
        pg9::gemm_phase<pg9::EpiBf16<0>, true, pg9::ListOrder>(F.lds, g, S, E);
        __syncthreads(); }
    for (;;) {
        __syncthreads();
        if (F.tid == 0) F.MISC[16] = __hip_atomic_fetch_add(F.ctl + CW_QUEUE + 64 * qslot, 1u, RLX_AGENT);
        __syncthreads();
        const int it = (int)F.MISC[16];
        if (it >= NSI + DT_NCHUNK) break;
        if (it < NSI) gla_sample_item(F, it); else deferred_transpose_chunk(F, it - NSI);
    }
    __syncthreads();
}

__device__ __forceinline__ void gate_rows(Frame& F, int row_lo, int nrows) {
    const bf16* O = (const bf16*)(F.ws + WS_O); const bf16* proj = (const bf16*)(F.ws + WS_PROJ); bf16* A2 = (bf16*)(F.ws + WS_A2); const float* ng = F.in[6];
    const int lane = F.lane; const bool b5 = lane & 32, b4 = lane & 16;
    f32x4 g4[8];
#pragma unroll
    for (int i = 0; i < 8; ++i) g4[i] = *((const f32x4*)ng + lane + 64 * i);
    const int r_lo = (F.wave * nrows) / NWAVES, r_hi = ((F.wave + 1) * nrows) / NWAVES;
    for (int rr = r_lo; rr < r_hi; rr += 2) {
        v2u ow[2][8], rw[2][8];
#pragma unroll
        for (int q = 0; q < 2; ++q) { const int m = row_lo + ((rr + q < r_hi) ? rr + q : r_hi - 1);
#pragma unroll
            for (int i = 0; i < 8; ++i) { ow[q][i] = *((const v2u*)(O + (size_t)m * DM) + lane + 64 * i); rw[q][i] = *((const v2u*)(proj + (size_t)m * NPROJ + 2 * KD + 2048) + lane + 64 * i); } }
#pragma unroll
        for (int q = 0; q < 2; ++q) { const int m = row_lo + ((rr + q < r_hi) ? rr + q : r_hi - 1);
            f32x4 v[8]; float hs[4];
#pragma unroll
            for (int i = 0; i < 8; ++i) v[i] = (f32x4){bf_lo(ow[q][i].x), bf_hi(ow[q][i].x), bf_lo(ow[q][i].y), bf_hi(ow[q][i].y)};
#pragma unroll
            for (int h = 0; h < 4; ++h) { const f32x4 a = v[2 * h], c = v[2 * h + 1]; hs[h] = (a.x * a.x + a.y * a.y) + (a.z * a.z + a.w * a.w) + (c.x * c.x + c.y * c.y) + (c.z * c.z + c.w * c.w); }
            float t2[2], t1;
#pragma unroll
            for (int i = 0; i < 2; ++i) { const float keep = b5 ? hs[i + 2] : hs[i], send = b5 ? hs[i] : hs[i + 2]; t2[i] = keep + __shfl_xor(send, 32); }
            { const float keep = b4 ? t2[1] : t2[0], send = b4 ? t2[0] : t2[1]; t1 = keep + __shfl_xor(send, 16); }
            t1 += __shfl_xor(t1, 8); t1 += __shfl_xor(t1, 4); t1 += __shfl_xor(t1, 2); t1 += __shfl_xor(t1, 1);
            float ss[4];
#pragma unroll
            for (int h = 0; h < 4; ++h) ss[h] = 1.0f / sqrtf(__int_as_float(__builtin_amdgcn_readlane(__float_as_int(t1), 16 * (h & 1) + 32 * (h >> 1))) * (1.0f / HV) + HN_EPS);
            v2u* o8 = (v2u*)(A2 + (size_t)m * PK2) + lane;
#pragma unroll
            for (int i = 0; i < 8; ++i) { const v2u rwv = rw[q][i];
                const float r0 = bf_lo(rwv.x), r1 = bf_hi(rwv.x), r2 = bf_lo(rwv.y), r3 = bf_hi(rwv.y); const float sc = ss[i >> 1];
                const float y0 = v[i].x * sc * g4[i].x * (r0 / (1.f + __expf(-r0))), y1 = v[i].y * sc * g4[i].y * (r1 / (1.f + __expf(-r1))), y2 = v[i].z * sc * g4[i].z * (r2 / (1.f + __expf(-r2))), y3 = v[i].w * sc * g4[i].w * (r3 / (1.f + __expf(-r3)));
                v2u w; w.x = pk2(y0, y1); w.y = pk2(y2, y3); o8[64 * i] = w; } }
    }
}
__device__ __forceinline__ void gate_panel_and_wait(Frame& F, int pm, int pn, unsigned* cnt) {
    gate_rows(F, pm * 288 + pn * 36, 36);
    asm volatile("s_waitcnt vmcnt(0)" ::: "memory");
    __syncthreads();
    if (F.tid == 0) {
        __builtin_amdgcn_fence(__ATOMIC_RELEASE, "agent");
        asm volatile("s_waitcnt vmcnt(0)" ::: "memory");
        __hip_atomic_fetch_add(cnt + 64 * pm, 1u, RLX_AGENT);
        unsigned sp = 0u;
        while (__hip_atomic_load(cnt + 64 * pm, RLX_AGENT) < 8u) { __builtin_amdgcn_s_sleep(2); if (++sp > (1u << 22)) { __hip_atomic_store(F.ctl + CW_TMO, 1u, RLX_AGENT); break; } }
        __builtin_amdgcn_fence(__ATOMIC_ACQUIRE, "agent");
        asm volatile("s_waitcnt vmcnt(0)" ::: "memory");
    }
    __syncthreads();
}

__device__ __forceinline__ void ln_rows(Frame& F, const float* in, const float* gam, const float* bet, float* outf, bf16* outb) {
    const int gw = F.vcu * NWAVES + F.wave, NGW = F.G * NWAVES;
    for (int m = gw; m < M; m += NGW) {
        const f32x4* xr = (const f32x4*)(in + (size_t)m * DM) + F.lane;
        f32x4 v[8]; float s = 0.f;
#pragma unroll
        for (int i = 0; i < 8; ++i) { v[i] = xr[64 * i]; s += (v[i].x + v[i].y) + (v[i].z + v[i].w); }
        const float mean = wave_sum(s) * (1.f / DM); float s2 = 0.f;
#pragma unroll
        for (int i = 0; i < 8; ++i) { v[i] = v[i] - mean; s2 += (v[i].x * v[i].x + v[i].y * v[i].y) + (v[i].z * v[i].z + v[i].w * v[i].w); }
        const float rstd = 1.f / sqrtf(wave_sum(s2) * (1.f / DM) + LN_EPS);
#pragma unroll
        for (int i = 0; i < 8; ++i) { const f32x4 g4 = *((const f32x4*)gam + F.lane + 64 * i), b4 = *((const f32x4*)bet + F.lane + 64 * i); const f32x4 y = v[i] * rstd * g4 + b4;
            if (outf) *((f32x4*)(outf + (size_t)m * DM) + F.lane + 64 * i) = y;
            if (outb) { v2u w; w.x = pk2(y.x, y.y); w.y = pk2(y.z, y.w); *((v2u*)(outb + (size_t)m * DM) + F.lane + 64 * i) = w; } }
    }
}
__device__ __forceinline__ void p10_vln(Frame& F) {
    const int gw = F.vcu * NWAVES + F.wave, NGW = F.G * NWAVES;
    const bf16* Z = (const bf16*)(F.ws + WS_Z); bf16* VN = (bf16*)(F.ws + WS_VN); const float* gam = F.in[10]; const float* bet = F.in[11];
    for (int m = gw; m < M; m += NGW) {
        const v2u* zr = (const v2u*)(Z + (size_t)m * (2 * SGW) + SGW) + F.lane;
        f32x4 v[8]; float s = 0.f;
#pragma unroll
        for (int i = 0; i < 8; ++i) { const v2u w = zr[64 * i]; v[i] = (f32x4){bf_lo(w.x), bf_hi(w.x), bf_lo(w.y), bf_hi(w.y)}; s += (v[i].x + v[i].y) + (v[i].z + v[i].w); }
        const float mean = wave_sum(s) * (1.f / SGW); float s2 = 0.f;
#pragma unroll
        for (int i = 0; i < 8; ++i) { v[i] = v[i] - mean; s2 += (v[i].x * v[i].x + v[i].y * v[i].y) + (v[i].z * v[i].z + v[i].w * v[i].w); }
        const float rstd = 1.f / sqrtf(wave_sum(s2) * (1.f / SGW) + LN_EPS);
#pragma unroll
        for (int i = 0; i < 8; ++i) { const f32x4 g4 = *((const f32x4*)gam + F.lane + 64 * i), b4 = *((const f32x4*)bet + F.lane + 64 * i); const f32x4 y = v[i] * rstd * g4 + b4;
            if (m >= MP) *((f32x4*)(F.out + OUT_SGV + (size_t)(m - MP) * SGW) + F.lane + 64 * i) = y;
            v2u w; w.x = pk2(y.x, y.y); w.y = pk2(y.z, y.w); *((v2u*)(VN + (size_t)m * SGW) + F.lane + 64 * i) = w; }
    }
}

constexpr int MIX_PITCH = 272;
__device__ __forceinline__ void mix_prompt_item(Frame& F, int item, bool load_w) {
    const int g = item & 7, ci = item >> 3; const int R0 = ci * SGC;
    const bf16* Z = (const bf16*)(F.ws + WS_Z); const bf16* Wc = (const bf16*)(F.ws + WS_WC); bf16* A2 = (bf16*)(F.ws + WS_A2); const float* stat = (const float*)(F.ws + WS_STAT);
    LAS unsigned char* WL = F.lds;
    LAS unsigned char* VT = F.lds + 128 * MIX_PITCH;
    LAS float* RS = (LAS float*)(F.lds + 128 * MIX_PITCH + 256 * MIX_PITCH);
    const int s_lo = F.lane >> 3, ch_lo = F.lane & 7;
    float sm = 0.f, sq = 0.f; v4u wq[4];
    if (F.tid < SGC) { sm = stat[2 * (size_t)(R0 + F.tid)]; sq = stat[2 * (size_t)(R0 + F.tid) + 1]; }
    if (load_w) {
#pragma unroll
        for (int i = 0; i < 4; ++i) { const int idx = F.tid + NTHR * i, t = idx >> 4, ch = idx & 15; wq[i] = *(const v4u*)(Wc + ((size_t)(g * SGC + t)) * SGC + ch * 8); } }
    v4u vr[8];
#pragma unroll
    for (int i = 0; i < 8; ++i) { const int s = 8 * (F.wave + 8 * (i & 1)) + s_lo, ch = 8 * (i >> 1) + ch_lo;
        vr[i] = *(const v4u*)(Z + (size_t)(R0 + s) * (2 * SGW) + SGW + g * SGD + ch * 8); }
    __syncthreads();
    if (F.tid < SGC) { const float mean = sm * (1.f / SGW), var = fmaxf(sq * (1.f / SGW) - mean * mean, 0.f);
        RS[2 * F.tid] = mean; RS[2 * F.tid + 1] = 1.f / sqrtf(var + LN_EPS); }
    if (load_w) {
#pragma unroll
        for (int i = 0; i < 4; ++i) { const int idx = F.tid + NTHR * i, t = idx >> 4, ch = idx & 15; *(LAS v4u*)(WL + t * MIX_PITCH + ch * 16) = wq[i]; } }
    __syncthreads();
#pragma unroll
    for (int i = 0; i < 8; ++i) { const int sh = F.wave + 8 * (i & 1), s = 8 * sh + s_lo, ch = 8 * (i >> 1) + ch_lo; const v4u w = vr[i];
        const float mean = RS[2 * s], rstd = RS[2 * s + 1];
        const f32x4 ga = *(const f32x4*)(F.in[10] + g * SGD + ch * 8), gb = *(const f32x4*)(F.in[10] + g * SGD + ch * 8 + 4), ba = *(const f32x4*)(F.in[11] + g * SGD + ch * 8), bb = *(const f32x4*)(F.in[11] + g * SGD + ch * 8 + 4);
        LAS unsigned short* col = (LAS unsigned short*)(VT + (size_t)(8 * ch) * MIX_PITCH + 16 * (sh ^ ch_lo) + 2 * s_lo);
        col[0 * (MIX_PITCH / 2)] = (unsigned short)(pk2((bf_lo(w.x) - mean) * rstd * ga.x + ba.x, 0.f) & 0xffffu); col[1 * (MIX_PITCH / 2)] = (unsigned short)(pk2((bf_hi(w.x) - mean) * rstd * ga.y + ba.y, 0.f) & 0xffffu);
        col[2 * (MIX_PITCH / 2)] = (unsigned short)(pk2((bf_lo(w.y) - mean) * rstd * ga.z + ba.z, 0.f) & 0xffffu); col[3 * (MIX_PITCH / 2)] = (unsigned short)(pk2((bf_hi(w.y) - mean) * rstd * ga.w + ba.w, 0.f) & 0xffffu);
        col[4 * (MIX_PITCH / 2)] = (unsigned short)(pk2((bf_lo(w.z) - mean) * rstd * gb.x + bb.x, 0.f) & 0xffffu); col[5 * (MIX_PITCH / 2)] = (unsigned short)(pk2((bf_hi(w.z) - mean) * rstd * gb.y + bb.y, 0.f) & 0xffffu);
        col[6 * (MIX_PITCH / 2)] = (unsigned short)(pk2((bf_lo(w.w) - mean) * rstd * gb.z + bb.z, 0.f) & 0xffffu); col[7 * (MIX_PITCH / 2)] = (unsigned short)(pk2((bf_hi(w.w) - mean) * rstd * gb.w + bb.w, 0.f) & 0xffffu); }
    __syncthreads();
    const int dg = F.wave & 3, th = F.wave >> 2, fr = F.lane & 15, fq = F.lane >> 4;
    f32x4 acc[4][4];
#pragma unroll
    for (int a = 0; a < 4; ++a)
#pragma unroll
        for (int j = 0; j < 4; ++j) acc[a][j] = (f32x4){0.f, 0.f, 0.f, 0.f};
#pragma unroll
    for (int ks = 0; ks < 4; ++ks) {
        bf16x8 af[4];
#pragma unroll
        for (int j = 0; j < 4; ++j) { const int d = 64 * dg + 16 * (fr >> 2) + 4 * j + (fr & 3);
            af[j] = *(const LAS bf16x8*)(VT + (size_t)d * MIX_PITCH + 16 * ((4 * ks + fq) ^ ((d >> 3) & 7))); }
#pragma unroll
        for (int a = 0; a < 4; ++a) { const int tt = th + 2 * a; if (2 * ks > tt) continue;
            const bf16x8 bw = *(const LAS bf16x8*)(WL + (size_t)(16 * tt + fr) * MIX_PITCH + (32 * ks + 8 * fq) * 2);
#pragma unroll
            for (int j = 0; j < 4; ++j) acc[a][j] = __builtin_amdgcn_mfma_f32_16x16x32_bf16(af[j], bw, acc[a][j], 0, 0, 0); }
    }
    const float* bsp = F.in[13] + g * SGC;
#pragma unroll
    for (int a = 0; a < 4; ++a) { const int t = 16 * (th + 2 * a) + fr; const float bb = bsp[t]; const size_t row = (size_t)R0 + t; const int col = g * SGD + 64 * dg + 16 * fq;
        const v4u u0 = *(const v4u*)(Z + row * (2 * SGW) + col), u1 = *(const v4u*)(Z + row * (2 * SGW) + col + 8);
        const f32x4 m0 = acc[a][0] + bb, m1 = acc[a][1] + bb, m2 = acc[a][2] + bb, m3 = acc[a][3] + bb;
        v4u o0, o1;
        o0.x = pk2(bf_lo(u0.x) * m0.x, bf_hi(u0.x) * m0.y); o0.y = pk2(bf_lo(u0.y) * m0.z, bf_hi(u0.y) * m0.w);
        o0.z = pk2(bf_lo(u0.z) * m1.x, bf_hi(u0.z) * m1.y); o0.w = pk2(bf_lo(u0.w) * m1.z, bf_hi(u0.w) * m1.w);
        o1.x = pk2(bf_lo(u1.x) * m2.x, bf_hi(u1.x) * m2.y); o1.y = pk2(bf_lo(u1.y) * m2.z, bf_hi(u1.y) * m2.w);
        o1.z = pk2(bf_lo(u1.z) * m3.x, bf_hi(u1.z) * m3.y); o1.w = pk2(bf_lo(u1.w) * m3.z, bf_hi(u1.w) * m3.w);
        *(v4u*)(A2 + row * PK2 + col) = o0; *(v4u*)(A2 + row * PK2 + col + 8) = o1; }
}
#define MIX_LDS_BARRIER() do { asm volatile("s_waitcnt lgkmcnt(0)" ::: "memory"); __builtin_amdgcn_s_barrier(); asm volatile("" ::: "memory"); } while (0)
__device__ __forceinline__ void mix_load_v(Frame& F, const bf16* Z, int R0, int g, v4u (&vr)[8]) {
    const int s_lo = F.lane >> 3, ch_lo = F.lane & 7;
#pragma unroll
    for (int i = 0; i < 8; ++i) { const int s = 8 * (F.wave + 8 * (i & 1)) + s_lo, ch = 8 * (i >> 1) + ch_lo;
        vr[i] = *(const v4u*)(Z + (size_t)(R0 + s) * (2 * SGW) + SGW + g * SGD + ch * 8); }
}
__device__ __forceinline__ void mix_load_u(Frame& F, const bf16* Z, int R0, int g, v4u (&u)[4][2]) {
    const int dg = F.wave & 3, th = F.wave >> 2, fr = F.lane & 15, fq = F.lane >> 4;
#pragma unroll
    for (int a = 0; a < 4; ++a) { const size_t row = (size_t)R0 + 16 * (th + 2 * a) + fr; const int col = g * SGD + 64 * dg + 16 * fq;
        u[a][0] = *(const v4u*)(Z + row * (2 * SGW) + col); u[a][1] = *(const v4u*)(Z + row * (2 * SGW) + col + 8); }
}
__device__ __forceinline__ void mix_transpose(Frame& F, int g, const v4u (&vr)[8], LAS unsigned char* VT, LAS const float* RS) {
    const int s_lo = F.lane >> 3, ch_lo = F.lane & 7;
#pragma unroll
    for (int i = 0; i < 8; ++i) { const int sh = F.wave + 8 * (i & 1), s = 8 * sh + s_lo, ch = 8 * (i >> 1) + ch_lo; const v4u w = vr[i];
        const float mean = RS[2 * s], rstd = RS[2 * s + 1];
        const f32x4 ga = *(const f32x4*)(F.in[10] + g * SGD + ch * 8), gb = *(const f32x4*)(F.in[10] + g * SGD + ch * 8 + 4), ba = *(const f32x4*)(F.in[11] + g * SGD + ch * 8), bb = *(const f32x4*)(F.in[11] + g * SGD + ch * 8 + 4);
        LAS unsigned short* col = (LAS unsigned short*)(VT + (size_t)(8 * ch) * MIX_PITCH + 16 * (sh ^ ch_lo) + 2 * s_lo);
        col[0 * (MIX_PITCH / 2)] = (unsigned short)(pk2((bf_lo(w.x) - mean) * rstd * ga.x + ba.x, 0.f) & 0xffffu); col[1 * (MIX_PITCH / 2)] = (unsigned short)(pk2((bf_hi(w.x) - mean) * rstd * ga.y + ba.y, 0.f) & 0xffffu);
        col[2 * (MIX_PITCH / 2)] = (unsigned short)(pk2((bf_lo(w.y) - mean) * rstd * ga.z + ba.z, 0.f) & 0xffffu); col[3 * (MIX_PITCH / 2)] = (unsigned short)(pk2((bf_hi(w.y) - mean) * rstd * ga.w + ba.w, 0.f) & 0xffffu);
        col[4 * (MIX_PITCH / 2)] = (unsigned short)(pk2((bf_lo(w.z) - mean) * rstd * gb.x + bb.x, 0.f) & 0xffffu); col[5 * (MIX_PITCH / 2)] = (unsigned short)(pk2((bf_hi(w.z) - mean) * rstd * gb.y + bb.y, 0.f) & 0xffffu);
        col[6 * (MIX_PITCH / 2)] = (unsigned short)(pk2((bf_lo(w.w) - mean) * rstd * gb.z + bb.z, 0.f) & 0xffffu); col[7 * (MIX_PITCH / 2)] = (unsigned short)(pk2((bf_hi(w.w) - mean) * rstd * gb.w + bb.w, 0.f) & 0xffffu); }
}
__device__ __forceinline__ void mix_mma_epi(Frame& F, int R0, int g, const v4u (&u)[4][2], LAS const unsigned char* WL, LAS const unsigned char* VT) {
    bf16* A2 = (bf16*)(F.ws + WS_A2);
    const int dg = F.wave & 3, th = F.wave >> 2, fr = F.lane & 15, fq = F.lane >> 4;
    f32x4 acc[4][4];
#pragma unroll
    for (int a = 0; a < 4; ++a)
#pragma unroll
        for (int j = 0; j < 4; ++j) acc[a][j] = (f32x4){0.f, 0.f, 0.f, 0.f};
#pragma unroll
    for (int ks = 0; ks < 4; ++ks) {
        bf16x8 af[4];
#pragma unroll
        for (int j = 0; j < 4; ++j) { const int d = 64 * dg + 16 * (fr >> 2) + 4 * j + (fr & 3);
            af[j] = *(const LAS bf16x8*)(VT + (size_t)d * MIX_PITCH + 16 * ((4 * ks + fq) ^ ((d >> 3) & 7))); }
#pragma unroll
        for (int a = 0; a < 4; ++a) { const int tt = th + 2 * a; if (2 * ks > tt) continue;
            const bf16x8 bw = *(const LAS bf16x8*)(WL + (size_t)(16 * tt + fr) * MIX_PITCH + (32 * ks + 8 * fq) * 2);
#pragma unroll
            for (int j = 0; j < 4; ++j) acc[a][j] = __builtin_amdgcn_mfma_f32_16x16x32_bf16(af[j], bw, acc[a][j], 0, 0, 0); }
    }
    const float* bsp = F.in[13] + g * SGC;
#pragma unroll
    for (int a = 0; a < 4; ++a) { const int t = 16 * (th + 2 * a) + fr; const float bb = bsp[t]; const size_t row = (size_t)R0 + t; const int col = g * SGD + 64 * dg + 16 * fq;
        const v4u u0 = u[a][0], u1 = u[a][1];
        const f32x4 m0 = acc[a][0] + bb, m1 = acc[a][1] + bb, m2 = acc[a][2] + bb, m3 = acc[a][3] + bb;
        v4u o0, o1;
        o0.x = pk2(bf_lo(u0.x) * m0.x, bf_hi(u0.x) * m0.y); o0.y = pk2(bf_lo(u0.y) * m0.z, bf_hi(u0.y) * m0.w);
        o0.z = pk2(bf_lo(u0.z) * m1.x, bf_hi(u0.z) * m1.y); o0.w = pk2(bf_lo(u0.w) * m1.z, bf_hi(u0.w) * m1.w);
        o1.x = pk2(bf_lo(u1.x) * m2.x, bf_hi(u1.x) * m2.y); o1.y = pk2(bf_lo(u1.y) * m2.z, bf_hi(u1.y) * m2.w);
        o1.z = pk2(bf_lo(u1.z) * m3.x, bf_hi(u1.z) * m3.y); o1.w = pk2(bf_lo(u1.w) * m3.z, bf_hi(u1.w) * m3.w);
        *(v4u*)(A2 + row * PK2 + col) = o0; *(v4u*)(A2 + row * PK2 + col + 8) = o1; }
}
struct MixS { unsigned v[8], u[8]; float st, wv, bv; float2 gam, bet; };
__device__ __forceinline__ void mix_sample_load(Frame& F, int hi, MixS& S) {
    const int g = (hi >> 1) & 7, b = hi >> 4; const size_t r0 = (size_t)MP + (size_t)b * DT; const int col = g * SGD + 128 * (hi & 1) + 2 * F.lane;
    const bf16* Z = (const bf16*)(F.ws + WS_Z); const float* stat = (const float*)(F.ws + WS_STAT);
#pragma unroll
    for (int s = 0; s < 8; ++s) { S.v[s] = *(const unsigned*)(Z + (r0 + s) * (2 * SGW) + SGW + col); S.u[s] = *(const unsigned*)(Z + (r0 + s) * (2 * SGW) + col); }
    S.st = stat[2 * r0 + (F.lane & 15)];
    S.wv = F.in[12][(size_t)g * SGC * SGC + (F.lane >> 3) * SGC + (F.lane & 7)];
    S.bv = F.in[13][g * SGC + (F.lane & 7)];
    S.gam = *(const float2*)(F.in[10] + col); S.bet = *(const float2*)(F.in[11] + col);
}
#define MIX_RDL(x, l) __int_as_float(__builtin_amdgcn_readlane(__float_as_int(x), (l)))
__device__ __forceinline__ void mix_sample_compute(Frame& F, int hi, const MixS& S) {
    const int g = (hi >> 1) & 7, b = hi >> 4; const size_t r0 = (size_t)MP + (size_t)b * DT; const int col = g * SGD + 128 * (hi & 1) + 2 * F.lane;
    bf16* A2 = (bf16*)(F.ws + WS_A2);
    const float wr = bf2f((bf16)(pk2(S.wv, 0.f) & 0xffffu));
    float v0[8], v1[8];
#pragma unroll
    for (int s = 0; s < 8; ++s) { const float sm = MIX_RDL(S.st, 2 * s), sq = MIX_RDL(S.st, 2 * s + 1);
        const float mean = sm * (1.f / SGW), rstd = 1.f / sqrtf(fmaxf(sq * (1.f / SGW) - mean * mean, 0.f) + LN_EPS);
        const float y0 = (bf_lo(S.v[s]) - mean) * rstd * S.gam.x + S.bet.x, y1 = (bf_hi(S.v[s]) - mean) * rstd * S.gam.y + S.bet.y;
        *(float2*)(F.out + OUT_SGV + (size_t)(b * DT + s) * SGW + col) = make_float2(y0, y1);
        const unsigned rb = pk2(y0, y1); v0[s] = bf_lo(rb); v1[s] = bf_hi(rb); }
#pragma unroll
    for (int t = 0; t < 8; ++t) { float m0 = 0.f, m1 = 0.f;
#pragma unroll
        for (int s = 0; s < 8; ++s) if (s <= t) { const float w = MIX_RDL(wr, 8 * t + s); m0 += v0[s] * w; m1 += v1[s] * w; }
        const float bb = MIX_RDL(S.bv, t); m0 += bb; m1 += bb;
        *(unsigned*)(A2 + (r0 + t) * PK2 + col) = pk2(bf_lo(S.u[t]) * m0, bf_hi(S.u[t]) * m1); }
}
__device__ __forceinline__ void mix_prompt_pair(Frame& F, int itA, int itB) {
    const int g = itA & 7; const int R0A = (itA >> 3) * SGC, R0B = (itB >> 3) * SGC;
    const bf16* Z = (const bf16*)(F.ws + WS_Z); const bf16* Wc = (const bf16*)(F.ws + WS_WC); const float* stat = (const float*)(F.ws + WS_STAT);
    LAS unsigned char* WL = F.lds; LAS unsigned char* VT = F.lds + 128 * MIX_PITCH;
    LAS float* RS = (LAS float*)(F.lds + 128 * MIX_PITCH + 256 * MIX_PITCH);
    const int hi = F.vcu * NWAVES + F.wave;
    float sm = 0.f, sq = 0.f; v4u wq[4]; MixS S;
    mix_sample_load(F, hi, S);
    if (F.tid < 2 * SGC) { const size_t r = (F.tid < SGC) ? (size_t)(R0A + F.tid) : (size_t)(R0B + F.tid - SGC); sm = stat[2 * r]; sq = stat[2 * r + 1]; }
#pragma unroll
    for (int i = 0; i < 4; ++i) { const int idx = F.tid + NTHR * i, t = idx >> 4, ch = idx & 15; wq[i] = *(const v4u*)(Wc + ((size_t)(g * SGC + t)) * SGC + ch * 8); }
    v4u vA[8], vB[8], uA[4][2], uB[4][2];
    mix_load_v(F, Z, R0A, g, vA); mix_load_u(F, Z, R0A, g, uA); mix_load_v(F, Z, R0B, g, vB);
    mix_sample_compute(F, hi, S);
    MIX_LDS_BARRIER();
    if (F.tid < 2 * SGC) { const float mean = sm * (1.f / SGW), var = fmaxf(sq * (1.f / SGW) - mean * mean, 0.f);
        RS[2 * F.tid] = mean; RS[2 * F.tid + 1] = 1.f / sqrtf(var + LN_EPS); }
#pragma unroll
    for (int i = 0; i < 4; ++i) { const int idx = F.tid + NTHR * i, t = idx >> 4, ch = idx & 15; *(LAS v4u*)(WL + t * MIX_PITCH + ch * 16) = wq[i]; }
    MIX_LDS_BARRIER();
    mix_transpose(F, g, vA, VT, RS);
    mix_load_u(F, Z, R0B, g, uB);
    MIX_LDS_BARRIER();
    mix_mma_epi(F, R0A, g, uA, WL, VT);
    MIX_LDS_BARRIER();
    mix_transpose(F, g, vB, VT, RS + 2 * SGC);
    MIX_LDS_BARRIER();
    mix_mma_epi(F, R0B, g, uB, WL, VT);
}
__device__ __forceinline__ void p11_mix(Frame& F) {
    constexpr int NPI = (MP / SGC) * SGG, NSH = 2 * DB * SGG;
    if (2 * F.G == NPI && F.G * NWAVES == NSH) mix_prompt_pair(F, F.vcu, F.vcu + F.G);
    else {
        for (int it = F.vcu; it < NPI; it += F.G) mix_prompt_item(F, it, it == F.vcu || (F.G & 7) != 0);
        const int gw = F.vcu * NWAVES + F.wave, NGW = F.G * NWAVES;
        for (int hi = gw; hi < NSH; hi += NGW) { MixS S; mix_sample_load(F, hi, S); mix_sample_compute(F, hi, S); }
    }
    __syncthreads();
}

struct Args { const float* in[21]; float* out; unsigned char* ws; int ph_lo, ph_hi, coop, pad; };
__global__ void __launch_bounds__(NTHR, 2) fwd_kernel(Args args) {
    extern __shared__ __attribute__((aligned(16))) unsigned char lds[];
    Frame F;
    F.lds = (LAS unsigned char*)lds;
    F.MISC = (volatile LAS unsigned*)(F.lds + MISC_OFF);
    F.tid = threadIdx.x; F.lane = F.tid & 63; F.wave = __builtin_amdgcn_readfirstlane(F.tid >> 6);
    F.G = gridDim.x; { const int bx = blockIdx.x; F.vcu = (F.G % 8 == 0) ? (bx % 8) * (F.G / 8) + bx / 8 : bx; }
#pragma unroll
    for (int i = 0; i < 21; ++i) F.in[i] = args.in[i];
    F.out = args.out; F.ws = args.ws; F.ctl = (unsigned*)(args.ws + WS_CTL);
    if (F.tid < 64) F.MISC[F.tid] = 0u;
    __syncthreads();
    XcdBarrier bar; bar.bar = F.ctl + CW_BAR; bar.x = 0; bar.st = nullptr;
    if (args.coop) bar = xcd_barrier_post(F.ctl + CW_BAR, F.MISC + 8);
    unsigned char* ws = F.ws;
    bf16* XB = (bf16*)(ws + WS_XB); bf16* A2 = (bf16*)(ws + WS_A2); bf16* HB = (bf16*)(ws + WS_HB);
    LAS unsigned char* ring = F.lds;

    const int lo = args.ph_lo, hi = args.ph_hi;
#define IN(k) (lo <= (k) && (k) < hi)
#define AGAIN(k) (IN(k) && (((PROBE_MASK) >> (k)) & 1))
#define SEAM(k) do { if (IN(k) && IN((k) + 1)) xcd_barrier(bar); } while (0)
#define GEMM_LN_B(INST, Amat, Bmat, Kdim, GAM, BET, OUTF, OUTB) { pg9::Gemm g{Amat, Bmat, M, DM, Kdim, (Kdim) + 64, (Kdim) + 64}; pg9::Order S; S.init(M, DM, F.G, (int)blockIdx.x); \
        pg9::PanelStats st{(unsigned*)(ws + WS_XCH), F.ctl + CW_LN + (INST) * LN_BANK, F.ctl + CW_TMO, LN_EPS}; pg9::EpiLn E{XB, PK2, ALPHA, GAM, BET, OUTF, OUTB, PK2, st}; \
        pg9::gemm_phase<pg9::EpiLn, false>(ring, g, S, E); }
#define GEMM_LN(k, INST, Amat, Bmat, Kdim, GAM, BET, OUTF, OUTB) if (IN(k)) GEMM_LN_B(INST, Amat, Bmat, Kdim, GAM, BET, OUTF, OUTB) SEAM(k)
#define GEMM_UP_B(l) { pg9::Gemm g{XB, (const bf16*)(ws + WS_W1) + (size_t)(l) * DFF * PK2, M, DFF, DM, PK2, PK2}; pg9::Order S; S.init(M, DFF, F.G, (int)blockIdx.x); pg9::EpiBf16<2> E{HB, PK8, nullptr}; \
        pg9::gemm_phase<pg9::EpiBf16<2>>(ring, g, S, E); }
#define GEMM_UP(k, l) if (IN(k)) GEMM_UP_B(l) if (AGAIN(k)) GEMM_UP_B(l) SEAM(k)
#define GEMM_IN_B { pg9::Gemm g{XB, (const bf16*)(ws + WS_WIN), M, NQKV, DM, PK2, PK2}; pg9::Order S; S.init(M, NQKV, F.G, (int)blockIdx.x); pg9::EpiBf16<0> E{(bf16*)(ws + WS_PROJ), NPROJ, nullptr}; \
        pg9::gemm_phase<pg9::EpiBf16<0>>(ring, g, S, E); }
#define GEMM_SG_B { pg9::Gemm g{XB, (const bf16*)(ws + WS_SGIN), M, 2 * SGW, DM, PK2, PK2}; pg9::Order S; S.init(M, 2 * SGW, F.G, (int)blockIdx.x); pg9::EpiSg E{(bf16*)(ws + WS_Z), 2 * SGW, F.in[9], (float*)(ws + WS_STAT)}; \
        pg9::gemm_phase<pg9::EpiSg>(ring, g, S, E); }
    if (IN(0)) p0_prologue(F); if (AGAIN(0)) p0_prologue(F);
    SEAM(0);
    if (IN(1)) GEMM_IN_B if (AGAIN(1)) GEMM_IN_B
    SEAM(1);
    if (IN(2)) p2a_gla_prep(F);
    SEAM(2);
    if (IN(3)) p2_gla(F, 0); if (AGAIN(3)) p2_gla(F, 1);
    SEAM(3);
    if (IN(4) && F.G == 256) {
        const int c = (int)blockIdx.x, wgid = (c & 7) * 32 + (c >> 3), pm0 = (wgid >> 6) * 8 + (wgid & 7), pn0 = (wgid & 63) >> 3;
        gate_panel_and_wait(F, pm0, pn0, F.ctl + CW_GATE); }
    GEMM_LN(4, 0, A2, (const bf16*)(ws + WS_WOUT), DM, F.in[17], F.in[18], (float*)nullptr, XB);
    GEMM_UP(5, 0);
    GEMM_LN(6, 1, HB, (const bf16*)(ws + WS_W2), DFF, F.in[19], F.in[20], (float*)nullptr, XB);
    if (IN(7)) GEMM_SG_B
    SEAM(7);
    if (IN(8)) p11_mix(F); if (AGAIN(8)) p11_mix(F);
    SEAM(8);
    GEMM_LN(9, 2, A2, (const bf16*)(ws + WS_SGOUT), SGW, F.in[17] + DM, F.in[18] + DM, (float*)nullptr, XB);
    GEMM_UP(10, 1);
    GEMM_LN(11, 3, HB, (const bf16*)(ws + WS_W2) + (size_t)DM * PK8, DFF, F.in[19] + DM, F.in[20] + DM, F.out + OUT_Y, (bf16*)nullptr);
#undef IN
#undef AGAIN
#undef SEAM
}

extern "C" void kernel_launch(void* const* d_in, const int* in_sizes, int n_in, void* d_out, int out_size, void* d_ws, size_t ws_size, hipStream_t stream) {
    static int grid = 0;
    if (grid == 0) {
        if (n_in != 21 || (size_t)out_size != OUT_END || ws_size < WS_END) { fprintf(stderr, "kernel_launch: unexpected shapes: n_in %d out %d ws %zu (need %zu)\n", n_in, out_size, ws_size, (size_t)WS_END); grid = -1; return; }
        int dev = 0, cus = 0, per_cu = 0;
        if (hipGetDevice(&dev) != hipSuccess || hipDeviceGetAttribute(&cus, hipDeviceAttributeMultiprocessorCount, dev) != hipSuccess) { fprintf(stderr, "kernel_launch: device query failed\n"); grid = -1; return; }
        if (hipFuncSetAttribute((const void*)fwd_kernel, hipFuncAttributeMaxDynamicSharedMemorySize, LDS_BYTES) != hipSuccess) { fprintf(stderr, "kernel_launch: hipFuncSetAttribute failed\n"); grid = -1; return; }
        if (hipOccupancyMaxActiveBlocksPerMultiprocessor(&per_cu, (const void*)fwd_kernel, NTHR, LDS_BYTES) != hipSuccess || per_cu < 1) { fprintf(stderr, "kernel_launch: occupancy query says %d blocks per CU\n", per_cu); per_cu = 1; }
        (void)hipGetLastError();
        grid = cus * 1;
    }
    if (grid < 0) return;
    if (hipMemsetAsync((char*)d_ws + WS_CTL, 0, CTL_ZERO_BYTES, stream) != hipSuccess) { fprintf(stderr, "kernel_launch: memset failed\n"); return; }
    Args a{};
    for (int i = 0; i < 21; ++i) a.in[i] = (const float*)d_in[i];
    a.out = (float*)d_out; a.ws = (unsigned char*)d_ws;
    if (N_LAUNCHES == 1) {
        a.ph_lo = 0; a.ph_hi = NPHASE; a.coop = 1;
        void* kargs[] = {&a};
        hipError_t e = hipLaunchCooperativeKernel((const void*)fwd_kernel, dim3(grid), dim3(NTHR), kargs, LDS_BYTES, stream);
        if (e != hipSuccess) fprintf(stderr, "kernel_launch: cooperative launch failed: %s (grid %d)\n", hipGetErrorString(e), grid);
    } else {
        for (int ph = 0; ph < NPHASE; ++ph) {
            a.ph_lo = ph; a.ph_hi = ph + 1; a.coop = 0;
            hipLaunchKernelGGL(fwd_kernel, dim3(grid), dim3(NTHR), LDS_BYTES, stream, a);
            const hipError_t le = hipPeekAtLastError();
            if (le != hipSuccess) { fprintf(stderr, "kernel_launch: launch %d failed: %s\n", ph, hipGetErrorName(le)); break; }
        }
    }
}
```

```cpp
#include <hip/hip_runtime.h>
#include <hip/hip_cooperative_groups.h>
#include <cstdio>
#include <cstdint>
namespace cg = cooperative_groups;

#ifndef PROBE_MASK
#define PROBE_MASK 0
#endif
#ifndef MK_N_LAUNCHES
#define MK_N_LAUNCHES 1
#endif

namespace pg8 {
#define PG8_LAS __attribute__((address_space(3)))
typedef unsigned short bf16_t;
typedef short bf16x8 __attribute__((ext_vector_type(8)));
typedef float f32x4 __attribute__((ext_vector_type(4)));
typedef float f32x2 __attribute__((ext_vector_type(2)));
typedef unsigned u32x4 __attribute__((ext_vector_type(4)));
constexpr int BM = 256, BK = 64, HALF = 128, HTB = HALF * BK * 2, STAGE_BYTES = 8 * HTB, NXCD = 8, WGM = 8;

__host__ __device__ __forceinline__ int lds_byte(int r, int c) { const int st = (r >> 4) * 2 + (c >> 5), rr = r & 15, cc = c & 31, ob = rr * 64 + cc * 2; return st * 1024 + (ob ^ (((ob >> 9) & 1) << 5)); }
__host__ __device__ __forceinline__ void stage_rc(int b, int& R, int& C) { const int st = b / 1024, sb = b % 1024, swz = sb ^ (((sb >> 9) & 1) << 5); R = (st >> 1) * 16 + swz / 64; C = (st & 1) * 32 + (swz % 64) / 2; }
__host__ __device__ __forceinline__ int perm32(int rho) { const int n = rho >> 4, i = rho & 15; return 8 * (i >> 2) + 4 * n + (i & 3); }

struct Unit { int pm, pn; };
struct Gemm { const bf16_t* A; const bf16_t* Bt; int M, N, K; };

struct StaticOrder {
    int nM, nN, nwg, G, c;
    __host__ __device__ void init(int M, int N, int G_, int c_) { nM = M / BM; nN = N / BM; nwg = nM * nN; G = G_; c = c_; }
    __host__ __device__ bool next(int i, Unit& u) const {
        const long L = (long)i * G + c; if (L >= nwg) return false;
        int wgid = (int)L; { const int q = nwg / NXCD, r = nwg % NXCD, xcd = wgid % NXCD, off = wgid / NXCD; wgid = (xcd < r ? xcd * (q + 1) : r * (q + 1) + (xcd - r) * q) + off; }
        const int nig = WGM * nN, gid = wgid / nig, fm = gid * WGM, gsz = (nM - fm) < WGM ? (nM - fm) : WGM;
        u.pm = fm + ((wgid % nig) % gsz); u.pn = (wgid % nig) / gsz; return true;
    }
    __device__ __forceinline__ void a_ready(const Unit&) const {}
    __device__ __forceinline__ void done(const Unit&) const {}
};

__device__ __forceinline__ unsigned cvt_pk_bf16(float lo, float hi) { unsigned r; asm volatile("v_cvt_pk_bf16_f32 %0, %1, %2" : "=v"(r) : "v"(lo), "v"(hi)); return r; }
__device__ __forceinline__ f32x2 gelu_pk(f32x2 v) {
    const f32x2 av = __builtin_elementwise_abs(v), d = av * 0.2316418882f + 1.0f;
    f32x2 t; t.x = __builtin_amdgcn_rcpf(d.x); t.y = __builtin_amdgcn_rcpf(d.y);
    f32x2 q = t * 0.5307027145f + (-0.7265760135f); q = q * t + 0.7107068705f; q = q * t + (-0.142248368f); q = q * t + 0.127414796f; q = q * t;
    const f32x2 s = (v * v) * (-0.72134752044f);
    f32x2 e; e.x = __builtin_amdgcn_exp2f(s.x); e.y = __builtin_amdgcn_exp2f(s.y);
    const f32x2 m = v * (q * e), r = v - m;
    f32x2 o; o.x = v.x < 0.f ? m.x : r.x; o.y = v.y < 0.f ? m.y : r.y; return o;
}

template <int ACT  > struct EpiBf16 {
    static constexpr bool PERM = true, AFTER_DRAIN = false;
    bf16_t* O; int ldc; const float* bias;
    __device__ __forceinline__ void operator()(const f32x4 (&acc)[2][2][4][2], const Unit& u, int wr, int wc, int fr, int fq) const {
        const int row0 = u.pm * BM + wr * 64 + fr; const int col0 = u.pn * BM + wc * 32 + 8 * fq;
        f32x4 bv[2][2];
#pragma unroll
        for (int bj = 0; bj < 2; ++bj)
#pragma unroll
            for (int n = 0; n < 2; ++n) bv[bj][n] = (ACT == 1) ? *(const f32x4*)(bias + col0 + bj * HALF + 4 * n) : (f32x4){0.f, 0.f, 0.f, 0.f};
#pragma unroll
        for (int ai = 0; ai < 2; ++ai)
#pragma unroll
            for (int m = 0; m < 4; ++m) { bf16_t* rowp = O + (size_t)(row0 + ai * HALF + m * 16) * ldc + col0;
#pragma unroll
                for (int bj = 0; bj < 2; ++bj) { f32x4 v0 = acc[ai][bj][m][0] + bv[bj][0], v1 = acc[ai][bj][m][1] + bv[bj][1];
                    if (ACT == 1) { f32x2 a = gelu_pk((f32x2){v0[0], v0[1]}), b = gelu_pk((f32x2){v0[2], v0[3]}), c = gelu_pk((f32x2){v1[0], v1[1]}), d = gelu_pk((f32x2){v1[2], v1[3]});
                        v0 = (f32x4){a.x, a.y, b.x, b.y}; v1 = (f32x4){c.x, c.y, d.x, d.y}; }
                    if (ACT == 2) {
#pragma unroll
                        for (int j = 0; j < 4; ++j) { const float p = fmaxf(v0[j], 0.f), q = fmaxf(v1[j], 0.f); v0[j] = p * p; v1[j] = q * q; } }
                    u32x4 w; w.x = cvt_pk_bf16(v0[0], v0[1]); w.y = cvt_pk_bf16(v0[2], v0[3]); w.z = cvt_pk_bf16(v1[0], v1[1]); w.w = cvt_pk_bf16(v1[2], v1[3]);
                    *(u32x4*)(rowp + bj * HALF) = w; } }
    }
};
struct EpiRes {
    static constexpr bool PERM = false, AFTER_DRAIN = false;
    float* out; int ldc; const float* resA; const float* resB; int split; float alpha;
    __device__ __forceinline__ void operator()(const f32x4 (&acc)[2][2][4][2], const Unit& u, int wr, int wc, int fr, int fq) const {
        const int row0 = u.pm * BM + wr * 64 + fr, col0 = u.pn * BM + wc * 32 + 4 * fq;
#pragma unroll
        for (int ai = 0; ai < 2; ++ai)
#pragma unroll
            for (int m = 0; m < 4; ++m) { const int row = row0 + ai * HALF + m * 16;
                const float* rp = (row < split ? resA + (size_t)row * ldc : resB + (size_t)(row - split) * ldc) + col0; float* op = out + (size_t)row * ldc + col0;
#pragma unroll
                for (int bj = 0; bj < 2; ++bj)
#pragma unroll
                    for (int n = 0; n < 2; ++n) { const f32x4 rv = *(const f32x4*)(rp + bj * HALF + n * 16); *(f32x4*)(op + bj * HALF + n * 16) = acc[ai][bj][m][n] + rv * alpha; } }
    }
};

template <class Epi, class Sched, bool ALIGN_EPI = false, bool SP2 = false>
__device__ __forceinline__ void gemm_phase(PG8_LAS unsigned char* lds, const Gemm g, const Sched& S, const Epi& E) {
    const int tid = threadIdx.x, wid = __builtin_amdgcn_readfirstlane(tid >> 6), lane = tid & 63, wr = wid >> 2, wc = wid & 3, fr = lane & 15, fq = lane >> 4;
    const int K = g.K, nt = K / BK;
    unsigned voffA[2], voffB[2];
#pragma unroll
    for (int i = 0; i < 2; ++i) { int R, C; stage_rc(tid * 16 + i * 8192, R, C); const int Rb = Epi::PERM ? ((R & ~31) + perm32(R & 31)) : R;
        voffA[i] = (unsigned)(R * K + C) * 2u; voffB[i] = (unsigned)(Rb * K + C) * 2u; }
    const size_t kstep = (size_t)(BK * 2);
    const size_t hstep = (size_t)HALF * K * 2;
    const size_t tstep = 2 * hstep;
    const unsigned ldsw = (unsigned)wid * 1024u;
    const int aoff = lds_byte(wr * 64 + fr, fq * 8), boff = lds_byte(wc * 32 + fr, fq * 8);
#define PG8_SA(b, h) (((b) * 2 + (h)) * HTB)
#define PG8_SB(b, h) ((4 + (b) * 2 + (h)) * HTB)
#define PG8_STAGE(bufoff, gbase, voff) do { _Pragma("unroll") for (int _i = 0; _i < 2; ++_i) \
        __builtin_amdgcn_global_load_lds((const unsigned*)((const char*)(gbase) + (voff)[_i]), (PG8_LAS unsigned*)(lds + (bufoff) + ldsw + _i * 8192), 16, 0, 0); } while (0)
#define PG8_LDA(dst, b, h) do { _Pragma("unroll") for (int m = 0; m < 4; ++m) _Pragma("unroll") for (int k = 0; k < 2; ++k) dst[m][k] = *(const PG8_LAS bf16x8*)(lds + PG8_SA(b, h) + aoff + m * 2048 + k * 1024); } while (0)
#define PG8_LDB(dst, b, h) do { _Pragma("unroll") for (int n = 0; n < 2; ++n) _Pragma("unroll") for (int k = 0; k < 2; ++k) dst[n][k] = *(const PG8_LAS bf16x8*)(lds + PG8_SB(b, h) + boff + n * 2048 + k * 1024); } while (0)
#define PG8_MMA(ai, bj, At, Bt) do { __builtin_amdgcn_s_setprio(1); _Pragma("unroll") for (int m = 0; m < 4; ++m) _Pragma("unroll") for (int n = 0; n < 2; ++n) _Pragma("unroll") for (int k = 0; k < 2; ++k) \
        acc[ai][bj][m][n] = __builtin_amdgcn_mfma_f32_16x16x32_bf16(Bt[n][k], At[m][k], acc[ai][bj][m][n], 0, 0, 0); __builtin_amdgcn_s_setprio(0); } while (0)
#define PG8_WAIT_V(n) asm volatile("s_waitcnt vmcnt(" #n ")" ::: "memory")
#define PG8_WAIT_L(n) asm volatile("s_waitcnt lgkmcnt(" #n ")" ::: "memory")
#define PG8_BAR __builtin_amdgcn_s_barrier()
#define PG8_SCHED __builtin_amdgcn_sched_barrier(0)
    Unit cur, nxt; int ui = 0;
    if (!S.next(0, cur)) return;
    f32x4 acc[2][2][4][2];
#pragma unroll
    for (int a = 0; a < 2; ++a)
#pragma unroll
        for (int b = 0; b < 2; ++b)
#pragma unroll
            for (int m = 0; m < 4; ++m)
#pragma unroll
                for (int n = 0; n < 2; ++n) acc[a][b][m][n] = (f32x4){0.f, 0.f, 0.f, 0.f};
    bf16x8 At[4][2], B0[2][2], B1[2][2];
    const char* cA = (const char*)g.A + (size_t)cur.pm * tstep; const char* cB = (const char*)g.Bt + (size_t)cur.pn * tstep;
    S.a_ready(cur);
    if constexpr (SP2) {
        PG8_STAGE(PG8_SB(0, 0), cB, voffB); PG8_STAGE(PG8_SB(0, 1), cB + hstep, voffB); PG8_STAGE(PG8_SA(0, 0), cA, voffA); PG8_STAGE(PG8_SA(0, 1), cA + hstep, voffA);
        if (wr == 1) PG8_BAR;
        PG8_WAIT_V(2); PG8_BAR;
        PG8_STAGE(PG8_SB(1, 0), cB + kstep, voffB); PG8_STAGE(PG8_SA(1, 0), cA + kstep, voffA); PG8_STAGE(PG8_SB(1, 1), cB + hstep + kstep, voffB);
        PG8_WAIT_V(6); PG8_BAR;
    } else {
        PG8_STAGE(PG8_SB(0, 0), cB, voffB); PG8_STAGE(PG8_SA(0, 0), cA, voffA); PG8_STAGE(PG8_SB(0, 1), cB + hstep, voffB); PG8_STAGE(PG8_SA(0, 1), cA + hstep, voffA);
        if (wr == 1) PG8_BAR;
        PG8_WAIT_V(4); PG8_BAR;
        PG8_STAGE(PG8_SB(1, 0), cB + kstep, voffB); PG8_STAGE(PG8_SA(1, 0), cA + kstep, voffA); PG8_STAGE(PG8_SB(1, 1), cB + hstep + kstep, voffB);
        PG8_WAIT_V(6); PG8_BAR;
    }
    for (;;) {
        const bool has_next = S.next(ui + 1, nxt);
        const char* nA = has_next ? (const char*)g.A + (size_t)nxt.pm * tstep : cA; const char* nB = has_next ? (const char*)g.Bt + (size_t)nxt.pn * tstep : cB;
        for (int t = 0; t < nt; t += 2) {
            const bool last = (t == nt - 2);
            const char* a1 = cA + (size_t)(t + 1) * kstep;
            const char* a2 = last ? nA : cA + (size_t)(t + 2) * kstep; const char* b2 = last ? nB : cB + (size_t)(t + 2) * kstep;
            const char* a3 = a2 + kstep; const char* b3 = b2 + kstep;
            if (last && has_next) S.a_ready(nxt);
            if constexpr (SP2) {
            PG8_LDB(B0, 0, 0); PG8_LDB(B1, 0, 1); PG8_SCHED; PG8_LDA(At, 0, 0); PG8_STAGE(PG8_SA(1, 1), a1 + hstep, voffA);
            PG8_WAIT_V(8); PG8_WAIT_L(0); PG8_BAR; PG8_MMA(0, 0, At, B0); PG8_MMA(0, 1, At, B1); PG8_BAR; PG8_SCHED;
            PG8_LDA(At, 0, 1); PG8_STAGE(PG8_SB(0, 0), b2, voffB); PG8_STAGE(PG8_SB(0, 1), b2 + hstep, voffB); PG8_STAGE(PG8_SA(0, 0), a2, voffA);
            PG8_WAIT_V(8); PG8_WAIT_L(0); PG8_BAR; PG8_MMA(1, 0, At, B0); PG8_MMA(1, 1, At, B1); PG8_BAR; PG8_SCHED;
            PG8_LDB(B0, 1, 0); PG8_LDB(B1, 1, 1); PG8_SCHED; PG8_LDA(At, 1, 0); PG8_STAGE(PG8_SA(0, 1), a2 + hstep, voffA);
            PG8_WAIT_V(8); PG8_WAIT_L(0); PG8_BAR; PG8_MMA(0, 0, At, B0); PG8_MMA(0, 1, At, B1); PG8_BAR; PG8_SCHED;
            PG8_LDA(At, 1, 1); PG8_STAGE(PG8_SB(1, 0), b3, voffB); PG8_STAGE(PG8_SB(1, 1), b3 + hstep, voffB); PG8_STAGE(PG8_SA(1, 0), a3, voffA);
            PG8_WAIT_V(8); PG8_WAIT_L(0); PG8_BAR; PG8_MMA(1, 0, At, B0); PG8_MMA(1, 1, At, B1); PG8_BAR; PG8_SCHED;
            } else {
            PG8_LDB(B0, 0, 0); PG8_SCHED; PG8_LDA(At, 0, 0); PG8_STAGE(PG8_SA(1, 1), a1 + hstep, voffA);
            PG8_WAIT_L(8); PG8_BAR; PG8_WAIT_L(0); PG8_MMA(0, 0, At, B0); PG8_BAR; PG8_SCHED;
            PG8_LDB(B1, 0, 1); PG8_STAGE(PG8_SB(0, 0), b2, voffB);
            PG8_BAR; PG8_WAIT_L(0); PG8_MMA(0, 1, At, B1); PG8_BAR;
            PG8_LDA(At, 0, 1); PG8_STAGE(PG8_SA(0, 0), a2, voffA);
            PG8_BAR; PG8_WAIT_L(0); PG8_MMA(1, 0, At, B0); PG8_BAR; PG8_SCHED;
            PG8_STAGE(PG8_SB(0, 1), b2 + hstep, voffB);
            PG8_WAIT_V(6); PG8_BAR; PG8_MMA(1, 1, At, B1); PG8_BAR;
            PG8_LDB(B0, 1, 0); PG8_SCHED; PG8_LDA(At, 1, 0); PG8_STAGE(PG8_SA(0, 1), a2 + hstep, voffA);
            PG8_WAIT_L(8); PG8_BAR; PG8_WAIT_L(0); PG8_MMA(0, 0, At, B0); PG8_BAR; PG8_SCHED;
            PG8_LDB(B1, 1, 1); PG8_STAGE(PG8_SB(1, 0), b3, voffB);
            PG8_BAR; PG8_WAIT_L(0); PG8_MMA(0, 1, At, B1); PG8_BAR;
            PG8_LDA(At, 1, 1); PG8_STAGE(PG8_SA(1, 0), a3, voffA);
            PG8_BAR; PG8_WAIT_L(0); PG8_MMA(1, 0, At, B0); PG8_BAR; PG8_SCHED;
            PG8_STAGE(PG8_SB(1, 1), b3 + hstep, voffB);
            PG8_WAIT_V(6); PG8_BAR; PG8_MMA(1, 1, At, B1); PG8_BAR;
            }
        }
        if constexpr (ALIGN_EPI) { if (wr == 0) PG8_BAR; }
        E(acc, cur, wr, wc, fr, fq); S.done(cur);
        if (!has_next) break;
#pragma unroll
        for (int a = 0; a < 2; ++a)
#pragma unroll
            for (int b = 0; b < 2; ++b)
#pragma unroll
                for (int m = 0; m < 4; ++m)
#pragma unroll
                    for (int n = 0; n < 2; ++n) acc[a][b][m][n] = (f32x4){0.f, 0.f, 0.f, 0.f};
        cur = nxt; cA = nA; cB = nB; ++ui;
        if constexpr (ALIGN_EPI) { if (wr == 1) PG8_BAR; }
    }
    PG8_WAIT_V(0);
    if constexpr (!ALIGN_EPI) { if (wr == 0) PG8_BAR; }
    PG8_BAR;
#undef PG8_SA
#undef PG8_SB
#undef PG8_STAGE
#undef PG8_LDA
#undef PG8_LDB
#undef PG8_MMA
#undef PG8_WAIT_V
#undef PG8_WAIT_L
#undef PG8_BAR
#undef PG8_SCHED
}
}

namespace pg9 {
using pg8::bf16_t; using pg8::bf16x8; using pg8::f32x4; using pg8::f32x2; using pg8::u32x4; using pg8::stage_rc; using pg8::lds_byte; using pg8::perm32; using pg8::cvt_pk_bf16; using pg8::gelu_pk;
constexpr int BMR = 288, BNC = 256, BK = 64, THIRD = 96, HALF = 128, ATB = THIRD * BK * 2, BHB = HALF * BK * 2, NXCD = 8, WGM = 8;
constexpr int STAGE_BYTES = 6 * ATB + 4 * BHB;
__device__ __forceinline__ void st16_wt(void* p, u32x4 v) { asm volatile("global_store_dwordx4 %0, %1, off sc1\n\ts_nop 2" :: "v"(p), "v"(v) : "memory"); }
struct Unit { int pm, pn; };
struct Gemm { const bf16_t* A; const bf16_t* Bt; int M, N, K, lda, ldb; };
struct Order {
    int nM, nN, nwg, G, c;
    __host__ __device__ void init(int M, int N, int G_, int c_) { nM = M / BMR; nN = N / BNC; nwg = nM * nN; G = G_; c = c_; }
    __host__ __device__ bool next(int i, Unit& u) const {
        const long L = (long)i * G + c; if (L >= nwg) return false;
        int wgid = (int)L; { const int q = nwg / NXCD, r = nwg % NXCD, xcd = wgid % NXCD, off = wgid / NXCD; wgid = (xcd < r ? xcd * (q + 1) : r * (q + 1) + (xcd - r) * q) + off; }
        const int nig = WGM * nN, gid = wgid / nig, fm = gid * WGM, gsz = (nM - fm) < WGM ? (nM - fm) : WGM;
        u.pm = fm + ((wgid % nig) % gsz); u.pn = (wgid % nig) / gsz; return true;
    }
};
template <int ACT  > struct EpiBf16 {
    static constexpr bool PERM = true, AFTER_DRAIN = false, INIT_ACC = false;
    bf16_t* O; int ldc; const float* bias; bool wt_last = true;
    __device__ __forceinline__ void operator()(const f32x4 (&acc)[3][2][3][2], const Unit& u, int wr, int wc, int fr, int fq, bool last) const {
        const bool wt = last && wt_last;
        const int row0 = u.pm * BMR + wr * 48 + fr; const int col0 = u.pn * BNC + wc * 32 + 8 * fq;
        f32x4 bv[2][2];
#pragma unroll
        for (int bj = 0; bj < 2; ++bj)
#pragma unroll
            for (int n = 0; n < 2; ++n) bv[bj][n] = (ACT == 1) ? *(const f32x4*)(bias + col0 + bj * HALF + 4 * n) : (f32x4){0.f, 0.f, 0.f, 0.f};
#pragma unroll
        for (int ai = 0; ai < 3; ++ai)
#pragma unroll
            for (int m = 0; m < 3; ++m) { bf16_t* rowp = O + (size_t)(row0 + ai * THIRD + m * 16) * ldc + col0;
#pragma unroll
                for (int bj = 0; bj < 2; ++bj) { f32x4 v0 = acc[ai][bj][m][0] + bv[bj][0], v1 = acc[ai][bj][m][1] + bv[bj][1];
                    if (ACT == 1) { f32x2 a = gelu_pk((f32x2){v0[0], v0[1]}), b = gelu_pk((f32x2){v0[2], v0[3]}), c = gelu_pk((f32x2){v1[0], v1[1]}), d = gelu_pk((f32x2){v1[2], v1[3]});
                        v0 = (f32x4){a.x, a.y, b.x, b.y}; v1 = (f32x4){c.x, c.y, d.x, d.y}; }
                    if (ACT == 2) {
#pragma unroll
                        for (int j = 0; j < 4; ++j) { const float p = fmaxf(v0[j], 0.f), q = fmaxf(v1[j], 0.f); v0[j] = p * p; v1[j] = q * q; } }
                    u32x4 w; w.x = cvt_pk_bf16(v0[0], v0[1]); w.y = cvt_pk_bf16(v0[2], v0[3]); w.z = cvt_pk_bf16(v1[0], v1[1]); w.w = cvt_pk_bf16(v1[2], v1[3]);
                    if (wt) st16_wt(rowp + bj * HALF, w); else *(u32x4*)(rowp + bj * HALF) = w; } }
    }
};
struct EpiRes {
    static constexpr bool PERM = false, AFTER_DRAIN = false, INIT_ACC = false;
    float* out; int ldc; const float* resA; const float* resB; int split; float alpha;
    __device__ __forceinline__ void operator()(const f32x4 (&acc)[3][2][3][2], const Unit& u, int wr, int wc, int fr, int fq) const {
        const int row0 = u.pm * BMR + wr * 48 + fr, col0 = u.pn * BNC + wc * 32 + 4 * fq;
#pragma unroll
        for (int ai = 0; ai < 3; ++ai)
#pragma unroll
            for (int m = 0; m < 3; ++m) { const int row = row0 + ai * THIRD + m * 16;
                const float* rp = (row < split ? resA + (size_t)row * ldc : resB + (size_t)(row - split) * ldc) + col0; float* op = out + (size_t)row * ldc + col0;
#pragma unroll
                for (int bj = 0; bj < 2; ++bj)
#pragma unroll
                    for (int n = 0; n < 2; ++n) { const f32x4 rv = *(const f32x4*)(rp + bj * HALF + n * 16); *(f32x4*)(op + bj * HALF + n * 16) = acc[ai][bj][m][n] + rv * alpha; } }
    }
};

struct EpiSg {
    static constexpr bool PERM = true, AFTER_DRAIN = false, INIT_ACC = false;
    bf16_t* O; int ldc; const float* bias; float* stat;
    __device__ __forceinline__ void operator()(const f32x4 (&acc)[3][2][3][2], const Unit& u, int wr, int wc, int fr, int fq, bool last) const {
        const bool wt = last;
        const int row0 = u.pm * BMR + wr * 48 + fr; const int col0 = u.pn * BNC + wc * 32 + 8 * fq;
        f32x4 bv[2][2];
#pragma unroll
        for (int bj = 0; bj < 2; ++bj)
#pragma unroll
            for (int n = 0; n < 2; ++n) bv[bj][n] = *(const f32x4*)(bias + col0 + bj * HALF + 4 * n);
        const bool vhalf = u.pn >= 8;
#pragma unroll
        for (int ai = 0; ai < 3; ++ai)
#pragma unroll
            for (int m = 0; m < 3; ++m) { const int row = row0 + ai * THIRD + m * 16; bf16_t* rowp = O + (size_t)row * ldc + col0; float s = 0.f, q = 0.f;
#pragma unroll
                for (int bj = 0; bj < 2; ++bj) { f32x4 v0 = acc[ai][bj][m][0] + bv[bj][0], v1 = acc[ai][bj][m][1] + bv[bj][1];
                    { f32x2 a = gelu_pk((f32x2){v0[0], v0[1]}), b = gelu_pk((f32x2){v0[2], v0[3]}), c = gelu_pk((f32x2){v1[0], v1[1]}), d = gelu_pk((f32x2){v1[2], v1[3]});
                        v0 = (f32x4){a.x, a.y, b.x, b.y}; v1 = (f32x4){c.x, c.y, d.x, d.y}; }
                    s += ((v0[0] + v0[1]) + (v0[2] + v0[3])) + ((v1[0] + v1[1]) + (v1[2] + v1[3]));
                    q += ((v0[0] * v0[0] + v0[1] * v0[1]) + (v0[2] * v0[2] + v0[3] * v0[3])) + ((v1[0] * v1[0] + v1[1] * v1[1]) + (v1[2] * v1[2] + v1[3] * v1[3]));
                    u32x4 w; w.x = cvt_pk_bf16(v0[0], v0[1]); w.y = cvt_pk_bf16(v0[2], v0[3]); w.z = cvt_pk_bf16(v1[0], v1[1]); w.w = cvt_pk_bf16(v1[2], v1[3]);
                    if (wt) st16_wt(rowp + bj * HALF, w); else *(u32x4*)(rowp + bj * HALF) = w; }
                if (vhalf) { s += __shfl_xor(s, 16); s += __shfl_xor(s, 32); q += __shfl_xor(q, 16); q += __shfl_xor(q, 32);
                    if (fq == 0) { (void)__hip_atomic_fetch_add(stat + 2 * (size_t)row, s, __ATOMIC_RELAXED, __HIP_MEMORY_SCOPE_AGENT); (void)__hip_atomic_fetch_add(stat + 2 * (size_t)row + 1, q, __ATOMIC_RELAXED, __HIP_MEMORY_SCOPE_AGENT); } } }
    }
};

struct PanelStats {
    unsigned* xbuf; unsigned* cnt; unsigned* tmo; float eps;
    __device__ __forceinline__ void run(const f32x4 (&v)[3][2][3][2], const Unit& u, int wr, int wc, int fr, int fq, PG8_LAS unsigned char* lds, int wid, int lane) const {
        PG8_LAS f32x2* P = (PG8_LAS f32x2*)lds;
        PG8_LAS f32x2* St = (PG8_LAS f32x2*)(lds + 9216);
#pragma unroll
        for (int ai = 0; ai < 3; ++ai)
#pragma unroll
            for (int m = 0; m < 3; ++m) {
                float s = 0.f;
#pragma unroll
                for (int bj = 0; bj < 2; ++bj)
#pragma unroll
                    for (int n = 0; n < 2; ++n) { const f32x4 x = v[ai][bj][m][n]; s += (x[0] + x[1]) + (x[2] + x[3]); }
                s += __shfl_xor(s, 16); s += __shfl_xor(s, 32);
                const float mw = s * (1.0f / 64.0f); float q = 0.f;
#pragma unroll
                for (int bj = 0; bj < 2; ++bj)
#pragma unroll
                    for (int n = 0; n < 2; ++n) { const f32x4 d = v[ai][bj][m][n] - mw; q += (d[0] * d[0] + d[1] * d[1]) + (d[2] * d[2] + d[3] * d[3]); }
                q += __shfl_xor(q, 16); q += __shfl_xor(q, 32);
                if (fq == 0) P[(ai * THIRD + wr * 48 + m * 16 + fr) * 4 + wc] = (f32x2){mw, q};
            }
        asm volatile("s_waitcnt lgkmcnt(0)" ::: "memory"); __builtin_amdgcn_s_barrier(); asm volatile("" ::: "memory");
        const int row = wid * 64 + lane;
        if (row < BMR) {
            const f32x2 a = P[row * 4 + 0], b = P[row * 4 + 1], c = P[row * 4 + 2], d = P[row * 4 + 3];
            const float mt = (a.x + b.x + c.x + d.x) * 0.25f;
            const float da = a.x - mt, db = b.x - mt, dc = c.x - mt, dd = d.x - mt;
            const float m2 = (a.y + b.y) + (c.y + d.y) + 64.0f * ((da * da + db * db) + (dc * dc + dd * dd));
            unsigned long long* slot = (unsigned long long*)xbuf + ((size_t)(u.pm * BMR + row) * 8 + u.pn);
            __hip_atomic_store(slot, ((unsigned long long)__float_as_uint(m2) << 32) | __float_as_uint(mt), __ATOMIC_RELAXED, __HIP_MEMORY_SCOPE_AGENT);
        }
        asm volatile("s_waitcnt vmcnt(0)" ::: "memory");
        if (lane == 0) __hip_atomic_fetch_add(cnt + 64 * u.pm, 1u, __ATOMIC_RELAXED, __HIP_MEMORY_SCOPE_AGENT);
        if (wid == 0) {
            unsigned sp = 0u;
            for (;;) {
                if ((unsigned)__builtin_amdgcn_readfirstlane(__hip_atomic_load(cnt + 64 * u.pm, __ATOMIC_RELAXED, __HIP_MEMORY_SCOPE_AGENT)) >= 64u) break;
                __builtin_amdgcn_s_sleep(2);
                if (++sp > (1u << 22)) { if (lane == 0) __hip_atomic_store(tmo, 1u, __ATOMIC_RELAXED, __HIP_MEMORY_SCOPE_AGENT); break; }
            }
            __builtin_amdgcn_fence(__ATOMIC_ACQUIRE, "agent");
        }
        asm volatile("s_waitcnt vmcnt(0) lgkmcnt(0)" ::: "memory"); __builtin_amdgcn_s_barrier(); asm volatile("" ::: "memory");
        if (row < BMR) {
            const unsigned long long* slot = (const unsigned long long*)xbuf + (size_t)(u.pm * BMR + row) * 8; float mt[8], m2[8]; float ms = 0.f;
#pragma unroll
            for (int t = 0; t < 8; ++t) { const unsigned long long w = __hip_atomic_load(slot + t, __ATOMIC_RELAXED, __HIP_MEMORY_SCOPE_AGENT); mt[t] = __uint_as_float((unsigned)w); m2[t] = __uint_as_float((unsigned)(w >> 32)); ms += mt[t]; }
            const float mean = ms * 0.125f; float q = 0.f;
#pragma unroll
            for (int t = 0; t < 8; ++t) { const float dm = mt[t] - mean; q += m2[t] + 256.0f * dm * dm; }
            St[row] = (f32x2){mean, 1.0f / sqrtf(q * (1.0f / 2048.0f) + eps)};
        }
        asm volatile("s_waitcnt lgkmcnt(0)" ::: "memory"); __builtin_amdgcn_s_barrier(); asm volatile("" ::: "memory");
    }
};
struct EpiLn {
    static constexpr bool PERM = true, AFTER_DRAIN = true, INIT_ACC = true;
    const bf16_t* res; int ldr; float alpha;
    const float* gam; const float* bet; float* outf; bf16_t* outb; int ldb16;
    PanelStats st;
    __device__ __forceinline__ void init_load(u32x4 (&rw)[3][3][2], const Unit& u, int wr, int wc, int fr, int fq) const {
        const int row0 = u.pm * BMR + wr * 48 + fr, col0 = u.pn * BNC + wc * 32 + 8 * fq;
#pragma unroll
        for (int ai = 0; ai < 3; ++ai)
#pragma unroll
            for (int m = 0; m < 3; ++m)
#pragma unroll
                for (int bj = 0; bj < 2; ++bj) rw[ai][m][bj] = *(const u32x4*)(res + (size_t)(row0 + ai * THIRD + m * 16) * ldr + col0 + bj * HALF);
    }
    __device__ __forceinline__ void init_acc(f32x4 (&acc)[3][2][3][2], const u32x4 (&rw)[3][3][2]) const {
#pragma unroll
        for (int ai = 0; ai < 3; ++ai)
#pragma unroll
            for (int m = 0; m < 3; ++m)
#pragma unroll
                for (int bj = 0; bj < 2; ++bj) { const u32x4 w = rw[ai][m][bj];
                    acc[ai][bj][m][0] = (f32x4){__uint_as_float(w.x << 16), __uint_as_float(w.x & 0xffff0000u), __uint_as_float(w.y << 16), __uint_as_float(w.y & 0xffff0000u)} * alpha;
                    acc[ai][bj][m][1] = (f32x4){__uint_as_float(w.z << 16), __uint_as_float(w.z & 0xffff0000u), __uint_as_float(w.w << 16), __uint_as_float(w.w & 0xffff0000u)} * alpha; }
    }
    __device__ __forceinline__ void fused(f32x4 (&acc)[3][2][3][2], const Unit& u, int wr, int wc, int fr, int fq, PG8_LAS unsigned char* lds, int wid, int lane) const {
        const PG8_LAS f32x2* St = (const PG8_LAS f32x2*)(lds + 9216);
        const int row0 = u.pm * BMR + wr * 48 + fr, col0 = u.pn * BNC + wc * 32 + 8 * fq;
        st.run(acc, u, wr, wc, fr, fq, lds, wid, lane);
#pragma unroll
        for (int bj = 0; bj < 2; ++bj) {
            const f32x4 g0 = *(const f32x4*)(gam + col0 + bj * HALF), g1 = *(const f32x4*)(gam + col0 + bj * HALF + 4), b0 = *(const f32x4*)(bet + col0 + bj * HALF), b1 = *(const f32x4*)(bet + col0 + bj * HALF + 4);
#pragma unroll
            for (int ai = 0; ai < 3; ++ai)
#pragma unroll
                for (int m = 0; m < 3; ++m) { const int rl = ai * THIRD + wr * 48 + m * 16 + fr; const f32x2 sr = St[rl]; const size_t off = (size_t)(u.pm * BMR + rl) * 2048 + col0 + bj * HALF;
                    const f32x4 y0 = (acc[ai][bj][m][0] - sr.x) * sr.y * g0 + b0, y1 = (acc[ai][bj][m][1] - sr.x) * sr.y * g1 + b1;
                    if (outf) { *(f32x4*)(outf + off) = y0; *(f32x4*)(outf + off + 4) = y1; }
                    if (outb) { u32x4 w; w.x = cvt_pk_bf16(y0[0], y0[1]); w.y = cvt_pk_bf16(y0[2], y0[3]); w.z = cvt_pk_bf16(y1[0], y1[1]); w.w = cvt_pk_bf16(y1[2], y1[3]); st16_wt(outb + (size_t)(u.pm * BMR + rl) * ldb16 + col0 + bj * HALF, w); }
                    asm volatile("" ::: "memory"); }
        }
    }
};

struct ListOrder { int first, stride, total, nM;
    __host__ __device__ bool next(int i, Unit& u) const { const int id = first + i * stride; if (id >= total) return false; u.pm = id % nM; u.pn = id / nM; return true; } };

template <class Epi, bool ALIGN_EPI = true, class Sched = Order>
__device__ __forceinline__ void gemm_phase(PG8_LAS unsigned char* lds, const Gemm g, const Sched& S, const Epi& E) {
    const int tid = threadIdx.x, wid = __builtin_amdgcn_readfirstlane(tid >> 6), lane = tid & 63, wr = wid >> 2, wc = wid & 3, fr = lane & 15, fq = lane >> 4;
    const int K = g.K, nt = K / BK;
    const int lda = g.lda, ldb = g.ldb;
    unsigned voffA0, voffA1, voffB[2];
    { int R, C; stage_rc((wid & 3) * 1024 + lane * 16, R, C); voffA0 = (unsigned)(R * lda + C) * 2u; stage_rc((wid + 4) * 1024 + lane * 16, R, C); voffA1 = (unsigned)(R * lda + C) * 2u; }
#pragma unroll
    for (int i = 0; i < 2; ++i) { int R, C; stage_rc(tid * 16 + i * 8192, R, C); const int Rb = Epi::PERM ? ((R & ~31) + perm32(R & 31)) : R; voffB[i] = (unsigned)(Rb * ldb + C) * 2u; }
    const size_t kstep = (size_t)(BK * 2);
    const size_t thstep = (size_t)THIRD * lda * 2, hstep = (size_t)HALF * ldb * 2;
    const size_t tstepA = 3 * thstep, tstepB = 2 * hstep;
    const unsigned ldsw = (unsigned)wid * 1024u;
    const int aoff = lds_byte(wr * 48 + fr, fq * 8), boff = lds_byte(wc * 32 + fr, fq * 8);
#define PG9_SA(b, a) (((b) * 3 + (a)) * ATB)
#define PG9_SB(b, h) (6 * ATB + ((b) * 2 + (h)) * BHB)
#define PG9_GLDS(gp, lp) __builtin_amdgcn_global_load_lds((const unsigned*)(gp), (PG8_LAS unsigned*)(lp), 16, 0, 0)
#define PG9_STAGE_A(slot, gbase) do { if (wr == 0) PG9_GLDS((const char*)(gbase) + voffA0, lds + (slot) + ldsw); PG9_GLDS((const char*)(gbase) + voffA1, lds + (slot) + ldsw + 4096); } while (0)
#define PG9_STAGE_B(slot, gbase) do { PG9_GLDS((const char*)(gbase) + voffB[0], lds + (slot) + ldsw); PG9_GLDS((const char*)(gbase) + voffB[1], lds + (slot) + ldsw + 8192); } while (0)
#define PG9_LDA(dst, b, a) do { _Pragma("unroll") for (int m = 0; m < 3; ++m) _Pragma("unroll") for (int k = 0; k < 2; ++k) dst[m][k] = *(const PG8_LAS bf16x8*)(lds + PG9_SA(b, a) + aoff + m * 2048 + k * 1024); } while (0)
#define PG9_LDB(dst, b, h) do { _Pragma("unroll") for (int n = 0; n < 2; ++n) _Pragma("unroll") for (int k = 0; k < 2; ++k) dst[n][k] = *(const PG8_LAS bf16x8*)(lds + PG9_SB(b, h) + boff + n * 2048 + k * 1024); } while (0)
#define PG9_MMA(ai, bj, At, Bt) do { _Pragma("unroll") for (int m = 0; m < 3; ++m) _Pragma("unroll") for (int n = 0; n < 2; ++n) _Pragma("unroll") for (int k = 0; k < 2; ++k) \
        acc[ai][bj][m][n] = __builtin_amdgcn_mfma_f32_16x16x32_bf16(Bt[n][k], At[m][k], acc[ai][bj][m][n], 0, 0, 0); } while (0)
#define PG9_MMA2(ai) do { __builtin_amdgcn_s_setprio(1); PG9_MMA(ai, 0, At, B0); PG9_MMA(ai, 1, At, B1); __builtin_amdgcn_s_setprio(0); } while (0)
#define PG9_WAIT_V2(a, b) do { if (wr == 0) asm volatile("s_waitcnt vmcnt(" #a ")" ::: "memory"); else asm volatile("s_waitcnt vmcnt(" #b ")" ::: "memory"); } while (0)
#define PG9_WAIT_L0 asm volatile("s_waitcnt lgkmcnt(0)" ::: "memory")
#define PG9_BAR __builtin_amdgcn_s_barrier()
#define PG9_SCHED __builtin_amdgcn_sched_barrier(0)
    Unit cur, nxt; int ui = 0;
    if (!S.next(0, cur)) return;
    f32x4 acc[3][2][3][2];
    u32x4 rinit[3][3][2];
    if constexpr (Epi::INIT_ACC) E.init_load(rinit, cur, wr, wc, fr, fq);
    else {
#pragma unroll
    for (int a = 0; a < 3; ++a)
#pragma unroll
        for (int b = 0; b < 2; ++b)
#pragma unroll
            for (int m = 0; m < 3; ++m)
#pragma unroll
                for (int n = 0; n < 2; ++n) acc[a][b][m][n] = (f32x4){0.f, 0.f, 0.f, 0.f};
    }
    bf16x8 At[3][2], B0[2][2], B1[2][2];
    const char* cA = (const char*)g.A + (size_t)cur.pm * tstepA; const char* cB = (const char*)g.Bt + (size_t)cur.pn * tstepB;
    PG9_STAGE_B(PG9_SB(0, 0), cB); PG9_STAGE_B(PG9_SB(0, 1), cB + hstep); PG9_STAGE_A(PG9_SA(0, 0), cA); PG9_STAGE_A(PG9_SA(0, 1), cA + thstep); PG9_STAGE_A(PG9_SA(0, 2), cA + 2 * thstep);
    if constexpr (Epi::INIT_ACC) { PG9_SCHED; E.init_acc(acc, rinit); PG9_SCHED; }
    if (wr == 1) PG9_BAR;
    PG9_WAIT_V2(4, 2); PG9_BAR;
    PG9_STAGE_B(PG9_SB(1, 0), cB + kstep); PG9_STAGE_B(PG9_SB(1, 1), cB + hstep + kstep); PG9_STAGE_A(PG9_SA(1, 0), cA + kstep); PG9_STAGE_A(PG9_SA(1, 1), cA + thstep + kstep);
    PG9_WAIT_V2(8, 6); PG9_BAR;
    for (;;) {
        const bool has_next = S.next(ui + 1, nxt);
        const char* nA = has_next ? (const char*)g.A + (size_t)nxt.pm * tstepA : cA; const char* nB = has_next ? (const char*)g.Bt + (size_t)nxt.pn * tstepB : cB;
        for (int t = 0; t < nt; t += 2) {
            const bool last = (t == nt - 2);
            const char* a1 = cA + (size_t)(t + 1) * kstep;
            const char* a2 = last ? nA : cA + (size_t)(t + 2) * kstep; const char* b2 = last ? nB : cB + (size_t)(t + 2) * kstep;
            const char* a3 = a2 + kstep; const char* b3 = b2 + kstep;
            PG9_LDB(B0, 0, 0); PG9_LDB(B1, 0, 1); PG9_SCHED; PG9_LDA(At, 0, 0); PG9_STAGE_A(PG9_SA(1, 2), a1 + 2 * thstep);
            PG9_WAIT_V2(12, 8); PG9_WAIT_L0; PG9_BAR; PG9_MMA2(0); PG9_BAR; PG9_SCHED;
            PG9_LDA(At, 0, 1); PG9_STAGE_B(PG9_SB(0, 0), b2); PG9_STAGE_B(PG9_SB(0, 1), b2 + hstep);
            PG9_WAIT_V2(14, 11); PG9_WAIT_L0; PG9_BAR; PG9_MMA2(1); PG9_BAR; PG9_SCHED;
            PG9_LDA(At, 0, 2); PG9_STAGE_A(PG9_SA(0, 0), a2); PG9_STAGE_A(PG9_SA(0, 1), a2 + thstep);
            PG9_WAIT_V2(12, 8); PG9_WAIT_L0; PG9_BAR; PG9_MMA2(2); PG9_BAR; PG9_SCHED;
            PG9_LDB(B0, 1, 0); PG9_LDB(B1, 1, 1); PG9_SCHED; PG9_LDA(At, 1, 0); PG9_STAGE_A(PG9_SA(0, 2), a2 + 2 * thstep);
            PG9_WAIT_V2(12, 8); PG9_WAIT_L0; PG9_BAR; PG9_MMA2(0); PG9_BAR; PG9_SCHED;
            PG9_LDA(At, 1, 1); PG9_STAGE_B(PG9_SB(1, 0), b3); PG9_STAGE_B(PG9_SB(1, 1), b3 + hstep);
            PG9_WAIT_V2(14, 11); PG9_WAIT_L0; PG9_BAR; PG9_MMA2(1); PG9_BAR; PG9_SCHED;
            PG9_LDA(At, 1, 2); PG9_STAGE_A(PG9_SA(1, 0), a3); PG9_STAGE_A(PG9_SA(1, 1), a3 + thstep);
            PG9_WAIT_V2(12, 8); PG9_WAIT_L0; PG9_BAR; PG9_MMA2(2); PG9_BAR; PG9_SCHED;
        }
        if constexpr (ALIGN_EPI) { if (wr == 0) PG9_BAR; }
        if constexpr (!Epi::AFTER_DRAIN) E(acc, cur, wr, wc, fr, fq, !has_next);
        if (!has_next) break;
#pragma unroll
        for (int a = 0; a < 3; ++a)
#pragma unroll
            for (int b = 0; b < 2; ++b)
#pragma unroll
                for (int m = 0; m < 3; ++m)
#pragma unroll
                    for (int n = 0; n < 2; ++n) acc[a][b][m][n] = (f32x4){0.f, 0.f, 0.f, 0.f};
        cur = nxt; cA = nA; cB = nB; ++ui;
        if constexpr (ALIGN_EPI) { if (wr == 1) PG9_BAR; }
    }
    asm volatile("s_waitcnt vmcnt(0)" ::: "memory");
    if constexpr (!ALIGN_EPI) { if (wr == 0) PG9_BAR; }
    PG9_BAR;
    if constexpr (Epi::AFTER_DRAIN) E.fused(acc, cur, wr, wc, fr, fq, lds, wid, lane);
#undef PG9_SA
#undef PG9_SB
#undef PG9_GLDS
#undef PG9_STAGE_A
#undef PG9_STAGE_B
#undef PG9_LDA
#undef PG9_LDB
#undef PG9_MMA
#undef PG9_MMA2
#undef PG9_WAIT_V2
#undef PG9_WAIT_L0
#undef PG9_BAR
#undef PG9_SCHED
}
}

constexpr int NWAVES = 8, NTHR = NWAVES * 64;
constexpr int N_LAUNCHES = MK_N_LAUNCHES;
constexpr int NPHASE = 12;
constexpr int DM = 2048, MP = 8192, MS = 1024, M = MP + MS;
constexpr int SEQ = 2048, NB = 4, DB = 128, DT = 8;
constexpr int NH = 4, HK = 256, HV = 512, KD = 1024, RANK = 16;
constexpr int NPROJ = 6144, NQKV = 4096, RG_WGS = 86, WIN_LD = 6160, DFF = 8192, SGW = 2048, SGG = 8, SGC = 128, SGD = 256;
constexpr int PK2 = DM + 64, PK8 = DFF + 64;
constexpr float ALPHA = 1.41421356237309515f;
constexpr float LN_EPS = 1e-5f, HN_EPS = 1e-6f;
constexpr size_t OUT_Y = 0, OUT_SP = (size_t)M * DM, OUT_SS = OUT_SP + (size_t)NB * NH * HK * HV, OUT_SGV = OUT_SS + (size_t)DB * NH * HK * HV, OUT_END = OUT_SGV + (size_t)MS * SGW;

constexpr size_t MiB = 1u << 20;
constexpr size_t WS_CTL = 0, CTL_ZERO_BYTES = 1 * MiB;
constexpr size_t WS_WIN = 1 * MiB;
constexpr size_t WS_WOUT = WS_WIN + 25 * MiB;
constexpr size_t WS_W1 = WS_WOUT + 9 * MiB;
constexpr size_t WS_W2 = WS_W1 + 66 * MiB;
constexpr size_t WS_SGIN = WS_W2 + 65 * MiB;
constexpr size_t WS_SGOUT = WS_SGIN + 17 * MiB;
constexpr size_t WS_WC = WS_SGOUT + 9 * MiB;
constexpr size_t WS_XB = WS_WC + 1 * MiB;
constexpr size_t WS_RA = WS_XB + 38 * MiB;
constexpr size_t WS_PROJ = WS_RA, WS_LOGA = WS_RA + 108 * MiB, WS_HB = WS_RA;
constexpr size_t WS_RB = WS_RA + 146 * MiB;
constexpr size_t WS_O = WS_RB, WS_Z = WS_RB;
constexpr size_t WS_A2 = WS_RB + 72 * MiB;
constexpr size_t WS_XCH = WS_A2 + 38 * MiB;
constexpr size_t WS_X1 = WS_XCH + 1 * MiB;
constexpr size_t WS_X2 = WS_X1 + 72 * MiB;
constexpr size_t WS_VN = WS_X2 + 72 * MiB;
constexpr size_t WS_STAT = WS_VN + 36 * MiB;
constexpr size_t WS_IMG = WS_STAT + 1 * MiB;
constexpr size_t WS_END = WS_IMG + 37 * MiB;
constexpr int CW_BAR = 4096;
constexpr int CW_QUEUE = 64;
constexpr int CW_TMO = 1;
constexpr int CW_GATE = 8192;
constexpr int CW_LN = 16384, LN_BANK = 32 * 64;

constexpr int RING_BYTES = 139264;
constexpr int LDS_BYTES = 147456;
constexpr int MISC_OFF = LDS_BYTES - 256;

#define GAS __attribute__((address_space(1)))
#define LAS __attribute__((address_space(3)))
typedef unsigned short bf16;
typedef unsigned v4u __attribute__((ext_vector_type(4)));
typedef unsigned v2u __attribute__((ext_vector_type(2)));
typedef float f32x4 __attribute__((ext_vector_type(4)));
typedef short bf16x8 __attribute__((ext_vector_type(8)));
#define RLX_AGENT __ATOMIC_RELAXED, __HIP_MEMORY_SCOPE_AGENT
#define LDS_WAIT() asm volatile("s_waitcnt lgkmcnt(0)" ::: "memory")
#define VM_WAIT() asm volatile("s_waitcnt vmcnt(0)" ::: "memory")
__device__ __forceinline__ unsigned pk2(float lo, float hi) { return pg8::cvt_pk_bf16(lo, hi); }
__device__ __forceinline__ float bf_lo(unsigned w) { return __uint_as_float(w << 16); }
__device__ __forceinline__ float bf_hi(unsigned w) { return __uint_as_float(w & 0xffff0000u); }
__device__ __forceinline__ float bf2f(bf16 b) { return __uint_as_float(((unsigned)b) << 16); }

#define XB_TMO      128
#define XB_XCNT(j)  (256  + 64 * (j))
#define XB_XSUB(j)  (1280 + 64 * (j))
#define XB_XGEN(j)  (2304 + 64 * (j))
#define XB_TOP      3328
#define XB_TOPGEN   3392
#define XCD_BAR_WORDS 3456
#define XB_SPIN_CAP (1u << 22)
__device__ __forceinline__ unsigned xb_ld(unsigned* p)              { return __hip_atomic_load(p, __ATOMIC_RELAXED, __HIP_MEMORY_SCOPE_AGENT); }
__device__ __forceinline__ unsigned xb_add(unsigned* p, unsigned v) { return __hip_atomic_fetch_add(p, v, __ATOMIC_RELAXED, __HIP_MEMORY_SCOPE_AGENT); }
__device__ __forceinline__ unsigned xb_xcc_id() { return (unsigned)__builtin_amdgcn_s_getreg((3 << 11) | 20) & 0xFu; }
#define XB_SPIN(cond, bar) do { unsigned _sp = 0; while (cond) { __builtin_amdgcn_s_sleep(1); \
    if ((++_sp & 255u) == 0u) { if (xb_ld(&(bar)[XB_TMO])) break; if (_sp > XB_SPIN_CAP) { atomicAdd(&(bar)[XB_TMO], 1u); break; } } } } while (0)
struct XcdBarrier { unsigned* bar; unsigned x; volatile LAS unsigned* st; };
__device__ __forceinline__ XcdBarrier xcd_barrier_post(unsigned* bar, volatile LAS unsigned* st) {
    XcdBarrier b; b.bar = bar; b.x = xb_xcc_id(); b.st = st;
    if (threadIdx.x == 0) (void)xb_add(&bar[XB_XCNT(b.x)], 1u);
    return b;
}
__device__ __forceinline__ void xcd_barrier_complete(unsigned* bar, unsigned x, unsigned& nloc, unsigned& nx) {
    const unsigned G = gridDim.x * gridDim.y * gridDim.z;
    unsigned sum, cnt, mine, sp = 0u;
    for (;;) {
        sum = 0u; cnt = 0u; mine = 0u;
#pragma unroll
        for (unsigned j = 0; j < 16; ++j) { const unsigned c = xb_ld(&bar[XB_XCNT(j)]); sum += c; cnt += (c > 0u) ? 1u : 0u; mine = (j == x) ? c : mine; }
        if (sum == G) break;
        __builtin_amdgcn_s_sleep(1);
        if ((++sp & 255u) == 0u) { if (xb_ld(&bar[XB_TMO])) break; if (sp > XB_SPIN_CAP) { atomicAdd(&bar[XB_TMO], 1u); break; } }
    }
    nloc = mine > 0u ? mine : 1u; nx = cnt > 0u ? cnt : 1u;
}
__device__ __forceinline__ void xcd_barrier(const XcdBarrier& b) {
    asm volatile("s_waitcnt vmcnt(0)" ::: "memory");
    __syncthreads();
    if (threadIdx.x == 0) {
        unsigned* bar = b.bar;
        __builtin_amdgcn_s_waitcnt(0);
        unsigned nloc = b.st[0], nx = b.st[1];
        if (nloc == 0u) { xcd_barrier_complete(bar, b.x, nloc, nx); b.st[0] = nloc; b.st[1] = nx; }
        const unsigned old = xb_add(&bar[XB_XSUB(b.x)], 1u);
        const unsigned gen = old / nloc;
        if (old + 1u == (gen + 1u) * nloc) {
            __builtin_amdgcn_fence(__ATOMIC_RELEASE, "agent");
            asm volatile("s_waitcnt vmcnt(0)" ::: "memory");
            const unsigned og = xb_add(&bar[XB_TOP], 1u);
            const unsigned tg = og / nx;
            if (og + 1u == (tg + 1u) * nx) xb_add(&bar[XB_TOPGEN], 1u);
            else XB_SPIN(xb_ld(&bar[XB_TOPGEN]) == tg, bar);
            __builtin_amdgcn_fence(__ATOMIC_ACQUIRE, "agent");
            xb_add(&bar[XB_XGEN(b.x)], 1u);
            asm volatile("s_waitcnt vmcnt(0)" ::: "memory");
        } else {
            XB_SPIN(xb_ld(&bar[XB_XGEN(b.x)]) == gen, bar);
            __builtin_amdgcn_fence(__ATOMIC_ACQUIRE, "agent");
            asm volatile("s_waitcnt vmcnt(0)" ::: "memory");
        }
    }
    __syncthreads();
}

struct Frame {
    LAS unsigned char* lds;
    volatile LAS unsigned* MISC;
    unsigned* ctl;
    int tid, lane, wave, vcu, G;
    const float* in[21];
    float* out;
    unsigned char* ws;
};
__device__ __forceinline__ float wave_sum(float v) {
#pragma unroll
    for (int o = 1; o < 64; o <<= 1) v += __shfl_xor(v, o);
    return v;
}
__device__ __forceinline__ const float* xrow_ptr(const Frame& F, int m) { return m < MP ? F.in[0] + (size_t)m * DM : F.in[1] + (size_t)(m - MP) * DM; }

__device__ __forceinline__ void p0_transpose_item(const float* W, int ldw, int ldk, bf16* WT, int item, int nblk, int lane) {
    const int kb = item / nblk, nb = item - kb * nblk, k0 = 64 * kb, n0 = 64 * nb, q = lane >> 4, c = lane & 15;
    f32x4 v[16];
    const float* src = W + (size_t)(k0 + 16 * q) * ldw + n0 + 4 * c;
#pragma unroll
    for (int i = 0; i < 16; ++i) v[i] = __builtin_nontemporal_load((const f32x4*)(src + (size_t)i * ldw));
#pragma unroll
    for (int j = 0; j < 4; ++j) {
        v4u lo, hi;
        lo.x = pk2(v[0][j], v[1][j]); lo.y = pk2(v[2][j], v[3][j]); lo.z = pk2(v[4][j], v[5][j]); lo.w = pk2(v[6][j], v[7][j]);
        hi.x = pk2(v[8][j], v[9][j]); hi.y = pk2(v[10][j], v[11][j]); hi.z = pk2(v[12][j], v[13][j]); hi.w = pk2(v[14][j], v[15][j]);
        bf16* dst = WT + (size_t)(n0 + 4 * c + j) * ldk + k0 + 16 * q;
        *(v4u*)dst = lo; *(v4u*)(dst + 8) = hi;
    }
}
constexpr int DT_I_WOUT = (DM / 64) * (DM / 64), DT_I_W1 = (DM / 64) * (DFF / 64), DT_I_W2 = (DFF / 64) * (DM / 64), DT_I_SGIN = (DM / 64) * (2 * SGW / 64), DT_I_SGOUT = (SGW / 64) * (DM / 64);
constexpr int DT_NITEMS = DT_I_WOUT + 2 * DT_I_W1 + 2 * DT_I_W2 + DT_I_SGIN + DT_I_SGOUT, DT_NCHUNK = DT_NITEMS / 64;
static_assert(DT_NITEMS % 64 == 0, "deferred transposes: whole chunks");
__device__ __forceinline__ void deferred_transpose_chunk(Frame& F, int chunk) {
    unsigned char* ws = F.ws;
    for (int i = 0; i < 8; ++i) {
        int r = chunk * 64 + F.wave * 8 + i;
        if (r < DT_I_WOUT) { p0_transpose_item(F.in[7], DM, PK2, (bf16*)(ws + WS_WOUT), r, DM / 64, F.lane); continue; } r -= DT_I_WOUT;
        if (r < 2 * DT_I_W1) { const int l = r / DT_I_W1; r -= l * DT_I_W1; p0_transpose_item(F.in[15] + (size_t)l * DM * DFF, DFF, PK2, (bf16*)(ws + WS_W1) + (size_t)l * DFF * PK2, r, DFF / 64, F.lane); continue; } r -= 2 * DT_I_W1;
        if (r < 2 * DT_I_W2) { const int l = r / DT_I_W2; r -= l * DT_I_W2; p0_transpose_item(F.in[16] + (size_t)l * DFF * DM, DM, PK8, (bf16*)(ws + WS_W2) + (size_t)l * DM * PK8, r, DM / 64, F.lane); continue; } r -= 2 * DT_I_W2;
        if (r < DT_I_SGIN) { p0_transpose_item(F.in[8], 2 * SGW, PK2, (bf16*)(ws + WS_SGIN), r, 2 * SGW / 64, F.lane); continue; } r -= DT_I_SGIN;
        p0_transpose_item(F.in[14], DM, PK2, (bf16*)(ws + WS_SGOUT), r, DM / 64, F.lane);
    }
}
__device__ __forceinline__ float logsigmoid_f(float x) { return fminf(x, 0.f) - log1pf(expf(-fabsf(x))); }
__device__ __forceinline__ float logsigmoid_fast(float x) { return fminf(x, 0.f) - __logf(1.0f + __expf(-fabsf(x))); }
__device__ __forceinline__ void p0_prologue(Frame& F) {
    const int gw = F.vcu * NWAVES + F.wave, NGW = F.G * NWAVES;
    unsigned char* ws = F.ws;
    {
        constexpr int I_WIN = (DM / 64) * (NPROJ / 64);
        for (int it = gw; it < I_WIN; it += NGW) p0_transpose_item(F.in[3], WIN_LD, PK2, (bf16*)(ws + WS_WIN), it, NPROJ / 64, F.lane);
    }
    {
        bf16* wc = (bf16*)(ws + WS_WC); const float* wsp = F.in[12];
        for (int i = F.vcu * NTHR + F.tid; i < SGG * SGC * SGC; i += F.G * NTHR) { const int s = i & 127, t = (i >> 7) & 127; wc[i] = (bf16)(pk2(s <= t ? wsp[i] : 0.f, 0.f) & 0xffffu); }
        float* stat = (float*)(ws + WS_STAT);
        for (int i = F.vcu * NTHR + F.tid; i < 2 * M; i += F.G * NTHR) stat[i] = 0.f;
    }
    {
        constexpr int WGP = DM + 4;
        LAS float* wgT = (LAS float*)F.lds;
        for (int idx = F.tid; idx < DM * 4; idx += NTHR) { const int k = idx >> 2, part = idx & 3; const f32x4 w = *(const f32x4*)(F.in[3] + (size_t)k * WIN_LD + NPROJ + 4 * part);
            wgT[(4 * part + 0) * WGP + k] = w.x; wgT[(4 * part + 1) * WGP + k] = w.y; wgT[(4 * part + 2) * WGP + k] = w.z; wgT[(4 * part + 3) * WGP + k] = w.w; }
        __syncthreads();
        const float* wgate = F.in[4]; const float* bgate = F.in[5];
        bf16* xb = (bf16*)(ws + WS_XB); float* loga = (float*)(ws + WS_LOGA);
        const int rows_wg = M / F.G;
        const int r_lo = (F.wave * rows_wg) / NWAVES, r_hi = ((F.wave + 1) * rows_wg) / NWAVES;
        const int lane = F.lane, fr = lane & 15, fq = lane >> 4;
        LAS float* GT = (LAS float*)(F.lds + 16 * WGP * 4);
        {
            const int kw = F.wave * 256, ntile = (rows_wg + 15) >> 4;
            pg8::bf16x8 bh[8], bl[8];
#pragma unroll
            for (int ks = 0; ks < 8; ++ks) { const f32x4 w0 = *(const LAS f32x4*)(wgT + fr * WGP + kw + 32 * ks + 8 * fq), w1 = *(const LAS f32x4*)(wgT + fr * WGP + kw + 32 * ks + 8 * fq + 4);
                const v4u h = (v4u){pk2(w0.x, w0.y), pk2(w0.z, w0.w), pk2(w1.x, w1.y), pk2(w1.z, w1.w)};
                const v4u l = (v4u){pk2(w0.x - bf_lo(h.x), w0.y - bf_hi(h.x)), pk2(w0.z - bf_lo(h.y), w0.w - bf_hi(h.y)), pk2(w1.x - bf_lo(h.z), w1.y - bf_hi(h.z)), pk2(w1.z - bf_lo(h.w), w1.w - bf_hi(h.w))};
                bh[ks] = __builtin_bit_cast(pg8::bf16x8, h); bl[ks] = __builtin_bit_cast(pg8::bf16x8, l); }
            __syncthreads();
            LAS f32x4* PS = (LAS f32x4*)F.lds;
            f32x4 xa[8][2];
            { const int row = fr < rows_wg ? fr : rows_wg - 1; const float* xp = xrow_ptr(F, F.vcu * rows_wg + row) + kw + 8 * fq;
#pragma unroll
              for (int ks = 0; ks < 8; ++ks) { xa[ks][0] = *(const f32x4*)(xp + 32 * ks); xa[ks][1] = *(const f32x4*)(xp + 32 * ks + 4); } }
            for (int rt = 0; rt < ntile; ++rt) {
                const int row = 16 * rt + fr; const bool valid = row < rows_wg; const int m = F.vcu * rows_wg + (valid ? row : rows_wg - 1);
                f32x4 xc[8][2];
#pragma unroll
                for (int ks = 0; ks < 8; ++ks) { xc[ks][0] = xa[ks][0]; xc[ks][1] = xa[ks][1]; }
                if (rt + 1 < ntile) { const int rown = 16 * (rt + 1) + fr; const float* xp = xrow_ptr(F, F.vcu * rows_wg + (rown < rows_wg ? rown : rows_wg - 1)) + kw + 8 * fq;
#pragma unroll
                    for (int ks = 0; ks < 8; ++ks) { xa[ks][0] = *(const f32x4*)(xp + 32 * ks); xa[ks][1] = *(const f32x4*)(xp + 32 * ks + 4); } }
                f32x4 acc = (f32x4){0.f, 0.f, 0.f, 0.f};
                bf16* xo = xb + (size_t)m * PK2 + kw + 8 * fq;
#pragma unroll
                for (int ks = 0; ks < 8; ++ks) { const f32x4 w0 = xc[ks][0], w1 = xc[ks][1];
                    const v4u h = (v4u){pk2(w0.x, w0.y), pk2(w0.z, w0.w), pk2(w1.x, w1.y), pk2(w1.z, w1.w)};
                    const v4u l = (v4u){pk2(w0.x - bf_lo(h.x), w0.y - bf_hi(h.x)), pk2(w0.z - bf_lo(h.y), w0.w - bf_hi(h.y)), pk2(w1.x - bf_lo(h.z), w1.y - bf_hi(h.z)), pk2(w1.z - bf_lo(h.w), w1.w - bf_hi(h.w))};
                    if (valid) *(v4u*)(xo + 32 * ks) = h;
                    const pg8::bf16x8 ah = __builtin_bit_cast(pg8::bf16x8, h), al = __builtin_bit_cast(pg8::bf16x8, l);
                    acc = __builtin_amdgcn_mfma_f32_16x16x32_bf16(ah, bh[ks], acc, 0, 0, 0);
                    acc = __builtin_amdgcn_mfma_f32_16x16x32_bf16(al, bh[ks], acc, 0, 0, 0);
                    acc = __builtin_amdgcn_mfma_f32_16x16x32_bf16(ah, bl[ks], acc, 0, 0, 0); }
                PS[(F.wave * ntile + rt) * 64 + lane] = acc;
            }
            __syncthreads();
            for (int idx = F.tid; idx < rows_wg * 16; idx += NTHR) { const int row = idx >> 4, r = idx & 15, rt = row >> 4, ml = row & 15; float t = 0.f;
#pragma unroll
                for (int w = 0; w < NWAVES; ++w) t += ((const LAS float*)(PS + (w * ntile + rt) * 64 + 16 * (ml >> 2) + r))[ml & 3];
                GT[row * 16 + r] = t; }
        }
        __syncthreads();
        LAS float* WG = (LAS float*)F.lds;
        LAS float* BG = WG + 16 * KD;
        for (int idx = F.tid; idx < 17 * KD / 4; idx += NTHR) *((LAS f32x4*)F.lds + idx) = (idx < 16 * KD / 4) ? *((const f32x4*)wgate + idx) : *((const f32x4*)bgate + (idx - 16 * KD / 4));
        __syncthreads();
        for (int rl = r_lo; rl < r_hi; ++rl) { const int m = F.vcu * rows_wg + rl;
            const f32x4 g0 = *(const LAS f32x4*)(GT + rl * 16), g1 = *(const LAS f32x4*)(GT + rl * 16 + 4), g2 = *(const LAS f32x4*)(GT + rl * 16 + 8), g3 = *(const LAS f32x4*)(GT + rl * 16 + 12);
            const float g[16] = {g0.x, g0.y, g0.z, g0.w, g1.x, g1.y, g1.z, g1.w, g2.x, g2.y, g2.z, g2.w, g3.x, g3.y, g3.z, g3.w};
#pragma unroll
            for (int j = 0; j < 4; ++j) { const int c0 = 4 * lane + 256 * j; f32x4 lg0 = *(const LAS f32x4*)(BG + c0);
#pragma unroll
                for (int r = 0; r < 16; ++r) { const f32x4 w = *(const LAS f32x4*)(WG + r * KD + c0); lg0 += w * g[r]; }
                f32x4 o;
                o.x = logsigmoid_fast(lg0.x) * 0.0625f; o.y = logsigmoid_fast(lg0.y) * 0.0625f; o.z = logsigmoid_fast(lg0.z) * 0.0625f; o.w = logsigmoid_fast(lg0.w) * 0.0625f; *(f32x4*)(loga + (size_t)m * KD + c0) = o;
                asm volatile("" ::: "memory"); }
        }
        __syncthreads();
    }
}

constexpr size_t IMG_QD = 0, IMG_KET = 32768, IMG_P = 65536, IMG_DV = 73728, IMG_BYTES = 74752;
constexpr int PP_QD = 0, PP_KI = 33792, PP_P = 67584, PP_RS = 76800;
constexpr int QD_PITCH = 528, T_PITCH = 144;
__device__ __forceinline__ pg8::bf16x8 as_bf16x8(v4u w) { return __builtin_bit_cast(pg8::bf16x8, w); }
__device__ __forceinline__ void gla_prep_item(Frame& F, int item) {
    const int n = item & 31, h = (item >> 5) & 3, b = item >> 7;
    const bf16* proj = (const bf16*)(F.ws + WS_PROJ); const float* loga = (const float*)(F.ws + WS_LOGA);
    unsigned char* img = F.ws + WS_IMG + (size_t)item * IMG_BYTES;
    LAS unsigned char* L = F.lds;
    const int tid = F.tid, lane = F.lane, w = F.wave, fr = lane & 15, fq = lane >> 4, cp = tid & 63, rg = tid >> 6;
    f32x4 lg[8]; v2u qr[8], kr[8];
    { const size_t R0 = (size_t)b * SEQ + (size_t)n * 64;
#pragma unroll
      for (int s = 0; s < 8; ++s) { const size_t row = R0 + 8 * rg + s;
          lg[s] = *(const f32x4*)(loga + row * KD + h * HK + 4 * cp); qr[s] = *(const v2u*)(proj + row * NPROJ + h * HK + 4 * cp); kr[s] = *(const v2u*)(proj + row * NPROJ + KD + h * HK + 4 * cp); } }
    __syncthreads();
    { f32x4 c = (f32x4){0.f, 0.f, 0.f, 0.f};
#pragma unroll
      for (int s = 0; s < 8; ++s) { c += lg[s]; lg[s] = c; }
      *((LAS f32x4*)(L + PP_RS) + rg * 64 + cp) = c; }
    __syncthreads();
    { f32x4 off = (f32x4){0.f, 0.f, 0.f, 0.f}, tot = (f32x4){0.f, 0.f, 0.f, 0.f};
#pragma unroll
      for (int r = 0; r < 8; ++r) { const f32x4 v = *((const LAS f32x4*)(L + PP_RS) + r * 64 + cp); tot += v; if (r < rg) off += v; }
      f32x4 ei; ei.x = __expf(-tot.x); ei.y = __expf(-tot.y); ei.z = __expf(-tot.z); ei.w = __expf(-tot.w);
      unsigned ke[4][4];
#pragma unroll
      for (int s2 = 0; s2 < 4; ++s2) { f32x4 kev[2]; unsigned qw[4];
#pragma unroll
          for (int u = 0; u < 2; ++u) { const int s = 2 * s2 + u; const f32x4 bb = off + lg[s], tb = tot - bb;
              f32x4 e1, e3; e1.x = __expf(bb.x); e1.y = __expf(bb.y); e1.z = __expf(bb.z); e1.w = __expf(bb.w); e3.x = __expf(tb.x); e3.y = __expf(tb.y); e3.z = __expf(tb.z); e3.w = __expf(tb.w);
              const f32x4 q4 = (f32x4){bf_lo(qr[s].x), bf_hi(qr[s].x), bf_lo(qr[s].y), bf_hi(qr[s].y)}, k4 = (f32x4){bf_lo(kr[s].x), bf_hi(kr[s].x), bf_lo(kr[s].y), bf_hi(kr[s].y)};
              const f32x4 qd = q4 * e1 * 0.0625f; kev[u] = k4 * e3; const f32x4 ki = kev[u] * ei;
              qw[2 * u] = pk2(qd.x, qd.y); qw[2 * u + 1] = pk2(qd.z, qd.w);
              *(LAS v2u*)(L + PP_QD + (8 * rg + s) * QD_PITCH + 8 * cp) = (v2u){qw[2 * u], qw[2 * u + 1]};
              *(LAS v2u*)(L + PP_KI + (8 * rg + s) * QD_PITCH + 8 * cp) = (v2u){pk2(ki.x, ki.y), pk2(ki.z, ki.w)}; }
          *((v4u*)(img + IMG_QD) + s2 * NTHR + tid) = (v4u){qw[0], qw[1], qw[2], qw[3]};
          ke[0][s2] = pk2(kev[0].x, kev[1].x); ke[1][s2] = pk2(kev[0].y, kev[1].y); ke[2][s2] = pk2(kev[0].z, kev[1].z); ke[3][s2] = pk2(kev[0].w, kev[1].w); }
#pragma unroll
      for (int c4 = 0; c4 < 4; ++c4) *((v4u*)(img + IMG_KET) + c4 * NTHR + tid) = (v4u){ke[c4][0], ke[c4][1], ke[c4][2], ke[c4][3]};
      if (rg == 0) { f32x4 dv; dv.x = __expf(tot.x); dv.y = __expf(tot.y); dv.z = __expf(tot.z); dv.w = __expf(tot.w); *((f32x4*)(img + IMG_DV) + cp) = dv; }
    }
    __syncthreads();
    { const int ttw = w >> 1, sp = w & 1;
      f32x4 sc0 = (f32x4){0.f, 0.f, 0.f, 0.f}, sc1 = (f32x4){0.f, 0.f, 0.f, 0.f};
      if (2 * sp <= ttw) {
#pragma unroll
          for (int ks = 0; ks < 8; ++ks) { const pg8::bf16x8 a = *(const LAS pg8::bf16x8*)(L + PP_QD + (16 * ttw + fr) * QD_PITCH + (32 * ks + 8 * fq) * 2);
              const pg8::bf16x8 b0 = *(const LAS pg8::bf16x8*)(L + PP_KI + (16 * (2 * sp) + fr) * QD_PITCH + (32 * ks + 8 * fq) * 2);
              sc0 = __builtin_amdgcn_mfma_f32_16x16x32_bf16(a, b0, sc0, 0, 0, 0);
              if (2 * sp + 1 <= ttw) { const pg8::bf16x8 b1 = *(const LAS pg8::bf16x8*)(L + PP_KI + (16 * (2 * sp + 1) + fr) * QD_PITCH + (32 * ks + 8 * fq) * 2);
                  sc1 = __builtin_amdgcn_mfma_f32_16x16x32_bf16(a, b1, sc1, 0, 0, 0); } } }
#pragma unroll
      for (int r = 0; r < 4; ++r) { const int tl = 4 * fq + r;
          float v0 = sc0[r], v1 = sc1[r];
          if (2 * sp > ttw || (2 * sp == ttw && fr > tl)) v0 = 0.f;
          if (2 * sp + 1 > ttw || (2 * sp + 1 == ttw && fr > tl)) v1 = 0.f;
          *(LAS unsigned short*)(L + PP_P + (16 * ttw + tl) * T_PITCH + (16 * (2 * sp) + fr) * 2) = (unsigned short)(pk2(v0, 0.f) & 0xffffu);
          *(LAS unsigned short*)(L + PP_P + (16 * ttw + tl) * T_PITCH + (16 * (2 * sp + 1) + fr) * 2) = (unsigned short)(pk2(v1, 0.f) & 0xffffu); } }
    __syncthreads();
    *((v4u*)(img + IMG_P) + tid) = *(const LAS v4u*)(L + PP_P + (tid >> 3) * T_PITCH + (tid & 7) * 16);
}
__device__ __forceinline__ void p2a_gla_prep(Frame& F) {
    for (int it = F.vcu; it < NB * NH * (SEQ / 64); it += F.G) gla_prep_item(F, it);
    __syncthreads();
}
constexpr int SC_QD = 0, SC_KET = 33792, SC_VT = 70656, SC_P = 79872, SC_DV = 89088, SC_OX = 90112, SC_END = 106496;
static_assert(SC_END <= MISC_OFF && PP_RS + 8192 <= MISC_OFF, "GLA LDS maps");
__device__ __forceinline__ void gla_prompt_item(Frame& F, int item) {
    const int j = item & 7, h = (item >> 3) & 3, b = item >> 5;
    const bf16* proj = (const bf16*)(F.ws + WS_PROJ); bf16* O = (bf16*)(F.ws + WS_O);
    const unsigned char* img0 = F.ws + WS_IMG + (size_t)((b * NH + h) * (SEQ / 64)) * IMG_BYTES;
    LAS unsigned char* L = F.lds;
    const int tid = F.tid, lane = F.lane, w = F.wave, fr = lane & 15, fq = lane >> 4, cp = tid & 63, rg = tid >> 6;
    const int kh = w >> 2, vt = w & 3;
    f32x4 S[8];
#pragma unroll
    for (int i = 0; i < 8; ++i) S[i] = (f32x4){0.f, 0.f, 0.f, 0.f};
    v4u qdA[4], keA[4], ppA, vrA, qdB[4], keB[4], ppB, vrB; f32x4 dvA = (f32x4){0.f, 0.f, 0.f, 0.f}, dvB = (f32x4){0.f, 0.f, 0.f, 0.f};
#define SC_LOAD(n_, QD_, KE_, PP_, DV_, VR_) do { const unsigned char* im_ = img0 + (size_t)(n_) * IMG_BYTES; \
        _Pragma("unroll") for (int i_ = 0; i_ < 4; ++i_) { QD_[i_] = *((const v4u*)(im_ + IMG_QD) + i_ * NTHR + tid); KE_[i_] = *((const v4u*)(im_ + IMG_KET) + i_ * NTHR + tid); } \
        PP_ = *((const v4u*)(im_ + IMG_P) + tid); if (rg == 0) DV_ = *((const f32x4*)(im_ + IMG_DV) + cp); \
        VR_ = *(const v4u*)(proj + ((size_t)b * SEQ + (size_t)(n_) * 64 + lane) * NPROJ + 2 * KD + h * HV + j * 64 + 8 * w); } while (0)
    SC_LOAD(0, qdA, keA, ppA, dvA, vrA);
    SC_LOAD(1, qdB, keB, ppB, dvB, vrB);
    __syncthreads();
    for (int n = 0; n < SEQ / 64; n += 2) {
#pragma unroll
        for (int s2 = 0; s2 < 4; ++s2) { *(LAS v2u*)(L + SC_QD + (8 * rg + 2 * s2) * QD_PITCH + 8 * cp) = (v2u){qdA[s2].x, qdA[s2].y}; *(LAS v2u*)(L + SC_QD + (8 * rg + 2 * s2 + 1) * QD_PITCH + 8 * cp) = (v2u){qdA[s2].z, qdA[s2].w}; }
#pragma unroll
        for (int c4 = 0; c4 < 4; ++c4) *(LAS v4u*)(L + SC_KET + (4 * cp + c4) * T_PITCH + 16 * rg) = keA[c4];
        *(LAS v4u*)(L + SC_P + (tid >> 3) * T_PITCH + (tid & 7) * 16) = ppA;
        if (rg == 0) *((LAS f32x4*)(L + SC_DV) + cp) = dvA;
        { LAS unsigned short* col = (LAS unsigned short*)(L + SC_VT + (8 * w) * T_PITCH + 2 * lane);
          col[0 * (T_PITCH / 2)] = (unsigned short)(vrA.x & 0xffffu); col[1 * (T_PITCH / 2)] = (unsigned short)(vrA.x >> 16); col[2 * (T_PITCH / 2)] = (unsigned short)(vrA.y & 0xffffu); col[3 * (T_PITCH / 2)] = (unsigned short)(vrA.y >> 16);
          col[4 * (T_PITCH / 2)] = (unsigned short)(vrA.z & 0xffffu); col[5 * (T_PITCH / 2)] = (unsigned short)(vrA.z >> 16); col[6 * (T_PITCH / 2)] = (unsigned short)(vrA.w & 0xffffu); col[7 * (T_PITCH / 2)] = (unsigned short)(vrA.w >> 16); }
        if ((n) + 2 < SEQ / 64) SC_LOAD((n) + 2, qdA, keA, ppA, dvA, vrA);
        __syncthreads();
        { f32x4 Oa[4];
#pragma unroll
        for (int tt = 0; tt < 4; ++tt) Oa[tt] = (f32x4){0.f, 0.f, 0.f, 0.f};
#pragma unroll
        for (int ks = 0; ks < 4; ++ks) {
            const pg8::bf16x8 Bv = as_bf16x8((v4u){pk2(S[2 * ks][0], S[2 * ks][1]), pk2(S[2 * ks][2], S[2 * ks][3]), pk2(S[2 * ks + 1][0], S[2 * ks + 1][1]), pk2(S[2 * ks + 1][2], S[2 * ks + 1][3])});
#pragma unroll
            for (int tt = 0; tt < 4; ++tt) { const v2u lo = *(const LAS v2u*)(L + SC_QD + (16 * tt + fr) * QD_PITCH + (128 * kh + 32 * ks + 4 * fq) * 2), hi = *(const LAS v2u*)(L + SC_QD + (16 * tt + fr) * QD_PITCH + (128 * kh + 32 * ks + 16 + 4 * fq) * 2);
                Oa[tt] = __builtin_amdgcn_mfma_f32_16x16x32_bf16(as_bf16x8((v4u){lo.x, lo.y, hi.x, hi.y}), Bv, Oa[tt], 0, 0, 0); } }
        if (kh == 1) {
#pragma unroll
            for (int tt = 0; tt < 4; ++tt)
#pragma unroll
                for (int r = 0; r < 4; ++r) *(LAS float*)(L + SC_OX + ((vt * 64 + 16 * tt + 4 * fq + r) * 16 + fr) * 4) = Oa[tt][r]; }
        __syncthreads();
        pg8::bf16x8 Vb[2];
#pragma unroll
        for (int k2 = 0; k2 < 2; ++k2) Vb[k2] = *(const LAS pg8::bf16x8*)(L + SC_VT + (16 * vt + fr) * T_PITCH + (32 * k2 + 8 * fq) * 2);
        if (kh == 0) {
#pragma unroll
            for (int tt = 0; tt < 4; ++tt) {
#pragma unroll
                for (int r = 0; r < 4; ++r) Oa[tt][r] += *(const LAS float*)(L + SC_OX + ((vt * 64 + 16 * tt + 4 * fq + r) * 16 + fr) * 4);
#pragma unroll
                for (int k2 = 0; k2 < 2; ++k2) { if (32 * k2 > 16 * tt + 15) continue;
                    const pg8::bf16x8 a = *(const LAS pg8::bf16x8*)(L + SC_P + (16 * tt + fr) * T_PITCH + (32 * k2 + 8 * fq) * 2);
                    Oa[tt] = __builtin_amdgcn_mfma_f32_16x16x32_bf16(a, Vb[k2], Oa[tt], 0, 0, 0); } }
            bf16* op = O + ((size_t)b * SEQ + (size_t)(n) * 64 + 4 * fq) * DM + h * HV + j * 64 + 16 * vt + fr;
#pragma unroll
            for (int tt = 0; tt < 4; ++tt)
#pragma unroll
                for (int r = 0; r < 4; ++r) op[(size_t)(16 * tt + r) * DM] = (bf16)(pk2(Oa[tt][r], 0.f) & 0xffffu); }
#pragma unroll
        for (int kt = 0; kt < 8; ++kt) { const f32x4 d4 = *(const LAS f32x4*)(L + SC_DV + (128 * kh + 16 * kt + 4 * fq) * 4); S[kt] = S[kt] * d4;
#pragma unroll
            for (int k2 = 0; k2 < 2; ++k2) { const pg8::bf16x8 a = *(const LAS pg8::bf16x8*)(L + SC_KET + (128 * kh + 16 * kt + fr) * T_PITCH + (32 * k2 + 8 * fq) * 2);
                S[kt] = __builtin_amdgcn_mfma_f32_16x16x32_bf16(a, Vb[k2], S[kt], 0, 0, 0); } }
        }
        __syncthreads();
#pragma unroll
        for (int s2 = 0; s2 < 4; ++s2) { *(LAS v2u*)(L + SC_QD + (8 * rg + 2 * s2) * QD_PITCH + 8 * cp) = (v2u){qdB[s2].x, qdB[s2].y}; *(LAS v2u*)(L + SC_QD + (8 * rg + 2 * s2 + 1) * QD_PITCH + 8 * cp) = (v2u){qdB[s2].z, qdB[s2].w}; }
#pragma unroll
        for (int c4 = 0; c4 < 4; ++c4) *(LAS v4u*)(L + SC_KET + (4 * cp + c4) * T_PITCH + 16 * rg) = keB[c4];
        *(LAS v4u*)(L + SC_P + (tid >> 3) * T_PITCH + (tid & 7) * 16) = ppB;
        if (rg == 0) *((LAS f32x4*)(L + SC_DV) + cp) = dvB;
        { LAS unsigned short* col = (LAS unsigned short*)(L + SC_VT + (8 * w) * T_PITCH + 2 * lane);
          col[0 * (T_PITCH / 2)] = (unsigned short)(vrB.x & 0xffffu); col[1 * (T_PITCH / 2)] = (unsigned short)(vrB.x >> 16); col[2 * (T_PITCH / 2)] = (unsigned short)(vrB.y & 0xffffu); col[3 * (T_PITCH / 2)] = (unsigned short)(vrB.y >> 16);
          col[4 * (T_PITCH / 2)] = (unsigned short)(vrB.z & 0xffffu); col[5 * (T_PITCH / 2)] = (unsigned short)(vrB.z >> 16); col[6 * (T_PITCH / 2)] = (unsigned short)(vrB.w & 0xffffu); col[7 * (T_PITCH / 2)] = (unsigned short)(vrB.w >> 16); }
        if ((n + 1) + 2 < SEQ / 64) SC_LOAD((n + 1) + 2, qdB, keB, ppB, dvB, vrB);
        __syncthreads();
        { f32x4 Oa[4];
#pragma unroll
        for (int tt = 0; tt < 4; ++tt) Oa[tt] = (f32x4){0.f, 0.f, 0.f, 0.f};
#pragma unroll
        for (int ks = 0; ks < 4; ++ks) {
            const pg8::bf16x8 Bv = as_bf16x8((v4u){pk2(S[2 * ks][0], S[2 * ks][1]), pk2(S[2 * ks][2], S[2 * ks][3]), pk2(S[2 * ks + 1][0], S[2 * ks + 1][1]), pk2(S[2 * ks + 1][2], S[2 * ks + 1][3])});
#pragma unroll
            for (int tt = 0; tt < 4; ++tt) { const v2u lo = *(const LAS v2u*)(L + SC_QD + (16 * tt + fr) * QD_PITCH + (128 * kh + 32 * ks + 4 * fq) * 2), hi = *(const LAS v2u*)(L + SC_QD + (16 * tt + fr) * QD_PITCH + (128 * kh + 32 * ks + 16 + 4 * fq) * 2);
                Oa[tt] = __builtin_amdgcn_mfma_f32_16x16x32_bf16(as_bf16x8((v4u){lo.x, lo.y, hi.x, hi.y}), Bv, Oa[tt], 0, 0, 0); } }
        if (kh == 1) {
#pragma unroll
            for (int tt = 0; tt < 4; ++tt)
#pragma unroll
                for (int r = 0; r < 4; ++r) *(LAS float*)(L + SC_OX + ((vt * 64 + 16 * tt + 4 * fq + r) * 16 + fr) * 4) = Oa[tt][r]; }
        __syncthreads();
        pg8::bf16x8 Vb[2];
#pragma unroll
        for (int k2 = 0; k2 < 2; ++k2) Vb[k2] = *(const LAS pg8::bf16x8*)(L + SC_VT + (16 * vt + fr) * T_PITCH + (32 * k2 + 8 * fq) * 2);
        if (kh == 0) {
#pragma unroll
            for (int tt = 0; tt < 4; ++tt) {
#pragma unroll
                for (int r = 0; r < 4; ++r) Oa[tt][r] += *(const LAS float*)(L + SC_OX + ((vt * 64 + 16 * tt + 4 * fq + r) * 16 + fr) * 4);
#pragma unroll
                for (int k2 = 0; k2 < 2; ++k2) { if (32 * k2 > 16 * tt + 15) continue;
                    const pg8::bf16x8 a = *(const LAS pg8::bf16x8*)(L + SC_P + (16 * tt + fr) * T_PITCH + (32 * k2 + 8 * fq) * 2);
                    Oa[tt] = __builtin_amdgcn_mfma_f32_16x16x32_bf16(a, Vb[k2], Oa[tt], 0, 0, 0); } }
            bf16* op = O + ((size_t)b * SEQ + (size_t)(n + 1) * 64 + 4 * fq) * DM + h * HV + j * 64 + 16 * vt + fr;
#pragma unroll
            for (int tt = 0; tt < 4; ++tt)
#pragma unroll
                for (int r = 0; r < 4; ++r) op[(size_t)(16 * tt + r) * DM] = (bf16)(pk2(Oa[tt][r], 0.f) & 0xffffu); }
#pragma unroll
        for (int kt = 0; kt < 8; ++kt) { const f32x4 d4 = *(const LAS f32x4*)(L + SC_DV + (128 * kh + 16 * kt + 4 * fq) * 4); S[kt] = S[kt] * d4;
#pragma unroll
            for (int k2 = 0; k2 < 2; ++k2) { const pg8::bf16x8 a = *(const LAS pg8::bf16x8*)(L + SC_KET + (128 * kh + 16 * kt + fr) * T_PITCH + (32 * k2 + 8 * fq) * 2);
                S[kt] = __builtin_amdgcn_mfma_f32_16x16x32_bf16(a, Vb[k2], S[kt], 0, 0, 0); } }
        }
        __syncthreads();
    }
#undef SC_LOAD
    { float* SP = F.out + OUT_SP + ((size_t)(b * NH + h) * HK + 128 * kh + 4 * fq) * HV + j * 64 + 16 * vt + fr;
#pragma unroll
      for (int kt = 0; kt < 8; ++kt)
#pragma unroll
          for (int r = 0; r < 4; ++r) SP[(size_t)(16 * kt + r) * HV] = S[kt][r]; }
}
__device__ __forceinline__ void gla_sample_item(Frame& F, int item) {
    const int h = item & 3, b = item >> 2;
    const bf16* proj = (const bf16*)(F.ws + WS_PROJ); const float* loga = (const float*)(F.ws + WS_LOGA); bf16* O = (bf16*)(F.ws + WS_O);
    LAS float* AT = (LAS float*)F.lds;
    LAS float* KT = AT + 256 * 8;
    LAS float* QT = KT + 256 * 8;
    LAS float* VV = QT + 256 * 8;
    LAS float* RED = VV + 8 * 512;
    const size_t r0 = (size_t)MP + (size_t)b * DT;
    const int c4 = F.tid & 127, kg = F.tid >> 7;
    const f32x4* S0 = (const f32x4*)(F.in[2] + (size_t)(b * NH + h) * HK * HV) + c4;
    f32x4* S1 = (f32x4*)(F.out + OUT_SS + (size_t)(b * NH + h) * HK * HV) + c4;
    f32x4 s[8];
#pragma unroll
    for (int u = 0; u < 8; ++u) s[u] = __builtin_nontemporal_load(S0 + (size_t)(kg * 64 + u) * 128);
    for (int idx = F.tid; idx < 8 * 256; idx += NTHR) { const int t = idx >> 8, k = idx & 255; const size_t row = r0 + t;
        AT[k * 8 + t] = __expf(loga[row * KD + h * HK + k]); KT[k * 8 + t] = bf2f(proj[row * NPROJ + KD + h * HK + k]); QT[k * 8 + t] = bf2f(proj[row * NPROJ + h * HK + k]) * 0.0625f; }
    for (int idx = F.tid; idx < 8 * 512; idx += NTHR) { const int t = idx >> 9, v = idx & 511; VV[idx] = bf2f(proj[(r0 + t) * NPROJ + 2 * KD + h * HV + v]); }
    __syncthreads();
    f32x4 vv[8], oa[8];
#pragma unroll
    for (int t = 0; t < 8; ++t) { vv[t] = *(const LAS f32x4*)(VV + t * 512 + 4 * c4); oa[t] = (f32x4){0.f, 0.f, 0.f, 0.f}; }
#define GLA_S_ROW(u_, k_, REFILL) do { const int k = (k_); \
            const f32x4 a0 = *(const LAS f32x4*)(AT + k * 8), a1 = *(const LAS f32x4*)(AT + k * 8 + 4), k0 = *(const LAS f32x4*)(KT + k * 8), k1 = *(const LAS f32x4*)(KT + k * 8 + 4), q0 = *(const LAS f32x4*)(QT + k * 8), q1 = *(const LAS f32x4*)(QT + k * 8 + 4); \
            f32x4 x = s[u_]; \
            x = x * a0.x + vv[0] * k0.x; oa[0] += x * q0.x; \
            x = x * a0.y + vv[1] * k0.y; oa[1] += x * q0.y; \
            x = x * a0.z + vv[2] * k0.z; oa[2] += x * q0.z; \
            x = x * a0.w + vv[3] * k0.w; oa[3] += x * q0.w; \
            x = x * a1.x + vv[4] * k1.x; oa[4] += x * q1.x; \
            x = x * a1.y + vv[5] * k1.y; oa[5] += x * q1.y; \
            x = x * a1.z + vv[6] * k1.z; oa[6] += x * q1.z; \
            x = x * a1.w + vv[7] * k1.w; oa[7] += x * q1.w; \
            __builtin_nontemporal_store(x, S1 + (size_t)k * 128); \
            if (REFILL) s[u_] = __builtin_nontemporal_load(S0 + (size_t)(k + 8) * 128); \
            asm volatile("" ::: "memory"); } while (0)
#pragma unroll 1
    for (int kb = 0; kb < 56; kb += 8) {
#pragma unroll
        for (int u = 0; u < 8; ++u) GLA_S_ROW(u, kg * 64 + kb + u, true);
    }
#pragma unroll
    for (int u = 0; u < 8; ++u) GLA_S_ROW(u, kg * 64 + 56 + u, false);
#undef GLA_S_ROW
#pragma unroll
    for (int t = 0; t < 8; ++t) *(LAS f32x4*)(RED + (kg * 8 + t) * 512 + 4 * c4) = oa[t];
    __syncthreads();
    for (int idx = F.tid; idx < 8 * 128; idx += NTHR) { const int t = idx >> 7, c = idx & 127;
        const f32x4 r = *(const LAS f32x4*)(RED + (0 * 8 + t) * 512 + 4 * c) + *(const LAS f32x4*)(RED + (1 * 8 + t) * 512 + 4 * c) + *(const LAS f32x4*)(RED + (2 * 8 + t) * 512 + 4 * c) + *(const LAS f32x4*)(RED + (3 * 8 + t) * 512 + 4 * c);
        v2u rb; rb.x = pk2(r.x, r.y); rb.y = pk2(r.z, r.w); *(v2u*)(O + (r0 + t) * DM + h * HV + 4 * c) = rb; }
    __syncthreads();
}
__device__ __forceinline__ void p2_gla(Frame& F, int qslot) {
    constexpr int NPI = NB * NH * 8, NSI = DB * NH;
    if ((int)blockIdx.x < NPI) { const int x = (int)blockIdx.x & 7, m = (int)blockIdx.x >> 3;
        gla_prompt_item(F, ((2 * x + (m & 1)) << 3) | (m >> 1));
        __syncthreads();
        pg9::Gemm g{(const bf16*)(F.ws + WS_XB), (const bf16*)(F.ws + WS_WIN) + (size_t)NQKV * PK2, M, NPROJ - NQKV, DM, PK2, PK2};
        pg9::ListOrder S{(int)blockIdx.x, NPI, (M / pg9::BMR) * ((NPROJ - NQKV) / pg9::BNC), M / pg9::BMR};
        pg9::EpiBf16<0> E{(bf16*)(F.ws + WS_PROJ) + NQKV, NPROJ, nullptr, false};
        pg9::gemm_phase<pg9::EpiBf16<0>, true, pg9::ListOrder>(F.lds, g, S, E);
        __syncthreads(); }
    for (;;) {
        __syncthreads();
        if (F.tid == 0) F.MISC[16] = __hip_atomic_fetch_add(F.ctl + CW_QUEUE + 64 * qslot, 1u, RLX_AGENT);
        __syncthreads();
        const int it = (int)F.MISC[16];
        if (it >= NSI + DT_NCHUNK) break;
        if (it < NSI) gla_sample_item(F, it); else deferred_transpose_chunk(F, it - NSI);
    }
    __syncthreads();
}

__device__ __forceinline__ void gate_rows(Frame& F, int row_lo, int nrows) {
    const bf16* O = (const bf16*)(F.ws + WS_O); const bf16* proj = (const bf16*)(F.ws + WS_PROJ); bf16* A2 = (bf16*)(F.ws + WS_A2); const float* ng = F.in[6];
    const int lane = F.lane; const bool b5 = lane & 32, b4 = lane & 16;
    f32x4 g4[8];
#pragma unroll
    for (int i = 0; i < 8; ++i) g4[i] = *((const f32x4*)ng + lane + 64 * i);
    const int r_lo = (F.wave * nrows) / NWAVES, r_hi = ((F.wave + 1) * nrows) / NWAVES;
    for (int rr = r_lo; rr < r_hi; rr += 2) {
        v2u ow[2][8], rw[2][8];
#pragma unroll
        for (int q = 0; q < 2; ++q) { const int m = row_lo + ((rr + q < r_hi) ? rr + q : r_hi - 1);
#pragma unroll
            for (int i = 0; i < 8; ++i) { ow[q][i] = *((const v2u*)(O + (size_t)m * DM) + lane + 64 * i); rw[q][i] = *((const v2u*)(proj + (size_t)m * NPROJ + 2 * KD + 2048) + lane + 64 * i); } }
#pragma unroll
        for (int q = 0; q < 2; ++q) { const int m = row_lo + ((rr + q < r_hi) ? rr + q : r_hi - 1);
            f32x4 v[8]; float hs[4];
#pragma unroll
            for (int i = 0; i < 8; ++i) v[i] = (f32x4){bf_lo(ow[q][i].x), bf_hi(ow[q][i].x), bf_lo(ow[q][i].y), bf_hi(ow[q][i].y)};
#pragma unroll
            for (int h = 0; h < 4; ++h) { const f32x4 a = v[2 * h], c = v[2 * h + 1]; hs[h] = (a.x * a.x + a.y * a.y) + (a.z * a.z + a.w * a.w) + (c.x * c.x + c.y * c.y) + (c.z * c.z + c.w * c.w); }
            float t2[2], t1;
#pragma unroll
            for (int i = 0; i < 2; ++i) { const float keep = b5 ? hs[i + 2] : hs[i], send = b5 ? hs[i] : hs[i + 2]; t2[i] = keep + __shfl_xor(send, 32); }
            { const float keep = b4 ? t2[1] : t2[0], send = b4 ? t2[0] : t2[1]; t1 = keep + __shfl_xor(send, 16); }
            t1 += __shfl_xor(t1, 8); t1 += __shfl_xor(t1, 4); t1 += __shfl_xor(t1, 2); t1 += __shfl_xor(t1, 1);
            float ss[4];
#pragma unroll
            for (int h = 0; h < 4; ++h) ss[h] = 1.0f / sqrtf(__int_as_float(__builtin_amdgcn_readlane(__float_as_int(t1), 16 * (h & 1) + 32 * (h >> 1))) * (1.0f / HV) + HN_EPS);
            v2u* o8 = (v2u*)(A2 + (size_t)m * PK2) + lane;
#pragma unroll
            for (int i = 0; i < 8; ++i) { const v2u rwv = rw[q][i];
                const float r0 = bf_lo(rwv.x), r1 = bf_hi(rwv.x), r2 = bf_lo(rwv.y), r3 = bf_hi(rwv.y); const float sc = ss[i >> 1];
                const float y0 = v[i].x * sc * g4[i].x * (r0 / (1.f + __expf(-r0))), y1 = v[i].y * sc * g4[i].y * (r1 / (1.f + __expf(-r1))), y2 = v[i].z * sc * g4[i].z * (r2 / (1.f + __expf(-r2))), y3 = v[i].w * sc * g4[i].w * (r3 / (1.f + __expf(-r3)));
                v2u w; w.x = pk2(y0, y1); w.y = pk2(y2, y3); o8[64 * i] = w; } }
    }
}
__device__ __forceinline__ void gate_panel_and_wait(Frame& F, int pm, int pn, unsigned* cnt) {
    gate_rows(F, pm * 288 + pn * 36, 36);
    asm volatile("s_waitcnt vmcnt(0)" ::: "memory");
    __syncthreads();
    if (F.tid == 0) {
        __builtin_amdgcn_fence(__ATOMIC_RELEASE, "agent");
        asm volatile("s_waitcnt vmcnt(0)" ::: "memory");
        __hip_atomic_fetch_add(cnt + 64 * pm, 1u, RLX_AGENT);
        unsigned sp = 0u;
        while (__hip_atomic_load(cnt + 64 * pm, RLX_AGENT) < 8u) { __builtin_amdgcn_s_sleep(2); if (++sp > (1u << 22)) { __hip_atomic_store(F.ctl + CW_TMO, 1u, RLX_AGENT); break; } }
        __builtin_amdgcn_fence(__ATOMIC_ACQUIRE, "agent");
        asm volatile("s_waitcnt vmcnt(0)" ::: "memory");
    }
    __syncthreads();
}

__device__ __forceinline__ void ln_rows(Frame& F, const float* in, const float* gam, const float* bet, float* outf, bf16* outb) {
    const int gw = F.vcu * NWAVES + F.wave, NGW = F.G * NWAVES;
    for (int m = gw; m < M; m += NGW) {
        const f32x4* xr = (const f32x4*)(in + (size_t)m * DM) + F.lane;
        f32x4 v[8]; float s = 0.f;
#pragma unroll
        for (int i = 0; i < 8; ++i) { v[i] = xr[64 * i]; s += (v[i].x + v[i].y) + (v[i].z + v[i].w); }
        const float mean = wave_sum(s) * (1.f / DM); float s2 = 0.f;
#pragma unroll
        for (int i = 0; i < 8; ++i) { v[i] = v[i] - mean; s2 += (v[i].x * v[i].x + v[i].y * v[i].y) + (v[i].z * v[i].z + v[i].w * v[i].w); }
        const float rstd = 1.f / sqrtf(wave_sum(s2) * (1.f / DM) + LN_EPS);
#pragma unroll
        for (int i = 0; i < 8; ++i) { const f32x4 g4 = *((const f32x4*)gam + F.lane + 64 * i), b4 = *((const f32x4*)bet + F.lane + 64 * i); const f32x4 y = v[i] * rstd * g4 + b4;
            if (outf) *((f32x4*)(outf + (size_t)m * DM) + F.lane + 64 * i) = y;
            if (outb) { v2u w; w.x = pk2(y.x, y.y); w.y = pk2(y.z, y.w); *((v2u*)(outb + (size_t)m * DM) + F.lane + 64 * i) = w; } }
    }
}
__device__ __forceinline__ void p10_vln(Frame& F) {
    const int gw = F.vcu * NWAVES + F.wave, NGW = F.G * NWAVES;
    const bf16* Z = (const bf16*)(F.ws + WS_Z); bf16* VN = (bf16*)(F.ws + WS_VN); const float* gam = F.in[10]; const float* bet = F.in[11];
    for (int m = gw; m < M; m += NGW) {
        const v2u* zr = (const v2u*)(Z + (size_t)m * (2 * SGW) + SGW) + F.lane;
        f32x4 v[8]; float s = 0.f;
#pragma unroll
        for (int i = 0; i < 8; ++i) { const v2u w = zr[64 * i]; v[i] = (f32x4){bf_lo(w.x), bf_hi(w.x), bf_lo(w.y), bf_hi(w.y)}; s += (v[i].x + v[i].y) + (v[i].z + v[i].w); }
        const float mean = wave_sum(s) * (1.f / SGW); float s2 = 0.f;
#pragma unroll
        for (int i = 0; i < 8; ++i) { v[i] = v[i] - mean; s2 += (v[i].x * v[i].x + v[i].y * v[i].y) + (v[i].z * v[i].z + v[i].w * v[i].w); }
        const float rstd = 1.f / sqrtf(wave_sum(s2) * (1.f / SGW) + LN_EPS);
#pragma unroll
        for (int i = 0; i < 8; ++i) { const f32x4 g4 = *((const f32x4*)gam + F.lane + 64 * i), b4 = *((const f32x4*)bet + F.lane + 64 * i); const f32x4 y = v[i] * rstd * g4 + b4;
            if (m >= MP) *((f32x4*)(F.out + OUT_SGV + (size_t)(m - MP) * SGW) + F.lane + 64 * i) = y;
            v2u w; w.x = pk2(y.x, y.y); w.y = pk2(y.z, y.w); *((v2u*)(VN + (size_t)m * SGW) + F.lane + 64 * i) = w; }
    }
}

constexpr int MIX_PITCH = 272;
__device__ __forceinline__ void mix_prompt_item(Frame& F, int item, bool load_w) {
    const int g = item & 7, ci = item >> 3; const int R0 = ci * SGC;
    const bf16* Z = (const bf16*)(F.ws + WS_Z); const bf16* Wc = (const bf16*)(F.ws + WS_WC); bf16* A2 = (bf16*)(F.ws + WS_A2); const float* stat = (const float*)(F.ws + WS_STAT);
    LAS unsigned char* WL = F.lds;
    LAS unsigned char* VT = F.lds + 128 * MIX_PITCH;
    LAS float* RS = (LAS float*)(F.lds + 128 * MIX_PITCH + 256 * MIX_PITCH);
    const int s_lo = F.lane >> 3, ch_lo = F.lane & 7;
    float sm = 0.f, sq = 0.f; v4u wq[4];
    if (F.tid < SGC) { sm = stat[2 * (size_t)(R0 + F.tid)]; sq = stat[2 * (size_t)(R0 + F.tid) + 1]; }
    if (load_w) {
#pragma unroll
        for (int i = 0; i < 4; ++i) { const int idx = F.tid + NTHR * i, t = idx >> 4, ch = idx & 15; wq[i] = *(const v4u*)(Wc + ((size_t)(g * SGC + t)) * SGC + ch * 8); } }
    v4u vr[8];
#pragma unroll
    for (int i = 0; i < 8; ++i) { const int s = 8 * (F.wave + 8 * (i & 1)) + s_lo, ch = 8 * (i >> 1) + ch_lo;
        vr[i] = *(const v4u*)(Z + (size_t)(R0 + s) * (2 * SGW) + SGW + g * SGD + ch * 8); }
    __syncthreads();
    if (F.tid < SGC) { const float mean = sm * (1.f / SGW), var = fmaxf(sq * (1.f / SGW) - mean * mean, 0.f);
        RS[2 * F.tid] = mean; RS[2 * F.tid + 1] = 1.f / sqrtf(var + LN_EPS); }
    if (load_w) {
#pragma unroll
        for (int i = 0; i < 4; ++i) { const int idx = F.tid + NTHR * i, t = idx >> 4, ch = idx & 15; *(LAS v4u*)(WL + t * MIX_PITCH + ch * 16) = wq[i]; } }
    __syncthreads();
#pragma unroll
    for (int i = 0; i < 8; ++i) { const int sh = F.wave + 8 * (i & 1), s = 8 * sh + s_lo, ch = 8 * (i >> 1) + ch_lo; const v4u w = vr[i];
        const float mean = RS[2 * s], rstd = RS[2 * s + 1];
        const f32x4 ga = *(const f32x4*)(F.in[10] + g * SGD + ch * 8), gb = *(const f32x4*)(F.in[10] + g * SGD + ch * 8 + 4), ba = *(const f32x4*)(F.in[11] + g * SGD + ch * 8), bb = *(const f32x4*)(F.in[11] + g * SGD + ch * 8 + 4);
        LAS unsigned short* col = (LAS unsigned short*)(VT + (size_t)(8 * ch) * MIX_PITCH + 16 * (sh ^ ch_lo) + 2 * s_lo);
        col[0 * (MIX_PITCH / 2)] = (unsigned short)(pk2((bf_lo(w.x) - mean) * rstd * ga.x + ba.x, 0.f) & 0xffffu); col[1 * (MIX_PITCH / 2)] = (unsigned short)(pk2((bf_hi(w.x) - mean) * rstd * ga.y + ba.y, 0.f) & 0xffffu);
        col[2 * (MIX_PITCH / 2)] = (unsigned short)(pk2((bf_lo(w.y) - mean) * rstd * ga.z + ba.z, 0.f) & 0xffffu); col[3 * (MIX_PITCH / 2)] = (unsigned short)(pk2((bf_hi(w.y) - mean) * rstd * ga.w + ba.w, 0.f) & 0xffffu);
        col[4 * (MIX_PITCH / 2)] = (unsigned short)(pk2((bf_lo(w.z) - mean) * rstd * gb.x + bb.x, 0.f) & 0xffffu); col[5 * (MIX_PITCH / 2)] = (unsigned short)(pk2((bf_hi(w.z) - mean) * rstd * gb.y + bb.y, 0.f) & 0xffffu);
        col[6 * (MIX_PITCH / 2)] = (unsigned short)(pk2((bf_lo(w.w) - mean) * rstd * gb.z + bb.z, 0.f) & 0xffffu); col[7 * (MIX_PITCH / 2)] = (unsigned short)(pk2((bf_hi(w.w) - mean) * rstd * gb.w + bb.w, 0.f) & 0xffffu); }
    __syncthreads();
    const int dg = F.wave & 3, th = F.wave >> 2, fr = F.lane & 15, fq = F.lane >> 4;
    f32x4 acc[4][4];
#pragma unroll
    for (int a = 0; a < 4; ++a)
#pragma unroll
        for (int j = 0; j < 4; ++j) acc[a][j] = (f32x4){0.f, 0.f, 0.f, 0.f};
#pragma unroll
    for (int ks = 0; ks < 4; ++ks) {
        bf16x8 af[4];
#pragma unroll
        for (int j = 0; j < 4; ++j) { const int d = 64 * dg + 16 * (fr >> 2) + 4 * j + (fr & 3);
            af[j] = *(const LAS bf16x8*)(VT + (size_t)d * MIX_PITCH + 16 * ((4 * ks + fq) ^ ((d >> 3) & 7))); }
#pragma unroll
        for (int a = 0; a < 4; ++a) { const int tt = th + 2 * a; if (2 * ks > tt) continue;
            const bf16x8 bw = *(const LAS bf16x8*)(WL + (size_t)(16 * tt + fr) * MIX_PITCH + (32 * ks + 8 * fq) * 2);
#pragma unroll
            for (int j = 0; j < 4; ++j) acc[a][j] = __builtin_amdgcn_mfma_f32_16x16x32_bf16(af[j], bw, acc[a][j], 0, 0, 0); }
    }
    const float* bsp = F.in[13] + g * SGC;
#pragma unroll
    for (int a = 0; a < 4; ++a) { const int t = 16 * (th + 2 * a) + fr; const float bb = bsp[t]; const size_t row = (size_t)R0 + t; const int col = g * SGD + 64 * dg + 16 * fq;
        const v4u u0 = *(const v4u*)(Z + row * (2 * SGW) + col), u1 = *(const v4u*)(Z + row * (2 * SGW) + col + 8);
        const f32x4 m0 = acc[a][0] + bb, m1 = acc[a][1] + bb, m2 = acc[a][2] + bb, m3 = acc[a][3] + bb;
        v4u o0, o1;
        o0.x = pk2(bf_lo(u0.x) * m0.x, bf_hi(u0.x) * m0.y); o0.y = pk2(bf_lo(u0.y) * m0.z, bf_hi(u0.y) * m0.w);
        o0.z = pk2(bf_lo(u0.z) * m1.x, bf_hi(u0.z) * m1.y); o0.w = pk2(bf_lo(u0.w) * m1.z, bf_hi(u0.w) * m1.w);
        o1.x = pk2(bf_lo(u1.x) * m2.x, bf_hi(u1.x) * m2.y); o1.y = pk2(bf_lo(u1.y) * m2.z, bf_hi(u1.y) * m2.w);
        o1.z = pk2(bf_lo(u1.z) * m3.x, bf_hi(u1.z) * m3.y); o1.w = pk2(bf_lo(u1.w) * m3.z, bf_hi(u1.w) * m3.w);
        *(v4u*)(A2 + row * PK2 + col) = o0; *(v4u*)(A2 + row * PK2 + col + 8) = o1; }
}
#define MIX_LDS_BARRIER() do { asm volatile("s_waitcnt lgkmcnt(0)" ::: "memory"); __builtin_amdgcn_s_barrier(); asm volatile("" ::: "memory"); } while (0)
__device__ __forceinline__ void mix_load_v(Frame& F, const bf16* Z, int R0, int g, v4u (&vr)[8]) {
    const int s_lo = F.lane >> 3, ch_lo = F.lane & 7;
#pragma unroll
    for (int i = 0; i < 8; ++i) { const int s = 8 * (F.wave + 8 * (i & 1)) + s_lo, ch = 8 * (i >> 1) + ch_lo;
        vr[i] = *(const v4u*)(Z + (size_t)(R0 + s) * (2 * SGW) + SGW + g * SGD + ch * 8); }
}
__device__ __forceinline__ void mix_load_u(Frame& F, const bf16* Z, int R0, int g, v4u (&u)[4][2]) {
    const int dg = F.wave & 3, th = F.wave >> 2, fr = F.lane & 15, fq = F.lane >> 4;
#pragma unroll
    for (int a = 0; a < 4; ++a) { const size_t row = (size_t)R0 + 16 * (th + 2 * a) + fr; const int col = g * SGD + 64 * dg + 16 * fq;
        u[a][0] = *(const v4u*)(Z + row * (2 * SGW) + col); u[a][1] = *(const v4u*)(Z + row * (2 * SGW) + col + 8); }
}
__device__ __forceinline__ void mix_transpose(Frame& F, int g, const v4u (&vr)[8], LAS unsigned char* VT, LAS const float* RS) {
    const int s_lo = F.lane >> 3, ch_lo = F.lane & 7;
#pragma unroll
    for (int i = 0; i < 8; ++i) { const int sh = F.wave + 8 * (i & 1), s = 8 * sh + s_lo, ch = 8 * (i >> 1) + ch_lo; const v4u w = vr[i];
        const float mean = RS[2 * s], rstd = RS[2 * s + 1];
        const f32x4 ga = *(const f32x4*)(F.in[10] + g * SGD + ch * 8), gb = *(const f32x4*)(F.in[10] + g * SGD + ch * 8 + 4), ba = *(const f32x4*)(F.in[11] + g * SGD + ch * 8), bb = *(const f32x4*)(F.in[11] + g * SGD + ch * 8 + 4);
        LAS unsigned short* col = (LAS unsigned short*)(VT + (size_t)(8 * ch) * MIX_PITCH + 16 * (sh ^ ch_lo) + 2 * s_lo);
        col[0 * (MIX_PITCH / 2)] = (unsigned short)(pk2((bf_lo(w.x) - mean) * rstd * ga.x + ba.x, 0.f) & 0xffffu); col[1 * (MIX_PITCH / 2)] = (unsigned short)(pk2((bf_hi(w.x) - mean) * rstd * ga.y + ba.y, 0.f) & 0xffffu);
        col[2 * (MIX_PITCH / 2)] = (unsigned short)(pk2((bf_lo(w.y) - mean) * rstd * ga.z + ba.z, 0.f) & 0xffffu); col[3 * (MIX_PITCH / 2)] = (unsigned short)(pk2((bf_hi(w.y) - mean) * rstd * ga.w + ba.w, 0.f) & 0xffffu);
        col[4 * (MIX_PITCH / 2)] = (unsigned short)(pk2((bf_lo(w.z) - mean) * rstd * gb.x + bb.x, 0.f) & 0xffffu); col[5 * (MIX_PITCH / 2)] = (unsigned short)(pk2((bf_hi(w.z) - mean) * rstd * gb.y + bb.y, 0.f) & 0xffffu);
        col[6 * (MIX_PITCH / 2)] = (unsigned short)(pk2((bf_lo(w.w) - mean) * rstd * gb.z + bb.z, 0.f) & 0xffffu); col[7 * (MIX_PITCH / 2)] = (unsigned short)(pk2((bf_hi(w.w) - mean) * rstd * gb.w + bb.w, 0.f) & 0xffffu); }
}
__device__ __forceinline__ void mix_mma_epi(Frame& F, int R0, int g, const v4u (&u)[4][2], LAS const unsigned char* WL, LAS const unsigned char* VT) {
    bf16* A2 = (bf16*)(F.ws + WS_A2);
    const int dg = F.wave & 3, th = F.wave >> 2, fr = F.lane & 15, fq = F.lane >> 4;
    f32x4 acc[4][4];
#pragma unroll
    for (int a = 0; a < 4; ++a)
#pragma unroll
        for (int j = 0; j < 4; ++j) acc[a][j] = (f32x4){0.f, 0.f, 0.f, 0.f};
#pragma unroll
    for (int ks = 0; ks < 4; ++ks) {
        bf16x8 af[4];
#pragma unroll
        for (int j = 0; j < 4; ++j) { const int d = 64 * dg + 16 * (fr >> 2) + 4 * j + (fr & 3);
            af[j] = *(const LAS bf16x8*)(VT + (size_t)d * MIX_PITCH + 16 * ((4 * ks + fq) ^ ((d >> 3) & 7))); }
#pragma unroll
        for (int a = 0; a < 4; ++a) { const int tt = th + 2 * a; if (2 * ks > tt) continue;
            const bf16x8 bw = *(const LAS bf16x8*)(WL + (size_t)(16 * tt + fr) * MIX_PITCH + (32 * ks + 8 * fq) * 2);
#pragma unroll
            for (int j = 0; j < 4; ++j) acc[a][j] = __builtin_amdgcn_mfma_f32_16x16x32_bf16(af[j], bw, acc[a][j], 0, 0, 0); }
    }
    const float* bsp = F.in[13] + g * SGC;
#pragma unroll
    for (int a = 0; a < 4; ++a) { const int t = 16 * (th + 2 * a) + fr; const float bb = bsp[t]; const size_t row = (size_t)R0 + t; const int col = g * SGD + 64 * dg + 16 * fq;
        const v4u u0 = u[a][0], u1 = u[a][1];
        const f32x4 m0 = acc[a][0] + bb, m1 = acc[a][1] + bb, m2 = acc[a][2] + bb, m3 = acc[a][3] + bb;
        v4u o0, o1;
        o0.x = pk2(bf_lo(u0.x) * m0.x, bf_hi(u0.x) * m0.y); o0.y = pk2(bf_lo(u0.y) * m0.z, bf_hi(u0.y) * m0.w);
        o0.z = pk2(bf_lo(u0.z) * m1.x, bf_hi(u0.z) * m1.y); o0.w = pk2(bf_lo(u0.w) * m1.z, bf_hi(u0.w) * m1.w);
        o1.x = pk2(bf_lo(u1.x) * m2.x, bf_hi(u1.x) * m2.y); o1.y = pk2(bf_lo(u1.y) * m2.z, bf_hi(u1.y) * m2.w);
        o1.z = pk2(bf_lo(u1.z) * m3.x, bf_hi(u1.z) * m3.y); o1.w = pk2(bf_lo(u1.w) * m3.z, bf_hi(u1.w) * m3.w);
        *(v4u*)(A2 + row * PK2 + col) = o0; *(v4u*)(A2 + row * PK2 + col + 8) = o1; }
}
struct MixS { unsigned v[8], u[8]; float st, wv, bv; float2 gam, bet; };
__device__ __forceinline__ void mix_sample_load(Frame& F, int hi, MixS& S) {
    const int g = (hi >> 1) & 7, b = hi >> 4; const size_t r0 = (size_t)MP + (size_t)b * DT; const int col = g * SGD + 128 * (hi & 1) + 2 * F.lane;
    const bf16* Z = (const bf16*)(F.ws + WS_Z); const float* stat = (const float*)(F.ws + WS_STAT);
#pragma unroll
    for (int s = 0; s < 8; ++s) { S.v[s] = *(const unsigned*)(Z + (r0 + s) * (2 * SGW) + SGW + col); S.u[s] = *(const unsigned*)(Z + (r0 + s) * (2 * SGW) + col); }
    S.st = stat[2 * r0 + (F.lane & 15)];
    S.wv = F.in[12][(size_t)g * SGC * SGC + (F.lane >> 3) * SGC + (F.lane & 7)];
    S.bv = F.in[13][g * SGC + (F.lane & 7)];
    S.gam = *(const float2*)(F.in[10] + col); S.bet = *(const float2*)(F.in[11] + col);
}
#define MIX_RDL(x, l) __int_as_float(__builtin_amdgcn_readlane(__float_as_int(x), (l)))
__device__ __forceinline__ void mix_sample_compute(Frame& F, int hi, const MixS& S) {
    const int g = (hi >> 1) & 7, b = hi >> 4; const size_t r0 = (size_t)MP + (size_t)b * DT; const int col = g * SGD + 128 * (hi & 1) + 2 * F.lane;
    bf16* A2 = (bf16*)(F.ws + WS_A2);
    const float wr = bf2f((bf16)(pk2(S.wv, 0.f) & 0xffffu));
    float v0[8], v1[8];
#pragma unroll
    for (int s = 0; s < 8; ++s) { const float sm = MIX_RDL(S.st, 2 * s), sq = MIX_RDL(S.st, 2 * s + 1);
        const float mean = sm * (1.f / SGW), rstd = 1.f / sqrtf(fmaxf(sq * (1.f / SGW) - mean * mean, 0.f) + LN_EPS);
        const float y0 = (bf_lo(S.v[s]) - mean) * rstd * S.gam.x + S.bet.x, y1 = (bf_hi(S.v[s]) - mean) * rstd * S.gam.y + S.bet.y;
        *(float2*)(F.out + OUT_SGV + (size_t)(b * DT + s) * SGW + col) = make_float2(y0, y1);
        const unsigned rb = pk2(y0, y1); v0[s] = bf_lo(rb); v1[s] = bf_hi(rb); }
#pragma unroll
    for (int t = 0; t < 8; ++t) { float m0 = 0.f, m1 = 0.f;
#pragma unroll
        for (int s = 0; s < 8; ++s) if (s <= t) { const float w = MIX_RDL(wr, 8 * t + s); m0 += v0[s] * w; m1 += v1[s] * w; }
        const float bb = MIX_RDL(S.bv, t); m0 += bb; m1 += bb;
        *(unsigned*)(A2 + (r0 + t) * PK2 + col) = pk2(bf_lo(S.u[t]) * m0, bf_hi(S.u[t]) * m1); }
}
__device__ __forceinline__ void mix_prompt_pair(Frame& F, int itA, int itB) {
    const int g = itA & 7; const int R0A = (itA >> 3) * SGC, R0B = (itB >> 3) * SGC;
    const bf16* Z = (const bf16*)(F.ws + WS_Z); const bf16* Wc = (const bf16*)(F.ws + WS_WC); const float* stat = (const float*)(F.ws + WS_STAT);
    LAS unsigned char* WL = F.lds; LAS unsigned char* VT = F.lds + 128 * MIX_PITCH;
    LAS float* RS = (LAS float*)(F.lds + 128 * MIX_PITCH + 256 * MIX_PITCH);
    const int hi = F.vcu * NWAVES + F.wave;
    float sm = 0.f, sq = 0.f; v4u wq[4]; MixS S;
    mix_sample_load(F, hi, S);
    if (F.tid < 2 * SGC) { const size_t r = (F.tid < SGC) ? (size_t)(R0A + F.tid) : (size_t)(R0B + F.tid - SGC); sm = stat[2 * r]; sq = stat[2 * r + 1]; }
#pragma unroll
    for (int i = 0; i < 4; ++i) { const int idx = F.tid + NTHR * i, t = idx >> 4, ch = idx & 15; wq[i] = *(const v4u*)(Wc + ((size_t)(g * SGC + t)) * SGC + ch * 8); }
    v4u vA[8], vB[8], uA[4][2], uB[4][2];
    mix_load_v(F, Z, R0A, g, vA); mix_load_u(F, Z, R0A, g, uA); mix_load_v(F, Z, R0B, g, vB);
    mix_sample_compute(F, hi, S);
    MIX_LDS_BARRIER();
    if (F.tid < 2 * SGC) { const float mean = sm * (1.f / SGW), var = fmaxf(sq * (1.f / SGW) - mean * mean, 0.f);
        RS[2 * F.tid] = mean; RS[2 * F.tid + 1] = 1.f / sqrtf(var + LN_EPS); }
#pragma unroll
    for (int i = 0; i < 4; ++i) { const int idx = F.tid + NTHR * i, t = idx >> 4, ch = idx & 15; *(LAS v4u*)(WL + t * MIX_PITCH + ch * 16) = wq[i]; }
    MIX_LDS_BARRIER();
    mix_transpose(F, g, vA, VT, RS);
    mix_load_u(F, Z, R0B, g, uB);
    MIX_LDS_BARRIER();
    mix_mma_epi(F, R0A, g, uA, WL, VT);
    MIX_LDS_BARRIER();
    mix_transpose(F, g, vB, VT, RS + 2 * SGC);
    MIX_LDS_BARRIER();
    mix_mma_epi(F, R0B, g, uB, WL, VT);
}
__device__ __forceinline__ void p11_mix(Frame& F) {
    constexpr int NPI = (MP / SGC) * SGG, NSH = 2 * DB * SGG;
    if (2 * F.G == NPI && F.G * NWAVES == NSH) mix_prompt_pair(F, F.vcu, F.vcu + F.G);
    else {
        for (int it = F.vcu; it < NPI; it += F.G) mix_prompt_item(F, it, it == F.vcu || (F.G & 7) != 0);
        const int gw = F.vcu * NWAVES + F.wave, NGW = F.G * NWAVES;
        for (int hi = gw; hi < NSH; hi += NGW) { MixS S; mix_sample_load(F, hi, S); mix_sample_compute(F, hi, S); }
    }
    __syncthreads();
}

struct Args { const float* in[21]; float* out; unsigned char* ws; int ph_lo, ph_hi, coop, pad; };
__global__ void __launch_bounds__(NTHR, 2) fwd_kernel(Args args) {
    extern __shared__ __attribute__((aligned(16))) unsigned char lds[];
    Frame F;
    F.lds = (LAS unsigned char*)lds;
    F.MISC = (volatile LAS unsigned*)(F.lds + MISC_OFF);
    F.tid = threadIdx.x; F.lane = F.tid & 63; F.wave = __builtin_amdgcn_readfirstlane(F.tid >> 6);
    F.G = gridDim.x; { const int bx = blockIdx.x; F.vcu = (F.G % 8 == 0) ? (bx % 8) * (F.G / 8) + bx / 8 : bx; }
#pragma unroll
    for (int i = 0; i < 21; ++i) F.in[i] = args.in[i];
    F.out = args.out; F.ws = args.ws; F.ctl = (unsigned*)(args.ws + WS_CTL);
    if (F.tid < 64) F.MISC[F.tid] = 0u;
    __syncthreads();
    XcdBarrier bar; bar.bar = F.ctl + CW_BAR; bar.x = 0; bar.st = nullptr;
    if (args.coop) bar = xcd_barrier_post(F.ctl + CW_BAR, F.MISC + 8);
    unsigned char* ws = F.ws;
    bf16* XB = (bf16*)(ws + WS_XB); bf16* A2 = (bf16*)(ws + WS_A2); bf16* HB = (bf16*)(ws + WS_HB);
    LAS unsigned char* ring = F.lds;

    const int lo = args.ph_lo, hi = args.ph_hi;
#define IN(k) (lo <= (k) && (k) < hi)
#define AGAIN(k) (IN(k) && (((PROBE_MASK) >> (k)) & 1))
#define SEAM(k) do { if (IN(k) && IN((k) + 1)) xcd_barrier(bar); } while (0)
#define GEMM_LN_B(INST, Amat, Bmat, Kdim, GAM, BET, OUTF, OUTB) { pg9::Gemm g{Amat, Bmat, M, DM, Kdim, (Kdim) + 64, (Kdim) + 64}; pg9::Order S; S.init(M, DM, F.G, (int)blockIdx.x); \
        pg9::PanelStats st{(unsigned*)(ws + WS_XCH), F.ctl + CW_LN + (INST) * LN_BANK, F.ctl + CW_TMO, LN_EPS}; pg9::EpiLn E{XB, PK2, ALPHA, GAM, BET, OUTF, OUTB, PK2, st}; \
        pg9::gemm_phase<pg9::EpiLn, false>(ring, g, S, E); }
#define GEMM_LN(k, INST, Amat, Bmat, Kdim, GAM, BET, OUTF, OUTB) if (IN(k)) GEMM_LN_B(INST, Amat, Bmat, Kdim, GAM, BET, OUTF, OUTB) SEAM(k)
#define GEMM_UP_B(l) { pg9::Gemm g{XB, (const bf16*)(ws + WS_W1) + (size_t)(l) * DFF * PK2, M, DFF, DM, PK2, PK2}; pg9::Order S; S.init(M, DFF, F.G, (int)blockIdx.x); pg9::EpiBf16<2> E{HB, PK8, nullptr}; \
        pg9::gemm_phase<pg9::EpiBf16<2>>(ring, g, S, E); }
#define GEMM_UP(k, l) if (IN(k)) GEMM_UP_B(l) if (AGAIN(k)) GEMM_UP_B(l) SEAM(k)
#define GEMM_IN_B { pg9::Gemm g{XB, (const bf16*)(ws + WS_WIN), M, NQKV, DM, PK2, PK2}; pg9::Order S; S.init(M, NQKV, F.G, (int)blockIdx.x); pg9::EpiBf16<0> E{(bf16*)(ws + WS_PROJ), NPROJ, nullptr}; \
        pg9::gemm_phase<pg9::EpiBf16<0>>(ring, g, S, E); }
#define GEMM_SG_B { pg9::Gemm g{XB, (const bf16*)(ws + WS_SGIN), M, 2 * SGW, DM, PK2, PK2}; pg9::Order S; S.init(M, 2 * SGW, F.G, (int)blockIdx.x); pg9::EpiSg E{(bf16*)(ws + WS_Z), 2 * SGW, F.in[9], (float*)(ws + WS_STAT)}; \
        pg9::gemm_phase<pg9::EpiSg>(ring, g, S, E); }
    if (IN(0)) p0_prologue(F); if (AGAIN(0)) p0_prologue(F);
    SEAM(0);
    if (IN(1)) GEMM_IN_B if (AGAIN(1)) GEMM_IN_B
    SEAM(1);
    if (IN(2)) p2a_gla_prep(F);
    SEAM(2);
    if (IN(3)) p2_gla(F, 0); if (AGAIN(3)) p2_gla(F, 1);
    SEAM(3);
    if (IN(4) && F.G == 256) {
        const int c = (int)blockIdx.x, wgid = (c & 7) * 32 + (c >> 3), pm0 = (wgid >> 6) * 8 + (wgid & 7), pn0 = (wgid & 63) >> 3;
        gate_panel_and_wait(F, pm0, pn0, F.ctl + CW_GATE); }
    GEMM_LN(4, 0, A2, (const bf16*)(ws + WS_WOUT), DM, F.in[17], F.in[18], (float*)nullptr, XB);
    GEMM_UP(5, 0);
    GEMM_LN(6, 1, HB, (const bf16*)(ws + WS_W2), DFF, F.in[19], F.in[20], (float*)nullptr, XB);
    if (IN(7)) GEMM_SG_B
    SEAM(7);
    if (IN(8)) p11_mix(F); if (AGAIN(8)) p11_mix(F);
    SEAM(8);
    GEMM_LN(9, 2, A2, (const bf16*)(ws + WS_SGOUT), SGW, F.in[17] + DM, F.in[18] + DM, (float*)nullptr, XB);
    GEMM_UP(10, 1);
    GEMM_LN(11, 3, HB, (const bf16*)(ws + WS_W2) + (size_t)DM * PK8, DFF, F.in[19] + DM, F.in[20] + DM, F.out + OUT_Y, (bf16*)nullptr);
#undef IN
#undef AGAIN
#undef SEAM
}

extern "C" void kernel_launch(void* const* d_in, const int* in_sizes, int n_in, void* d_out, int out_size, void* d_ws, size_t ws_size, hipStream_t stream) {
    static int grid = 0;
    if (grid == 0) {
        if (n_in != 21 || (size_t)out_size != OUT_END || ws_size < WS_END) { fprintf(stderr, "kernel_launch: unexpected shapes: n_in %d out %d ws %zu (need %zu)\n", n_in, out_size, ws_size, (size_t)WS_END); grid = -1; return; }
        int dev = 0, cus = 0, per_cu = 0;
        if (hipGetDevice(&dev) != hipSuccess || hipDeviceGetAttribute(&cus, hipDeviceAttributeMultiprocessorCount, dev) != hipSuccess) { fprintf(stderr, "kernel_launch: device query failed\n"); grid = -1; return; }
        if (hipFuncSetAttribute((const void*)fwd_kernel, hipFuncAttributeMaxDynamicSharedMemorySize, LDS_BYTES) != hipSuccess) { fprintf(stderr, "kernel_launch: hipFuncSetAttribute failed\n"); grid = -1; return; }
        if (hipOccupancyMaxActiveBlocksPerMultiprocessor(&per_cu, (const void*)fwd_kernel, NTHR, LDS_BYTES) != hipSuccess || per_cu < 1) { fprintf(stderr, "kernel_launch: occupancy query says %d blocks per CU\n", per_cu); per_cu = 1; }
        (void)hipGetLastError();
        grid = cus * 1;
    }
    if (grid < 0) return;
    if (hipMemsetAsync((char*)d_ws + WS_CTL, 0, CTL_ZERO_BYTES, stream) != hipSuccess) { fprintf(stderr, "kernel_launch: memset failed\n"); return; }
    Args a{};
    for (int i = 0; i < 21; ++i) a.in[i] = (const float*)d_in[i];
    a.out = (float*)d_out; a.ws = (unsigned char*)d_ws;
    if (N_LAUNCHES == 1) {
        a.ph_lo = 0; a.ph_hi = NPHASE; a.coop = 1;
        void* kargs[] = {&a};
        hipError_t e = hipLaunchCooperativeKernel((const void*)fwd_kernel, dim3(grid), dim3(NTHR), kargs, LDS_BYTES, stream);
        if (e != hipSuccess) fprintf(stderr, "kernel_launch: cooperative launch failed: %s (grid %d)\n", hipGetErrorString(e), grid);
    } else {
        for (int ph = 0; ph < NPHASE; ++ph) {
            a.ph_lo = ph; a.ph_hi = ph + 1; a.coop = 0;
            hipLaunchKernelGGL(fwd_kernel, dim3(grid), dim3(NTHR), LDS_BYTES, stream, a);
            const hipError_t le = hipPeekAtLastError();
            if (le != hipSuccess) { fprintf(stderr, "kernel_launch: launch %d failed: %s\n", ph, hipGetErrorName(le)); break; }
        }
    }
}
```

```cpp
#include <hip/hip_runtime.h>
#include <hip/hip_cooperative_groups.h>
#include <cstdio>
#include <cstdint>
namespace cg = cooperative_groups;

#ifndef PROBE_MASK
#define PROBE_MASK 0
#endif
#ifndef MK_N_LAUNCHES
#define MK_N_LAUNCHES 1
#endif

namespace pg8 {
#define PG8_LAS __attribute__((address_space(3)))
typedef unsigned short bf16_t;
typedef short bf16x8 __attribute__((ext_vector_type(8)));
typedef float f32x4 __attribute__((ext_vector_type(4)));
typedef float f32x2 __attribute__((ext_vector_type(2)));
typedef unsigned u32x4 __attribute__((ext_vector_type(4)));
constexpr int BM = 256, BK = 64, HALF = 128, HTB = HALF * BK * 2, STAGE_BYTES = 8 * HTB, NXCD = 8, WGM = 8;

__host__ __device__ __forceinline__ int lds_byte(int r, int c) { const int st = (r >> 4) * 2 + (c >> 5), rr = r & 15, cc = c & 31, ob = rr * 64 + cc * 2; return st * 1024 + (ob ^ (((ob >> 9) & 1) << 5)); }
__host__ __device__ __forceinline__ void stage_rc(int b, int& R, int& C) { const int st = b / 1024, sb = b % 1024, swz = sb ^ (((sb >> 9) & 1) << 5); R = (st >> 1) * 16 + swz / 64; C = (st & 1) * 32 + (swz % 64) / 2; }
__host__ __device__ __forceinline__ int perm32(int rho) { const int n = rho >> 4, i = rho & 15; return 8 * (i >> 2) + 4 * n + (i & 3); }

struct Unit { int pm, pn; };
struct Gemm { const bf16_t* A; const bf16_t* Bt; int M, N, K; };

struct StaticOrder {
    int nM, nN, nwg, G, c;
    __host__ __device__ void init(int M, int N, int G_, int c_) { nM = M / BM; nN = N / BM; nwg = nM * nN; G = G_; c = c_; }
    __host__ __device__ bool next(int i, Unit& u) const {
        const long L = (long)i * G + c; if (L >= nwg) return false;
        int wgid = (int)L; { const int q = nwg / NXCD, r = nwg % NXCD, xcd = wgid % NXCD, off = wgid / NXCD; wgid = (xcd < r ? xcd * (q + 1) : r * (q + 1) + (xcd - r) * q) + off; }
        const int nig = WGM * nN, gid = wgid / nig, fm = gid * WGM, gsz = (nM - fm) < WGM ? (nM - fm) : WGM;
        u.pm = fm + ((wgid % nig) % gsz); u.pn = (wgid % nig) / gsz; return true;
    }
    __device__ __forceinline__ void a_ready(const Unit&) const {}
    __device__ __forceinline__ void done(const Unit&) const {}
};

__device__ __forceinline__ unsigned cvt_pk_bf16(float lo, float hi) { unsigned r; asm volatile("v_cvt_pk_bf16_f32 %0, %1, %2" : "=v"(r) : "v"(lo), "v"(hi)); return r; }
__device__ __forceinline__ f32x2 gelu_pk(f32x2 v) {
    const f32x2 av = __builtin_elementwise_abs(v), d = av * 0.2316418882f + 1.0f;
    f32x2 t; t.x = __builtin_amdgcn_rcpf(d.x); t.y = __builtin_amdgcn_rcpf(d.y);
    f32x2 q = t * 0.5307027145f + (-0.7265760135f); q = q * t + 0.7107068705f; q = q * t + (-0.142248368f); q = q * t + 0.127414796f; q = q * t;
    const f32x2 s = (v * v) * (-0.72134752044f);
    f32x2 e; e.x = __builtin_amdgcn_exp2f(s.x); e.y = __builtin_amdgcn_exp2f(s.y);
    const f32x2 m = v * (q * e), r = v - m;
    f32x2 o; o.x = v.x < 0.f ? m.x : r.x; o.y = v.y < 0.f ? m.y : r.y; return o;
}

template <int ACT  > struct EpiBf16 {
    static constexpr bool PERM = true, AFTER_DRAIN = false;
    bf16_t* O; int ldc; const float* bias;
    __device__ __forceinline__ void operator()(const f32x4 (&acc)[2][2][4][2], const Unit& u, int wr, int wc, int fr, int fq) const {
        const int row0 = u.pm * BM + wr * 64 + fr; const int col0 = u.pn * BM + wc * 32 + 8 * fq;
        f32x4 bv[2][2];
#pragma unroll
        for (int bj = 0; bj < 2; ++bj)
#pragma unroll
            for (int n = 0; n < 2; ++n) bv[bj][n] = (ACT == 1) ? *(const f32x4*)(bias + col0 + bj * HALF + 4 * n) : (f32x4){0.f, 0.f, 0.f, 0.f};
#pragma unroll
        for (int ai = 0; ai < 2; ++ai)
#pragma unroll
            for (int m = 0; m < 4; ++m) { bf16_t* rowp = O + (size_t)(row0 + ai * HALF + m * 16) * ldc + col0;
#pragma unroll
                for (int bj = 0; bj < 2; ++bj) { f32x4 v0 = acc[ai][bj][m][0] + bv[bj][0], v1 = acc[ai][bj][m][1] + bv[bj][1];
                    if (ACT == 1) { f32x2 a = gelu_pk((f32x2){v0[0], v0[1]}), b = gelu_pk((f32x2){v0[2], v0[3]}), c = gelu_pk((f32x2){v1[0], v1[1]}), d = gelu_pk((f32x2){v1[2], v1[3]});
                        v0 = (f32x4){a.x, a.y, b.x, b.y}; v1 = (f32x4){c.x, c.y, d.x, d.y}; }
                    if (ACT == 2) {
#pragma unroll
                        for (int j = 0; j < 4; ++j) { const float p = fmaxf(v0[j], 0.f), q = fmaxf(v1[j], 0.f); v0[j] = p * p; v1[j] = q * q; } }
                    u32x4 w; w.x = cvt_pk_bf16(v0[0], v0[1]); w.y = cvt_pk_bf16(v0[2], v0[3]); w.z = cvt_pk_bf16(v1[0], v1[1]); w.w = cvt_pk_bf16(v1[2], v1[3]);
                    *(u32x4*)(rowp + bj * HALF) = w; } }
    }
};
struct EpiRes {
    static constexpr bool PERM = false, AFTER_DRAIN = false;
    float* out; int ldc; const float* resA; const float* resB; int split; float alpha;
    __device__ __forceinline__ void operator()(const f32x4 (&acc)[2][2][4][2], const Unit& u, int wr, int wc, int fr, int fq) const {
        const int row0 = u.pm * BM + wr * 64 + fr, col0 = u.pn * BM + wc * 32 + 4 * fq;
#pragma unroll
        for (int ai = 0; ai < 2; ++ai)
#pragma unroll
            for (int m = 0; m < 4; ++m) { const int row = row0 + ai * HALF + m * 16;
                const float* rp = (row < split ? resA + (size_t)row * ldc : resB + (size_t)(row - split) * ldc) + col0; float* op = out + (size_t)row * ldc + col0;
#pragma unroll
                for (int bj = 0; bj < 2; ++bj)
#pragma unroll
                    for (int n = 0; n < 2; ++n) { const f32x4 rv = *(const f32x4*)(rp + bj * HALF + n * 16); *(f32x4*)(op + bj * HALF + n * 16) = acc[ai][bj][m][n] + rv * alpha; } }
    }
};

template <class Epi, class Sched, bool ALIGN_EPI = false, bool SP2 = false>
__device__ __forceinline__ void gemm_phase(PG8_LAS unsigned char* lds, const Gemm g, const Sched& S, const Epi& E) {
    const int tid = threadIdx.x, wid = __builtin_amdgcn_readfirstlane(tid >> 6), lane = tid & 63, wr = wid >> 2, wc = wid & 3, fr = lane & 15, fq = lane >> 4;
    const int K = g.K, nt = K / BK;
    unsigned voffA[2], voffB[2];
#pragma unroll
    for (int i = 0; i < 2; ++i) { int R, C; stage_rc(tid * 16 + i * 8192, R, C); const int Rb = Epi::PERM ? ((R & ~31) + perm32(R & 31)) : R;
        voffA[i] = (unsigned)(R * K + C) * 2u; voffB[i] = (unsigned)(Rb * K + C) * 2u; }
    const size_t kstep = (size_t)(BK * 2);
    const size_t hstep = (size_t)HALF * K * 2;
    const size_t tstep = 2 * hstep;
    const unsigned ldsw = (unsigned)wid * 1024u;
    const int aoff = lds_byte(wr * 64 + fr, fq * 8), boff = lds_byte(wc * 32 + fr, fq * 8);
#define PG8_SA(b, h) (((b) * 2 + (h)) * HTB)
#define PG8_SB(b, h) ((4 + (b) * 2 + (h)) * HTB)
#define PG8_STAGE(bufoff, gbase, voff) do { _Pragma("unroll") for (int _i = 0; _i < 2; ++_i) \
        __builtin_amdgcn_global_load_lds((const unsigned*)((const char*)(gbase) + (voff)[_i]), (PG8_LAS unsigned*)(lds + (bufoff) + ldsw + _i * 8192), 16, 0, 0); } while (0)
#define PG8_LDA(dst, b, h) do { _Pragma("unroll") for (int m = 0; m < 4; ++m) _Pragma("unroll") for (int k = 0; k < 2; ++k) dst[m][k] = *(const PG8_LAS bf16x8*)(lds + PG8_SA(b, h) + aoff + m * 2048 + k * 1024); } while (0)
#define PG8_LDB(dst, b, h) do { _Pragma("unroll") for (int n = 0; n < 2; ++n) _Pragma("unroll") for (int k = 0; k < 2; ++k) dst[n][k] = *(const PG8_LAS bf16x8*)(lds + PG8_SB(b, h) + boff + n * 2048 + k * 1024); } while (0)
#define PG8_MMA(ai, bj, At, Bt) do { __builtin_amdgcn_s_setprio(1); _Pragma("unroll") for (int m = 0; m < 4; ++m) _Pragma("unroll") for (int n = 0; n < 2; ++n) _Pragma("unroll") for (int k = 0; k < 2; ++k) \
        acc[ai][bj][m][n] = __builtin_amdgcn_mfma_f32_16x16x32_bf16(Bt[n][k], At[m][k], acc[ai][bj][m][n], 0, 0, 0); __builtin_amdgcn_s_setprio(0); } while (0)
#define PG8_WAIT_V(n) asm volatile("s_waitcnt vmcnt(" #n ")" ::: "memory")
#define PG8_WAIT_L(n) asm volatile("s_waitcnt lgkmcnt(" #n ")" ::: "memory")
#define PG8_BAR __builtin_amdgcn_s_barrier()
#define PG8_SCHED __builtin_amdgcn_sched_barrier(0)
    Unit cur, nxt; int ui = 0;
    if (!S.next(0, cur)) return;
    f32x4 acc[2][2][4][2];
#pragma unroll
    for (int a = 0; a < 2; ++a)
#pragma unroll
        for (int b = 0; b < 2; ++b)
#pragma unroll
            for (int m = 0; m < 4; ++m)
#pragma unroll
                for (int n = 0; n < 2; ++n) acc[a][b][m][n] = (f32x4){0.f, 0.f, 0.f, 0.f};
    bf16x8 At[4][2], B0[2][2], B1[2][2];
    const char* cA = (const char*)g.A + (size_t)cur.pm * tstep; const char* cB = (const char*)g.Bt + (size_t)cur.pn * tstep;
    S.a_ready(cur);
    if constexpr (SP2) {
        PG8_STAGE(PG8_SB(0, 0), cB, voffB); PG8_STAGE(PG8_SB(0, 1), cB + hstep, voffB); PG8_STAGE(PG8_SA(0, 0), cA, voffA); PG8_STAGE(PG8_SA(0, 1), cA + hstep, voffA);
        if (wr == 1) PG8_BAR;
        PG8_WAIT_V(2); PG8_BAR;
        PG8_STAGE(PG8_SB(1, 0), cB + kstep, voffB); PG8_STAGE(PG8_SA(1, 0), cA + kstep, voffA); PG8_STAGE(PG8_SB(1, 1), cB + hstep + kstep, voffB);
        PG8_WAIT_V(6); PG8_BAR;
    } else {
        PG8_STAGE(PG8_SB(0, 0), cB, voffB); PG8_STAGE(PG8_SA(0, 0), cA, voffA); PG8_STAGE(PG8_SB(0, 1), cB + hstep, voffB); PG8_STAGE(PG8_SA(0, 1), cA + hstep, voffA);
        if (wr == 1) PG8_BAR;
        PG8_WAIT_V(4); PG8_BAR;
        PG8_STAGE(PG8_SB(1, 0), cB + kstep, voffB); PG8_STAGE(PG8_SA(1, 0), cA + kstep, voffA); PG8_STAGE(PG8_SB(1, 1), cB + hstep + kstep, voffB);
        PG8_WAIT_V(6); PG8_BAR;
    }
    for (;;) {
        const bool has_next = S.next(ui + 1, nxt);
        const char* nA = has_next ? (const char*)g.A + (size_t)nxt.pm * tstep : cA; const char* nB = has_next ? (const char*)g.Bt + (size_t)nxt.pn * tstep : cB;
        for (int t = 0; t < nt; t += 2) {
            const bool last = (t == nt - 2);
            const char* a1 = cA + (size_t)(t + 1) * kstep;
            const char* a2 = last ? nA : cA + (size_t)(t + 2) * kstep; const char* b2 = last ? nB : cB + (size_t)(t + 2) * kstep;
            const char* a3 = a2 + kstep; const char* b3 = b2 + kstep;
            if (last && has_next) S.a_ready(nxt);
            if constexpr (SP2) {
            PG8_LDB(B0, 0, 0); PG8_LDB(B1, 0, 1); PG8_SCHED; PG8_LDA(At, 0, 0); PG8_STAGE(PG8_SA(1, 1), a1 + hstep, voffA);
            PG8_WAIT_V(8); PG8_WAIT_L(0); PG8_BAR; PG8_MMA(0, 0, At, B0); PG8_MMA(0, 1, At, B1); PG8_BAR; PG8_SCHED;
            PG8_LDA(At, 0, 1); PG8_STAGE(PG8_SB(0, 0), b2, voffB); PG8_STAGE(PG8_SB(0, 1), b2 + hstep, voffB); PG8_STAGE(PG8_SA(0, 0), a2, voffA);
            PG8_WAIT_V(8); PG8_WAIT_L(0); PG8_BAR; PG8_MMA(1, 0, At, B0); PG8_MMA(1, 1, At, B1); PG8_BAR; PG8_SCHED;
            PG8_LDB(B0, 1, 0); PG8_LDB(B1, 1, 1); PG8_SCHED; PG8_LDA(At, 1, 0); PG8_STAGE(PG8_SA(0, 1), a2 + hstep, voffA);
            PG8_WAIT_V(8); PG8_WAIT_L(0); PG8_BAR; PG8_MMA(0, 0, At, B0); PG8_MMA(0, 1, At, B1); PG8_BAR; PG8_SCHED;
            PG8_LDA(At, 1, 1); PG8_STAGE(PG8_SB(1, 0), b3, voffB); PG8_STAGE(PG8_SB(1, 1), b3 + hstep, voffB); PG8_STAGE(PG8_SA(1, 0), a3, voffA);
            PG8_WAIT_V(8); PG8_WAIT_L(0); PG8_BAR; PG8_MMA(1, 0, At, B0); PG8_MMA(1, 1, At, B1); PG8_BAR; PG8_SCHED;
            } else {
            PG8_LDB(B0, 0, 0); PG8_SCHED; PG8_LDA(At, 0, 0); PG8_STAGE(PG8_SA(1, 1), a1 + hstep, voffA);
            PG8_WAIT_L(8); PG8_BAR; PG8_WAIT_L(0); PG8_MMA(0, 0, At, B0); PG8_BAR; PG8_SCHED;
            PG8_LDB(B1, 0, 1); PG8_STAGE(PG8_SB(0, 0), b2, voffB);
            PG8_BAR; PG8_WAIT_L(0); PG8_MMA(0, 1, At, B1); PG8_BAR;
            PG8_LDA(At, 0, 1); PG8_STAGE(PG8_SA(0, 0), a2, voffA);
            PG8_BAR; PG8_WAIT_L(0); PG8_MMA(1, 0, At, B0); PG8_BAR; PG8_SCHED;
            PG8_STAGE(PG8_SB(0, 1), b2 + hstep, voffB);
            PG8_WAIT_V(6); PG8_BAR; PG8_MMA(1, 1, At, B1); PG8_BAR;
            PG8_LDB(B0, 1, 0); PG8_SCHED; PG8_LDA(At, 1, 0); PG8_STAGE(PG8_SA(0, 1), a2 + hstep, voffA);
            PG8_WAIT_L(8); PG8_BAR; PG8_WAIT_L(0); PG8_MMA(0, 0, At, B0); PG8_BAR; PG8_SCHED;
            PG8_LDB(B1, 1, 1); PG8_STAGE(PG8_SB(1, 0), b3, voffB);
            PG8_BAR; PG8_WAIT_L(0); PG8_MMA(0, 1, At, B1); PG8_BAR;
            PG8_LDA(At, 1, 1); PG8_STAGE(PG8_SA(1, 0), a3, voffA);
            PG8_BAR; PG8_WAIT_L(0); PG8_MMA(1, 0, At, B0); PG8_BAR; PG8_SCHED;
            PG8_STAGE(PG8_SB(1, 1), b3 + hstep, voffB);
            PG8_WAIT_V(6); PG8_BAR; PG8_MMA(1, 1, At, B1); PG8_BAR;
            }
        }
        if constexpr (ALIGN_EPI) { if (wr == 0) PG8_BAR; }
        E(acc, cur, wr, wc, fr, fq); S.done(cur);
        if (!has_next) break;
#pragma unroll
        for (int a = 0; a < 2; ++a)
#pragma unroll
            for (int b = 0; b < 2; ++b)
#pragma unroll
                for (int m = 0; m < 4; ++m)
#pragma unroll
                    for (int n = 0; n < 2; ++n) acc[a][b][m][n] = (f32x4){0.f, 0.f, 0.f, 0.f};
        cur = nxt; cA = nA; cB = nB; ++ui;
        if constexpr (ALIGN_EPI) { if (wr == 1) PG8_BAR; }
    }
    PG8_WAIT_V(0);
    if constexpr (!ALIGN_EPI) { if (wr == 0) PG8_BAR; }
    PG8_BAR;
#undef PG8_SA
#undef PG8_SB
#undef PG8_STAGE
#undef PG8_LDA
#undef PG8_LDB
#undef PG8_MMA
#undef PG8_WAIT_V
#undef PG8_WAIT_L
#undef PG8_BAR
#undef PG8_SCHED
}
}

namespace pg9 {
using pg8::bf16_t; using pg8::bf16x8; using pg8::f32x4; using pg8::f32x2; using pg8::u32x4; using pg8::stage_rc; using pg8::lds_byte; using pg8::perm32; using pg8::cvt_pk_bf16; using pg8::gelu_pk;
constexpr int BMR = 288, BNC = 256, BK = 64, THIRD = 96, HALF = 128, ATB = THIRD * BK * 2, BHB = HALF * BK * 2, NXCD = 8, WGM = 8;
constexpr int STAGE_BYTES = 6 * ATB + 4 * BHB;
struct Unit { int pm, pn; };
struct Gemm { const bf16_t* A; const bf16_t* Bt; int M, N, K, lda, ldb; };
struct Order {
    int nM, nN, nwg, G, c;
    __host__ __device__ void init(int M, int N, int G_, int c_) { nM = M / BMR; nN = N / BNC; nwg = nM * nN; G = G_; c = c_; }
    __host__ __device__ bool next(int i, Unit& u) const {
        const long L = (long)i * G + c; if (L >= nwg) return false;
        int wgid = (int)L; { const int q = nwg / NXCD, r = nwg % NXCD, xcd = wgid % NXCD, off = wgid / NXCD; wgid = (xcd < r ? xcd * (q + 1) : r * (q + 1) + (xcd - r) * q) + off; }
        const int nig = WGM * nN, gid = wgid / nig, fm = gid * WGM, gsz = (nM - fm) < WGM ? (nM - fm) : WGM;
        u.pm = fm + ((wgid % nig) % gsz); u.pn = (wgid % nig) / gsz; return true;
    }
};
template <int ACT  > struct EpiBf16 {
    static constexpr bool PERM = true, AFTER_DRAIN = false, INIT_ACC = false;
    bf16_t* O; int ldc; const float* bias;
    __device__ __forceinline__ void operator()(const f32x4 (&acc)[3][2][3][2], const Unit& u, int wr, int wc, int fr, int fq) const {
        const int row0 = u.pm * BMR + wr * 48 + fr; const int col0 = u.pn * BNC + wc * 32 + 8 * fq;
        f32x4 bv[2][2];
#pragma unroll
        for (int bj = 0; bj < 2; ++bj)
#pragma unroll
            for (int n = 0; n < 2; ++n) bv[bj][n] = (ACT == 1) ? *(const f32x4*)(bias + col0 + bj * HALF + 4 * n) : (f32x4){0.f, 0.f, 0.f, 0.f};
#pragma unroll
        for (int ai = 0; ai < 3; ++ai)
#pragma unroll
            for (int m = 0; m < 3; ++m) { bf16_t* rowp = O + (size_t)(row0 + ai * THIRD + m * 16) * ldc + col0;
#pragma unroll
                for (int bj = 0; bj < 2; ++bj) { f32x4 v0 = acc[ai][bj][m][0] + bv[bj][0], v1 = acc[ai][bj][m][1] + bv[bj][1];
                    if (ACT == 1) { f32x2 a = gelu_pk((f32x2){v0[0], v0[1]}), b = gelu_pk((f32x2){v0[2], v0[3]}), c = gelu_pk((f32x2){v1[0], v1[1]}), d = gelu_pk((f32x2){v1[2], v1[3]});
                        v0 = (f32x4){a.x, a.y, b.x, b.y}; v1 = (f32x4){c.x, c.y, d.x, d.y}; }
                    if (ACT == 2) {
#pragma unroll
                        for (int j = 0; j < 4; ++j) { const float p = fmaxf(v0[j], 0.f), q = fmaxf(v1[j], 0.f); v0[j] = p * p; v1[j] = q * q; } }
                    u32x4 w; w.x = cvt_pk_bf16(v0[0], v0[1]); w.y = cvt_pk_bf16(v0[2], v0[3]); w.z = cvt_pk_bf16(v1[0], v1[1]); w.w = cvt_pk_bf16(v1[2], v1[3]);
                    *(u32x4*)(rowp + bj * HALF) = w; } }
    }
};
struct EpiRes {
    static constexpr bool PERM = false, AFTER_DRAIN = false, INIT_ACC = false;
    float* out; int ldc; const float* resA; const float* resB; int split; float alpha;
    __device__ __forceinline__ void operator()(const f32x4 (&acc)[3][2][3][2], const Unit& u, int wr, int wc, int fr, int fq) const {
        const int row0 = u.pm * BMR + wr * 48 + fr, col0 = u.pn * BNC + wc * 32 + 4 * fq;
#pragma unroll
        for (int ai = 0; ai < 3; ++ai)
#pragma unroll
            for (int m = 0; m < 3; ++m) { const int row = row0 + ai * THIRD + m * 16;
                const float* rp = (row < split ? resA + (size_t)row * ldc : resB + (size_t)(row - split) * ldc) + col0; float* op = out + (size_t)row * ldc + col0;
#pragma unroll
                for (int bj = 0; bj < 2; ++bj)
#pragma unroll
                    for (int n = 0; n < 2; ++n) { const f32x4 rv = *(const f32x4*)(rp + bj * HALF + n * 16); *(f32x4*)(op + bj * HALF + n * 16) = acc[ai][bj][m][n] + rv * alpha; } }
    }
};

struct EpiSg {
    static constexpr bool PERM = true, AFTER_DRAIN = false, INIT_ACC = false;
    bf16_t* O; int ldc; const float* bias; float* stat;
    __device__ __forceinline__ void operator()(const f32x4 (&acc)[3][2][3][2], const Unit& u, int wr, int wc, int fr, int fq) const {
        const int row0 = u.pm * BMR + wr * 48 + fr; const int col0 = u.pn * BNC + wc * 32 + 8 * fq;
        f32x4 bv[2][2];
#pragma unroll
        for (int bj = 0; bj < 2; ++bj)
#pragma unroll
            for (int n = 0; n < 2; ++n) bv[bj][n] = *(const f32x4*)(bias + col0 + bj * HALF + 4 * n);
        const bool vhalf = u.pn >= 8;
#pragma unroll
        for (int ai = 0; ai < 3; ++ai)
#pragma unroll
            for (int m = 0; m < 3; ++m) { const int row = row0 + ai * THIRD + m * 16; bf16_t* rowp = O + (size_t)row * ldc + col0; float s = 0.f, q = 0.f;
#pragma unroll
                for (int bj = 0; bj < 2; ++bj) { f32x4 v0 = acc[ai][bj][m][0] + bv[bj][0], v1 = acc[ai][bj][m][1] + bv[bj][1];
                    { f32x2 a = gelu_pk((f32x2){v0[0], v0[1]}), b = gelu_pk((f32x2){v0[2], v0[3]}), c = gelu_pk((f32x2){v1[0], v1[1]}), d = gelu_pk((f32x2){v1[2], v1[3]});
                        v0 = (f32x4){a.x, a.y, b.x, b.y}; v1 = (f32x4){c.x, c.y, d.x, d.y}; }
                    s += ((v0[0] + v0[1]) + (v0[2] + v0[3])) + ((v1[0] + v1[1]) + (v1[2] + v1[3]));
                    q += ((v0[0] * v0[0] + v0[1] * v0[1]) + (v0[2] * v0[2] + v0[3] * v0[3])) + ((v1[0] * v1[0] + v1[1] * v1[1]) + (v1[2] * v1[2] + v1[3] * v1[3]));
                    u32x4 w; w.x = cvt_pk_bf16(v0[0], v0[1]); w.y = cvt_pk_bf16(v0[2], v0[3]); w.z = cvt_pk_bf16(v1[0], v1[1]); w.w = cvt_pk_bf16(v1[2], v1[3]);
                    *(u32x4*)(rowp + bj * HALF) = w; }
                if (vhalf) { s += __shfl_xor(s, 16); s += __shfl_xor(s, 32); q += __shfl_xor(q, 16); q += __shfl_xor(q, 32);
                    if (fq == 0) { (void)__hip_atomic_fetch_add(stat + 2 * (size_t)row, s, __ATOMIC_RELAXED, __HIP_MEMORY_SCOPE_AGENT); (void)__hip_atomic_fetch_add(stat + 2 * (size_t)row + 1, q, __ATOMIC_RELAXED, __HIP_MEMORY_SCOPE_AGENT); } } }
    }
};

struct PanelStats {
    unsigned* xbuf; unsigned* cnt; unsigned* tmo; float eps;
    __device__ __forceinline__ void run(const f32x4 (&v)[3][2][3][2], const Unit& u, int wr, int wc, int fr, int fq, PG8_LAS unsigned char* lds, int wid, int lane) const {
        PG8_LAS f32x2* P = (PG8_LAS f32x2*)lds;
        PG8_LAS f32x2* St = (PG8_LAS f32x2*)(lds + 9216);
#pragma unroll
        for (int ai = 0; ai < 3; ++ai)
#pragma unroll
            for (int m = 0; m < 3; ++m) {
                float s = 0.f;
#pragma unroll
                for (int bj = 0; bj < 2; ++bj)
#pragma unroll
                    for (int n = 0; n < 2; ++n) { const f32x4 x = v[ai][bj][m][n]; s += (x[0] + x[1]) + (x[2] + x[3]); }
                s += __shfl_xor(s, 16); s += __shfl_xor(s, 32);
                const float mw = s * (1.0f / 64.0f); float q = 0.f;
#pragma unroll
                for (int bj = 0; bj < 2; ++bj)
#pragma unroll
                    for (int n = 0; n < 2; ++n) { const f32x4 d = v[ai][bj][m][n] - mw; q += (d[0] * d[0] + d[1] * d[1]) + (d[2] * d[2] + d[3] * d[3]); }
                q += __shfl_xor(q, 16); q += __shfl_xor(q, 32);
                if (fq == 0) P[(ai * THIRD + wr * 48 + m * 16 + fr) * 4 + wc] = (f32x2){mw, q};
            }
        asm volatile("s_waitcnt lgkmcnt(0)" ::: "memory"); __builtin_amdgcn_s_barrier(); asm volatile("" ::: "memory");
        const int row = wid * 64 + lane;
        if (row < BMR) {
            const f32x2 a = P[row * 4 + 0], b = P[row * 4 + 1], c = P[row * 4 + 2], d = P[row * 4 + 3];
            const float mt = (a.x + b.x + c.x + d.x) * 0.25f;
            const float da = a.x - mt, db = b.x - mt, dc = c.x - mt, dd = d.x - mt;
            const float m2 = (a.y + b.y) + (c.y + d.y) + 64.0f * ((da * da + db * db) + (dc * dc + dd * dd));
            unsigned long long* slot = (unsigned long long*)xbuf + ((size_t)(u.pm * BMR + row) * 8 + u.pn);
            __hip_atomic_store(slot, ((unsigned long long)__float_as_uint(m2) << 32) | __float_as_uint(mt), __ATOMIC_RELAXED, __HIP_MEMORY_SCOPE_AGENT);
        }
        asm volatile("s_waitcnt vmcnt(0)" ::: "memory");
        if (lane == 0) __hip_atomic_fetch_add(cnt + 64 * u.pm, 1u, __ATOMIC_RELAXED, __HIP_MEMORY_SCOPE_AGENT);
        if (wid == 0) {
            unsigned sp = 0u;
            for (;;) {
                if ((unsigned)__builtin_amdgcn_readfirstlane(__hip_atomic_load(cnt + 64 * u.pm, __ATOMIC_RELAXED, __HIP_MEMORY_SCOPE_AGENT)) >= 64u) break;
                __builtin_amdgcn_s_sleep(2);
                if (++sp > (1u << 22)) { if (lane == 0) __hip_atomic_store(tmo, 1u, __ATOMIC_RELAXED, __HIP_MEMORY_SCOPE_AGENT); break; }
            }
            __builtin_amdgcn_fence(__ATOMIC_ACQUIRE, "agent");
        }
        asm volatile("s_waitcnt vmcnt(0) lgkmcnt(0)" ::: "memory"); __builtin_amdgcn_s_barrier(); asm volatile("" ::: "memory");
        if (row < BMR) {
            const unsigned long long* slot = (const unsigned long long*)xbuf + (size_t)(u.pm * BMR + row) * 8; float mt[8], m2[8]; float ms = 0.f;
#pragma unroll
            for (int t = 0; t < 8; ++t) { const unsigned long long w = __hip_atomic_load(slot + t, __ATOMIC_RELAXED, __HIP_MEMORY_SCOPE_AGENT); mt[t] = __uint_as_float((unsigned)w); m2[t] = __uint_as_float((unsigned)(w >> 32)); ms += mt[t]; }
            const float mean = ms * 0.125f; float q = 0.f;
#pragma unroll
            for (int t = 0; t < 8; ++t) { const float dm = mt[t] - mean; q += m2[t] + 256.0f * dm * dm; }
            St[row] = (f32x2){mean, 1.0f / sqrtf(q * (1.0f / 2048.0f) + eps)};
        }
        asm volatile("s_waitcnt lgkmcnt(0)" ::: "memory"); __builtin_amdgcn_s_barrier(); asm volatile("" ::: "memory");
    }
};
struct EpiLn {
    static constexpr bool PERM = true, AFTER_DRAIN = true, INIT_ACC = true;
    const bf16_t* res; int ldr; float alpha;
    const float* gam; const float* bet; float* outf; bf16_t* outb; int ldb16;
    PanelStats st;
    __device__ __forceinline__ void init_load(u32x4 (&rw)[3][3][2], const Unit& u, int wr, int wc, int fr, int fq) const {
        const int row0 = u.pm * BMR + wr * 48 + fr, col0 = u.pn * BNC + wc * 32 + 8 * fq;
#pragma unroll
        for (int ai = 0; ai < 3; ++ai)
#pragma unroll
            for (int m = 0; m < 3; ++m)
#pragma unroll
                for (int bj = 0; bj < 2; ++bj) rw[ai][m][bj] = *(const u32x4*)(res + (size_t)(row0 + ai * THIRD + m * 16) * ldr + col0 + bj * HALF);
    }
    __device__ __forceinline__ void init_acc(f32x4 (&acc)[3][2][3][2], const u32x4 (&rw)[3][3][2]) const {
#pragma unroll
        for (int ai = 0; ai < 3; ++ai)
#pragma unroll
            for (int m = 0; m < 3; ++m)
#pragma unroll
                for (int bj = 0; bj < 2; ++bj) { const u32x4 w = rw[ai][m][bj];
                    acc[ai][bj][m][0] = (f32x4){__uint_as_float(w.x << 16), __uint_as_float(w.x & 0xffff0000u), __uint_as_float(w.y << 16), __uint_as_float(w.y & 0xffff0000u)} * alpha;
                    acc[ai][bj][m][1] = (f32x4){__uint_as_float(w.z << 16), __uint_as_float(w.z & 0xffff0000u), __uint_as_float(w.w << 16), __uint_as_float(w.w & 0xffff0000u)} * alpha; }
    }
    __device__ __forceinline__ void fused(f32x4 (&acc)[3][2][3][2], const Unit& u, int wr, int wc, int fr, int fq, PG8_LAS unsigned char* lds, int wid, int lane) const {
        const PG8_LAS f32x2* St = (const PG8_LAS f32x2*)(lds + 9216);
        const int row0 = u.pm * BMR + wr * 48 + fr, col0 = u.pn * BNC + wc * 32 + 8 * fq;
        st.run(acc, u, wr, wc, fr, fq, lds, wid, lane);
#pragma unroll
        for (int bj = 0; bj < 2; ++bj) {
            const f32x4 g0 = *(const f32x4*)(gam + col0 + bj * HALF), g1 = *(const f32x4*)(gam + col0 + bj * HALF + 4), b0 = *(const f32x4*)(bet + col0 + bj * HALF), b1 = *(const f32x4*)(bet + col0 + bj * HALF + 4);
#pragma unroll
            for (int ai = 0; ai < 3; ++ai)
#pragma unroll
                for (int m = 0; m < 3; ++m) { const int rl = ai * THIRD + wr * 48 + m * 16 + fr; const f32x2 sr = St[rl]; const size_t off = (size_t)(u.pm * BMR + rl) * 2048 + col0 + bj * HALF;
                    const f32x4 y0 = (acc[ai][bj][m][0] - sr.x) * sr.y * g0 + b0, y1 = (acc[ai][bj][m][1] - sr.x) * sr.y * g1 + b1;
                    if (outf) { *(f32x4*)(outf + off) = y0; *(f32x4*)(outf + off + 4) = y1; }
                    if (outb) { u32x4 w; w.x = cvt_pk_bf16(y0[0], y0[1]); w.y = cvt_pk_bf16(y0[2], y0[3]); w.z = cvt_pk_bf16(y1[0], y1[1]); w.w = cvt_pk_bf16(y1[2], y1[3]); *(u32x4*)(outb + (size_t)(u.pm * BMR + rl) * ldb16 + col0 + bj * HALF) = w; }
                    asm volatile("" ::: "memory"); }
        }
    }
};

struct ListOrder { int first, stride, total, nM;
    __host__ __device__ bool next(int i, Unit& u) const { const int id = first + i * stride; if (id >= total) return false; u.pm = id % nM; u.pn = id / nM; return true; } };

template <class Epi, bool ALIGN_EPI = true, class Sched = Order>
__device__ __forceinline__ void gemm_phase(PG8_LAS unsigned char* lds, const Gemm g, const Sched& S, const Epi& E) {
    const int tid = threadIdx.x, wid = __builtin_amdgcn_readfirstlane(tid >> 6), lane = tid & 63, wr = wid >> 2, wc = wid & 3, fr = lane & 15, fq = lane >> 4;
    const int K = g.K, nt = K / BK;
    const int lda = g.lda, ldb = g.ldb;
    unsigned voffA0, voffA1, voffB[2];
    { int R, C; stage_rc((wid & 3) * 1024 + lane * 16, R, C); voffA0 = (unsigned)(R * lda + C) * 2u; stage_rc((wid + 4) * 1024 + lane * 16, R, C); voffA1 = (unsigned)(R * lda + C) * 2u; }
#pragma unroll
    for (int i = 0; i < 2; ++i) { int R, C; stage_rc(tid * 16 + i * 8192, R, C); const int Rb = Epi::PERM ? ((R & ~31) + perm32(R & 31)) : R; voffB[i] = (unsigned)(Rb * ldb + C) * 2u; }
    const size_t kstep = (size_t)(BK * 2);
    const size_t thstep = (size_t)THIRD * lda * 2, hstep = (size_t)HALF * ldb * 2;
    const size_t tstepA = 3 * thstep, tstepB = 2 * hstep;
    const unsigned ldsw = (unsigned)wid * 1024u;
    const int aoff = lds_byte(wr * 48 + fr, fq * 8), boff = lds_byte(wc * 32 + fr, fq * 8);
#define PG9_SA(b, a) (((b) * 3 + (a)) * ATB)
#define PG9_SB(b, h) (6 * ATB + ((b) * 2 + (h)) * BHB)
#define PG9_GLDS(gp, lp) __builtin_amdgcn_global_load_lds((const unsigned*)(gp), (PG8_LAS unsigned*)(lp), 16, 0, 0)
#define PG9_STAGE_A(slot, gbase) do { if (wr == 0) PG9_GLDS((const char*)(gbase) + voffA0, lds + (slot) + ldsw); PG9_GLDS((const char*)(gbase) + voffA1, lds + (slot) + ldsw + 4096); } while (0)
#define PG9_STAGE_B(slot, gbase) do { PG9_GLDS((const char*)(gbase) + voffB[0], lds + (slot) + ldsw); PG9_GLDS((const char*)(gbase) + voffB[1], lds + (slot) + ldsw + 8192); } while (0)
#define PG9_LDA(dst, b, a) do { _Pragma("unroll") for (int m = 0; m < 3; ++m) _Pragma("unroll") for (int k = 0; k < 2; ++k) dst[m][k] = *(const PG8_LAS bf16x8*)(lds + PG9_SA(b, a) + aoff + m * 2048 + k * 1024); } while (0)
#define PG9_LDB(dst, b, h) do { _Pragma("unroll") for (int n = 0; n < 2; ++n) _Pragma("unroll") for (int k = 0; k < 2; ++k) dst[n][k] = *(const PG8_LAS bf16x8*)(lds + PG9_SB(b, h) + boff + n * 2048 + k * 1024); } while (0)
#define PG9_MMA(ai, bj, At, Bt) do { _Pragma("unroll") for (int m = 0; m < 3; ++m) _Pragma("unroll") for (int n = 0; n < 2; ++n) _Pragma("unroll") for (int k = 0; k < 2; ++k) \
        acc[ai][bj][m][n] = __builtin_amdgcn_mfma_f32_16x16x32_bf16(Bt[n][k], At[m][k], acc[ai][bj][m][n], 0, 0, 0); } while (0)
#define PG9_MMA2(ai) do { __builtin_amdgcn_s_setprio(1); PG9_MMA(ai, 0, At, B0); PG9_MMA(ai, 1, At, B1); __builtin_amdgcn_s_setprio(0); } while (0)
#define PG9_WAIT_V2(a, b) do { if (wr == 0) asm volatile("s_waitcnt vmcnt(" #a ")" ::: "memory"); else asm volatile("s_waitcnt vmcnt(" #b ")" ::: "memory"); } while (0)
#define PG9_WAIT_L0 asm volatile("s_waitcnt lgkmcnt(0)" ::: "memory")
#define PG9_BAR __builtin_amdgcn_s_barrier()
#define PG9_SCHED __builtin_amdgcn_sched_barrier(0)
    Unit cur, nxt; int ui = 0;
    if (!S.next(0, cur)) return;
    f32x4 acc[3][2][3][2];
    u32x4 rinit[3][3][2];
    if constexpr (Epi::INIT_ACC) E.init_load(rinit, cur, wr, wc, fr, fq);
    else {
#pragma unroll
    for (int a = 0; a < 3; ++a)
#pragma unroll
        for (int b = 0; b < 2; ++b)
#pragma unroll
            for (int m = 0; m < 3; ++m)
#pragma unroll
                for (int n = 0; n < 2; ++n) acc[a][b][m][n] = (f32x4){0.f, 0.f, 0.f, 0.f};
    }
    bf16x8 At[3][2], B0[2][2], B1[2][2];
    const char* cA = (const char*)g.A + (size_t)cur.pm * tstepA; const char* cB = (const char*)g.Bt + (size_t)cur.pn * tstepB;
    PG9_STAGE_B(PG9_SB(0, 0), cB); PG9_STAGE_B(PG9_SB(0, 1), cB + hstep); PG9_STAGE_A(PG9_SA(0, 0), cA); PG9_STAGE_A(PG9_SA(0, 1), cA + thstep); PG9_STAGE_A(PG9_SA(0, 2), cA + 2 * thstep);
    if constexpr (Epi::INIT_ACC) { PG9_SCHED; E.init_acc(acc, rinit); PG9_SCHED; }
    if (wr == 1) PG9_BAR;
    PG9_WAIT_V2(4, 2); PG9_BAR;
    PG9_STAGE_B(PG9_SB(1, 0), cB + kstep); PG9_STAGE_B(PG9_SB(1, 1), cB + hstep + kstep); PG9_STAGE_A(PG9_SA(1, 0), cA + kstep); PG9_STAGE_A(PG9_SA(1, 1), cA + thstep + kstep);
    PG9_WAIT_V2(8, 6); PG9_BAR;
    for (;;) {
        const bool has_next = S.next(ui + 1, nxt);
        const char* nA = has_next ? (const char*)g.A + (size_t)nxt.pm * tstepA : cA; const char* nB = has_next ? (const char*)g.Bt + (size_t)nxt.pn * tstepB : cB;
        for (int t = 0; t < nt; t += 2) {
            const bool last = (t == nt - 2);
            const char* a1 = cA + (size_t)(t + 1) * kstep;
            const char* a2 = last ? nA : cA + (size_t)(t + 2) * kstep; const char* b2 = last ? nB : cB + (size_t)(t + 2) * kstep;
            const char* a3 = a2 + kstep; const char* b3 = b2 + kstep;
            PG9_LDB(B0, 0, 0); PG9_LDB(B1, 0, 1); PG9_SCHED; PG9_LDA(At, 0, 0); PG9_STAGE_A(PG9_SA(1, 2), a1 + 2 * thstep);
            PG9_WAIT_V2(12, 8); PG9_WAIT_L0; PG9_BAR; PG9_MMA2(0); PG9_BAR; PG9_SCHED;
            PG9_LDA(At, 0, 1); PG9_STAGE_B(PG9_SB(0, 0), b2); PG9_STAGE_B(PG9_SB(0, 1), b2 + hstep);
            PG9_WAIT_V2(14, 11); PG9_WAIT_L0; PG9_BAR; PG9_MMA2(1); PG9_BAR; PG9_SCHED;
            PG9_LDA(At, 0, 2); PG9_STAGE_A(PG9_SA(0, 0), a2); PG9_STAGE_A(PG9_SA(0, 1), a2 + thstep);
            PG9_WAIT_V2(12, 8); PG9_WAIT_L0; PG9_BAR; PG9_MMA2(2); PG9_BAR; PG9_SCHED;
            PG9_LDB(B0, 1, 0); PG9_LDB(B1, 1, 1); PG9_SCHED; PG9_LDA(At, 1, 0); PG9_STAGE_A(PG9_SA(0, 2), a2 + 2 * thstep);
            PG9_WAIT_V2(12, 8); PG9_WAIT_L0; PG9_BAR; PG9_MMA2(0); PG9_BAR; PG9_SCHED;
            PG9_LDA(At, 1, 1); PG9_STAGE_B(PG9_SB(1, 0), b3); PG9_STAGE_B(PG9_SB(1, 1), b3 + hstep);
            PG9_WAIT_V2(14, 11); PG9_WAIT_L0; PG9_BAR; PG9_MMA2(1); PG9_BAR; PG9_SCHED;
            PG9_LDA(At, 1, 2); PG9_STAGE_A(PG9_SA(1, 0), a3); PG9_STAGE_A(PG9_SA(1, 1), a3 + thstep);
            PG9_WAIT_V2(12, 8); PG9_WAIT_L0; PG9_BAR; PG9_MMA2(2); PG9_BAR; PG9_SCHED;
        }
        if constexpr (ALIGN_EPI) { if (wr == 0) PG9_BAR; }
        if constexpr (!Epi::AFTER_DRAIN) E(acc, cur, wr, wc, fr, fq);
        if (!has_next) break;
#pragma unroll
        for (int a = 0; a < 3; ++a)
#pragma unroll
            for (int b = 0; b < 2; ++b)
#pragma unroll
                for (int m = 0; m < 3; ++m)
#pragma unroll
                    for (int n = 0; n < 2; ++n) acc[a][b][m][n] = (f32x4){0.f, 0.f, 0.f, 0.f};
        cur = nxt; cA = nA; cB = nB; ++ui;
        if constexpr (ALIGN_EPI) { if (wr == 1) PG9_BAR; }
    }
    asm volatile("s_waitcnt vmcnt(0)" ::: "memory");
    if constexpr (!ALIGN_EPI) { if (wr == 0) PG9_BAR; }
    PG9_BAR;
    if constexpr (Epi::AFTER_DRAIN) E.fused(acc, cur, wr, wc, fr, fq, lds, wid, lane);
#undef PG9_SA
#undef PG9_SB
#undef PG9_GLDS
#undef PG9_STAGE_A
#undef PG9_STAGE_B
#undef PG9_LDA
#undef PG9_LDB
#undef PG9_MMA
#undef PG9_MMA2
#undef PG9_WAIT_V2
#undef PG9_WAIT_L0
#undef PG9_BAR
#undef PG9_SCHED
}
}

constexpr int NWAVES = 8, NTHR = NWAVES * 64;
constexpr int N_LAUNCHES = MK_N_LAUNCHES;
constexpr int NPHASE = 12;
constexpr int DM = 2048, MP = 8192, MS = 1024, M = MP + MS;
constexpr int SEQ = 2048, NB = 4, DB = 128, DT = 8;
constexpr int NH = 4, HK = 256, HV = 512, KD = 1024, RANK = 16;
constexpr int NPROJ = 6144, NQKV = 4096, RG_WGS = 86, WIN_LD = 6160, DFF = 8192, SGW = 2048, SGG = 8, SGC = 128, SGD = 256;
constexpr int PK2 = DM + 64, PK8 = DFF + 64;
constexpr float ALPHA = 1.41421356237309515f;
constexpr float LN_EPS = 1e-5f, HN_EPS = 1e-6f;
constexpr size_t OUT_Y = 0, OUT_SP = (size_t)M * DM, OUT_SS = OUT_SP + (size_t)NB * NH * HK * HV, OUT_SGV = OUT_SS + (size_t)DB * NH * HK * HV, OUT_END = OUT_SGV + (size_t)MS * SGW;

constexpr size_t MiB = 1u << 20;
constexpr size_t WS_CTL = 0, CTL_ZERO_BYTES = 1 * MiB;
constexpr size_t WS_WIN = 1 * MiB;
constexpr size_t WS_WOUT = WS_WIN + 25 * MiB;
constexpr size_t WS_W1 = WS_WOUT + 9 * MiB;
constexpr size_t WS_W2 = WS_W1 + 66 * MiB;
constexpr size_t WS_SGIN = WS_W2 + 65 * MiB;
constexpr size_t WS_SGOUT = WS_SGIN + 17 * MiB;
constexpr size_t WS_WC = WS_SGOUT + 9 * MiB;
constexpr size_t WS_XB = WS_WC + 1 * MiB;
constexpr size_t WS_RA = WS_XB + 38 * MiB;
constexpr size_t WS_PROJ = WS_RA, WS_LOGA = WS_RA + 108 * MiB, WS_HB = WS_RA;
constexpr size_t WS_RB = WS_RA + 146 * MiB;
constexpr size_t WS_O = WS_RB, WS_Z = WS_RB;
constexpr size_t WS_A2 = WS_RB + 72 * MiB;
constexpr size_t WS_XCH = WS_A2 + 38 * MiB;
constexpr size_t WS_X1 = WS_XCH + 1 * MiB;
constexpr size_t WS_X2 = WS_X1 + 72 * MiB;
constexpr size_t WS_VN = WS_X2 + 72 * MiB;
constexpr size_t WS_STAT = WS_VN + 36 * MiB;
constexpr size_t WS_IMG = WS_STAT + 1 * MiB;
constexpr size_t WS_END = WS_IMG + 37 * MiB;
constexpr int CW_BAR = 4096;
constexpr int CW_QUEUE = 64;
constexpr int CW_TMO = 1;
constexpr int CW_GATE = 8192;
constexpr int CW_LN = 16384, LN_BANK = 32 * 64;

constexpr int RING_BYTES = 139264;
constexpr int LDS_BYTES = 147456;
constexpr int MISC_OFF = LDS_BYTES - 256;

#define GAS __attribute__((address_space(1)))
#define LAS __attribute__((address_space(3)))
typedef unsigned short bf16;
typedef unsigned v4u __attribute__((ext_vector_type(4)));
typedef unsigned v2u __attribute__((ext_vector_type(2)));
typedef float f32x4 __attribute__((ext_vector_type(4)));
typedef short bf16x8 __attribute__((ext_vector_type(8)));
#define RLX_AGENT __ATOMIC_RELAXED, __HIP_MEMORY_SCOPE_AGENT
#define LDS_WAIT() asm volatile("s_waitcnt lgkmcnt(0)" ::: "memory")
#define VM_WAIT() asm volatile("s_waitcnt vmcnt(0)" ::: "memory")
__device__ __forceinline__ unsigned pk2(float lo, float hi) { return pg8::cvt_pk_bf16(lo, hi); }
__device__ __forceinline__ float bf_lo(unsigned w) { return __uint_as_float(w << 16); }
__device__ __forceinline__ float bf_hi(unsigned w) { return __uint_as_float(w & 0xffff0000u); }
__device__ __forceinline__ float bf2f(bf16 b) { return __uint_as_float(((unsigned)b) << 16); }

#define XB_TMO      128
#define XB_XCNT(j)  (256  + 64 * (j))
#define XB_XSUB(j)  (1280 + 64 * (j))
#define XB_XGEN(j)  (2304 + 64 * (j))
#define XB_TOP      3328
#define XB_TOPGEN   3392
#define XCD_BAR_WORDS 3456
#define XB_SPIN_CAP (1u << 22)
__device__ __forceinline__ unsigned xb_ld(unsigned* p)              { return __hip_atomic_load(p, __ATOMIC_RELAXED, __HIP_MEMORY_SCOPE_AGENT); }
__device__ __forceinline__ unsigned xb_add(unsigned* p, unsigned v) { return __hip_atomic_fetch_add(p, v, __ATOMIC_RELAXED, __HIP_MEMORY_SCOPE_AGENT); }
__device__ __forceinline__ unsigned xb_xcc_id() { return (unsigned)__builtin_amdgcn_s_getreg((3 << 11) | 20) & 0xFu; }
#define XB_SPIN(cond, bar) do { unsigned _sp = 0; while (cond) { __builtin_amdgcn_s_sleep(1); \
    if ((++_sp & 255u) == 0u) { if (xb_ld(&(bar)[XB_TMO])) break; if (_sp > XB_SPIN_CAP) { atomicAdd(&(bar)[XB_TMO], 1u); break; } } } } while (0)
struct XcdBarrier { unsigned* bar; unsigned x; volatile LAS unsigned* st; };
__device__ __forceinline__ XcdBarrier xcd_barrier_post(unsigned* bar, volatile LAS unsigned* st) {
    XcdBarrier b; b.bar = bar; b.x = xb_xcc_id(); b.st = st;
    if (threadIdx.x == 0) (void)xb_add(&bar[XB_XCNT(b.x)], 1u);
    return b;
}
__device__ __forceinline__ void xcd_barrier_complete(unsigned* bar, unsigned x, unsigned& nloc, unsigned& nx) {
    const unsigned G = gridDim.x * gridDim.y * gridDim.z;
    unsigned sum, cnt, mine, sp = 0u;
    for (;;) {
        sum = 0u; cnt = 0u; mine = 0u;
#pragma unroll
        for (unsigned j = 0; j < 16; ++j) { const unsigned c = xb_ld(&bar[XB_XCNT(j)]); sum += c; cnt += (c > 0u) ? 1u : 0u; mine = (j == x) ? c : mine; }
        if (sum == G) break;
        __builtin_amdgcn_s_sleep(1);
        if ((++sp & 255u) == 0u) { if (xb_ld(&bar[XB_TMO])) break; if (sp > XB_SPIN_CAP) { atomicAdd(&bar[XB_TMO], 1u); break; } }
    }
    nloc = mine > 0u ? mine : 1u; nx = cnt > 0u ? cnt : 1u;
}
__device__ __forceinline__ void xcd_barrier(const XcdBarrier& b) {
    asm volatile("s_waitcnt vmcnt(0)" ::: "memory");
    __syncthreads();
    if (threadIdx.x == 0) {
        unsigned* bar = b.bar;
        __builtin_amdgcn_s_waitcnt(0);
        unsigned nloc = b.st[0], nx = b.st[1];
        if (nloc == 0u) { xcd_barrier_complete(bar, b.x, nloc, nx); b.st[0] = nloc; b.st[1] = nx; }
        const unsigned old = xb_add(&bar[XB_XSUB(b.x)], 1u);
        const unsigned gen = old / nloc;
        if (old + 1u == (gen + 1u) * nloc) {
            __builtin_amdgcn_fence(__ATOMIC_RELEASE, "agent");
            asm volatile("s_waitcnt vmcnt(0)" ::: "memory");
            const unsigned og = xb_add(&bar[XB_TOP], 1u);
            const unsigned tg = og / nx;
            if (og + 1u == (tg + 1u) * nx) xb_add(&bar[XB_TOPGEN], 1u);
            else XB_SPIN(xb_ld(&bar[XB_TOPGEN]) == tg, bar);
            __builtin_amdgcn_fence(__ATOMIC_ACQUIRE, "agent");
            xb_add(&bar[XB_XGEN(b.x)], 1u);
            asm volatile("s_waitcnt vmcnt(0)" ::: "memory");
        } else {
            XB_SPIN(xb_ld(&bar[XB_XGEN(b.x)]) == gen, bar);
            __builtin_amdgcn_fence(__ATOMIC_ACQUIRE, "agent");
            asm volatile("s_waitcnt vmcnt(0)" ::: "memory");
        }
    }
    __syncthreads();
}

struct Frame {
    LAS unsigned char* lds;
    volatile LAS unsigned* MISC;
    unsigned* ctl;
    int tid, lane, wave, vcu, G;
    const float* in[21];
    float* out;
    unsigned char* ws;
};
__device__ __forceinline__ float wave_sum(float v) {
#pragma unroll
    for (int o = 1; o < 64; o <<= 1) v += __shfl_xor(v, o);
    return v;
}
__device__ __forceinline__ const float* xrow_ptr(const Frame& F, int m) { return m < MP ? F.in[0] + (size_t)m * DM : F.in[1] + (size_t)(m - MP) * DM; }

__device__ __forceinline__ void p0_transpose_item(const float* W, int ldw, int ldk, bf16* WT, int item, int nblk, int lane) {
    const int kb = item / nblk, nb = item - kb * nblk, k0 = 64 * kb, n0 = 64 * nb, q = lane >> 4, c = lane & 15;
    f32x4 v[16];
    const float* src = W + (size_t)(k0 + 16 * q) * ldw + n0 + 4 * c;
#pragma unroll
    for (int i = 0; i < 16; ++i) v[i] = __builtin_nontemporal_load((const f32x4*)(src + (size_t)i * ldw));
#pragma unroll
    for (int j = 0; j < 4; ++j) {
        v4u lo, hi;
        lo.x = pk2(v[0][j], v[1][j]); lo.y = pk2(v[2][j], v[3][j]); lo.z = pk2(v[4][j], v[5][j]); lo.w = pk2(v[6][j], v[7][j]);
        hi.x = pk2(v[8][j], v[9][j]); hi.y = pk2(v[10][j], v[11][j]); hi.z = pk2(v[12][j], v[13][j]); hi.w = pk2(v[14][j], v[15][j]);
        bf16* dst = WT + (size_t)(n0 + 4 * c + j) * ldk + k0 + 16 * q;
        *(v4u*)dst = lo; *(v4u*)(dst + 8) = hi;
    }
}
constexpr int DT_I_WOUT = (DM / 64) * (DM / 64), DT_I_W1 = (DM / 64) * (DFF / 64), DT_I_W2 = (DFF / 64) * (DM / 64), DT_I_SGIN = (DM / 64) * (2 * SGW / 64), DT_I_SGOUT = (SGW / 64) * (DM / 64);
constexpr int DT_NITEMS = DT_I_WOUT + 2 * DT_I_W1 + 2 * DT_I_W2 + DT_I_SGIN + DT_I_SGOUT, DT_NCHUNK = DT_NITEMS / 64;
static_assert(DT_NITEMS % 64 == 0, "deferred transposes: whole chunks");
__device__ __forceinline__ void deferred_transpose_chunk(Frame& F, int chunk) {
    unsigned char* ws = F.ws;
    for (int i = 0; i < 8; ++i) {
        int r = chunk * 64 + F.wave * 8 + i;
        if (r < DT_I_WOUT) { p0_transpose_item(F.in[7], DM, PK2, (bf16*)(ws + WS_WOUT), r, DM / 64, F.lane); continue; } r -= DT_I_WOUT;
        if (r < 2 * DT_I_W1) { const int l = r / DT_I_W1; r -= l * DT_I_W1; p0_transpose_item(F.in[15] + (size_t)l * DM * DFF, DFF, PK2, (bf16*)(ws + WS_W1) + (size_t)l * DFF * PK2, r, DFF / 64, F.lane); continue; } r -= 2 * DT_I_W1;
        if (r < 2 * DT_I_W2) { const int l = r / DT_I_W2; r -= l * DT_I_W2; p0_transpose_item(F.in[16] + (size_t)l * DFF * DM, DM, PK8, (bf16*)(ws + WS_W2) + (size_t)l * DM * PK8, r, DM / 64, F.lane); continue; } r -= 2 * DT_I_W2;
        if (r < DT_I_SGIN) { p0_transpose_item(F.in[8], 2 * SGW, PK2, (bf16*)(ws + WS_SGIN), r, 2 * SGW / 64, F.lane); continue; } r -= DT_I_SGIN;
        p0_transpose_item(F.in[14], DM, PK2, (bf16*)(ws + WS_SGOUT), r, DM / 64, F.lane);
    }
}
__device__ __forceinline__ float logsigmoid_f(float x) { return fminf(x, 0.f) - log1pf(expf(-fabsf(x))); }
__device__ __forceinline__ float logsigmoid_fast(float x) { return fminf(x, 0.f) - __logf(1.0f + __expf(-fabsf(x))); }
__device__ __forceinline__ void p0_prologue(Frame& F) {
    const int gw = F.vcu * NWAVES + F.wave, NGW = F.G * NWAVES;
    unsigned char* ws = F.ws;
    {
        constexpr int I_WIN = (DM / 64) * (NPROJ / 64);
        for (int it = gw; it < I_WIN; it += NGW) p0_transpose_item(F.in[3], WIN_LD, PK2, (bf16*)(ws + WS_WIN), it, NPROJ / 64, F.lane);
    }
    {
        bf16* wc = (bf16*)(ws + WS_WC); const float* wsp = F.in[12];
        for (int i = F.vcu * NTHR + F.tid; i < SGG * SGC * SGC; i += F.G * NTHR) { const int s = i & 127, t = (i >> 7) & 127; wc[i] = (bf16)(pk2(s <= t ? wsp[i] : 0.f, 0.f) & 0xffffu); }
        float* stat = (float*)(ws + WS_STAT);
        for (int i = F.vcu * NTHR + F.tid; i < 2 * M; i += F.G * NTHR) stat[i] = 0.f;
    }
    {
        constexpr int WGP = DM + 4;
        LAS float* wgT = (LAS float*)F.lds;
        for (int idx = F.tid; idx < DM * 4; idx += NTHR) { const int k = idx >> 2, part = idx & 3; const f32x4 w = *(const f32x4*)(F.in[3] + (size_t)k * WIN_LD + NPROJ + 4 * part);
            wgT[(4 * part + 0) * WGP + k] = w.x; wgT[(4 * part + 1) * WGP + k] = w.y; wgT[(4 * part + 2) * WGP + k] = w.z; wgT[(4 * part + 3) * WGP + k] = w.w; }
        __syncthreads();
        const float* wgate = F.in[4]; const float* bgate = F.in[5];
        bf16* xb = (bf16*)(ws + WS_XB); float* loga = (float*)(ws + WS_LOGA);
        const int rows_wg = M / F.G;
        const int r_lo = (F.wave * rows_wg) / NWAVES, r_hi = ((F.wave + 1) * rows_wg) / NWAVES;
        const int lane = F.lane, fr = lane & 15, fq = lane >> 4;
        LAS float* GT = (LAS float*)(F.lds + 16 * WGP * 4);
        {
            const int kw = F.wave * 256, ntile = (rows_wg + 15) >> 4;
            pg8::bf16x8 bh[8], bl[8];
#pragma unroll
            for (int ks = 0; ks < 8; ++ks) { const f32x4 w0 = *(const LAS f32x4*)(wgT + fr * WGP + kw + 32 * ks + 8 * fq), w1 = *(const LAS f32x4*)(wgT + fr * WGP + kw + 32 * ks + 8 * fq + 4);
                const v4u h = (v4u){pk2(w0.x, w0.y), pk2(w0.z, w0.w), pk2(w1.x, w1.y), pk2(w1.z, w1.w)};
                const v4u l = (v4u){pk2(w0.x - bf_lo(h.x), w0.y - bf_hi(h.x)), pk2(w0.z - bf_lo(h.y), w0.w - bf_hi(h.y)), pk2(w1.x - bf_lo(h.z), w1.y - bf_hi(h.z)), pk2(w1.z - bf_lo(h.w), w1.w - bf_hi(h.w))};
                bh[ks] = __builtin_bit_cast(pg8::bf16x8, h); bl[ks] = __builtin_bit_cast(pg8::bf16x8, l); }
            __syncthreads();
            LAS f32x4* PS = (LAS f32x4*)F.lds;
            f32x4 xa[8][2];
            { const int row = fr < rows_wg ? fr : rows_wg - 1; const float* xp = xrow_ptr(F, F.vcu * rows_wg + row) + kw + 8 * fq;
#pragma unroll
              for (int ks = 0; ks < 8; ++ks) { xa[ks][0] = *(const f32x4*)(xp + 32 * ks); xa[ks][1] = *(const f32x4*)(xp + 32 * ks + 4); } }
            for (int rt = 0; rt < ntile; ++rt) {
                const int row = 16 * rt + fr; const bool valid = row < rows_wg; const int m = F.vcu * rows_wg + (valid ? row : rows_wg - 1);
                f32x4 xc[8][2];
#pragma unroll
                for (int ks = 0; ks < 8; ++ks) { xc[ks][0] = xa[ks][0]; xc[ks][1] = xa[ks][1]; }
                if (rt + 1 < ntile) { const int rown = 16 * (rt + 1) + fr; const float* xp = xrow_ptr(F, F.vcu * rows_wg + (rown < rows_wg ? rown : rows_wg - 1)) + kw + 8 * fq;
#pragma unroll
                    for (int ks = 0; ks < 8; ++ks) { xa[ks][0] = *(const f32x4*)(xp + 32 * ks); xa[ks][1] = *(const f32x4*)(xp + 32 * ks + 4); } }
                f32x4 acc = (f32x4){0.f, 0.f, 0.f, 0.f};
                bf16* xo = xb + (size_t)m * PK2 + kw + 8 * fq;
#pragma unroll
                for (int ks = 0; ks < 8; ++ks) { const f32x4 w0 = xc[ks][0], w1 = xc[ks][1];
                    const v4u h = (v4u){pk2(w0.x, w0.y), pk2(w0.z, w0.w), pk2(w1.x, w1.y), pk2(w1.z, w1.w)};
                    const v4u l = (v4u){pk2(w0.x - bf_lo(h.x), w0.y - bf_hi(h.x)), pk2(w0.z - bf_lo(h.y), w0.w - bf_hi(h.y)), pk2(w1.x - bf_lo(h.z), w1.y - bf_hi(h.z)), pk2(w1.z - bf_lo(h.w), w1.w - bf_hi(h.w))};
                    if (valid) *(v4u*)(xo + 32 * ks) = h;
                    const pg8::bf16x8 ah = __builtin_bit_cast(pg8::bf16x8, h), al = __builtin_bit_cast(pg8::bf16x8, l);
                    acc = __builtin_amdgcn_mfma_f32_16x16x32_bf16(ah, bh[ks], acc, 0, 0, 0);
                    acc = __builtin_amdgcn_mfma_f32_16x16x32_bf16(al, bh[ks], acc, 0, 0, 0);
                    acc = __builtin_amdgcn_mfma_f32_16x16x32_bf16(ah, bl[ks], acc, 0, 0, 0); }
                PS[(F.wave * ntile + rt) * 64 + lane] = acc;
            }
            __syncthreads();
            for (int idx = F.tid; idx < rows_wg * 16; idx += NTHR) { const int row = idx >> 4, r = idx & 15, rt = row >> 4, ml = row & 15; float t = 0.f;
#pragma unroll
                for (int w = 0; w < NWAVES; ++w) t += ((const LAS float*)(PS + (w * ntile + rt) * 64 + 16 * (ml >> 2) + r))[ml & 3];
                GT[row * 16 + r] = t; }
        }
        __syncthreads();
        LAS float* WG = (LAS float*)F.lds;
        LAS float* BG = WG + 16 * KD;
        for (int idx = F.tid; idx < 17 * KD / 4; idx += NTHR) *((LAS f32x4*)F.lds + idx) = (idx < 16 * KD / 4) ? *((const f32x4*)wgate + idx) : *((const f32x4*)bgate + (idx - 16 * KD / 4));
        __syncthreads();
        for (int rl = r_lo; rl < r_hi; ++rl) { const int m = F.vcu * rows_wg + rl;
            const f32x4 g0 = *(const LAS f32x4*)(GT + rl * 16), g1 = *(const LAS f32x4*)(GT + rl * 16 + 4), g2 = *(const LAS f32x4*)(GT + rl * 16 + 8), g3 = *(const LAS f32x4*)(GT + rl * 16 + 12);
            const float g[16] = {g0.x, g0.y, g0.z, g0.w, g1.x, g1.y, g1.z, g1.w, g2.x, g2.y, g2.z, g2.w, g3.x, g3.y, g3.z, g3.w};
#pragma unroll
            for (int j = 0; j < 4; ++j) { const int c0 = 4 * lane + 256 * j; f32x4 lg0 = *(const LAS f32x4*)(BG + c0);
#pragma unroll
                for (int r = 0; r < 16; ++r) { const f32x4 w = *(const LAS f32x4*)(WG + r * KD + c0); lg0 += w * g[r]; }
                f32x4 o;
                o.x = logsigmoid_fast(lg0.x) * 0.0625f; o.y = logsigmoid_fast(lg0.y) * 0.0625f; o.z = logsigmoid_fast(lg0.z) * 0.0625f; o.w = logsigmoid_fast(lg0.w) * 0.0625f; *(f32x4*)(loga + (size_t)m * KD + c0) = o;
                asm volatile("" ::: "memory"); }
        }
        __syncthreads();
    }
}

constexpr size_t IMG_QD = 0, IMG_KET = 32768, IMG_P = 65536, IMG_DV = 73728, IMG_BYTES = 74752;
constexpr int PP_QD = 0, PP_KI = 33792, PP_P = 67584, PP_RS = 76800;
constexpr int QD_PITCH = 528, T_PITCH = 144;
__device__ __forceinline__ pg8::bf16x8 as_bf16x8(v4u w) { return __builtin_bit_cast(pg8::bf16x8, w); }
__device__ __forceinline__ void gla_prep_item(Frame& F, int item) {
    const int n = item & 31, h = (item >> 5) & 3, b = item >> 7;
    const bf16* proj = (const bf16*)(F.ws + WS_PROJ); const float* loga = (const float*)(F.ws + WS_LOGA);
    unsigned char* img = F.ws + WS_IMG + (size_t)item * IMG_BYTES;
    LAS unsigned char* L = F.lds;
    const int tid = F.tid, lane = F.lane, w = F.wave, fr = lane & 15, fq = lane >> 4, cp = tid & 63, rg = tid >> 6;
    f32x4 lg[8]; v2u qr[8], kr[8];
    { const size_t R0 = (size_t)b * SEQ + (size_t)n * 64;
#pragma unroll
      for (int s = 0; s < 8; ++s) { const size_t row = R0 + 8 * rg + s;
          lg[s] = *(const f32x4*)(loga + row * KD + h * HK + 4 * cp); qr[s] = *(const v2u*)(proj + row * NPROJ + h * HK + 4 * cp); kr[s] = *(const v2u*)(proj + row * NPROJ + KD + h * HK + 4 * cp); } }
    __syncthreads();
    { f32x4 c = (f32x4){0.f, 0.f, 0.f, 0.f};
#pragma unroll
      for (int s = 0; s < 8; ++s) { c += lg[s]; lg[s] = c; }
      *((LAS f32x4*)(L + PP_RS) + rg * 64 + cp) = c; }
    __syncthreads();
    { f32x4 off = (f32x4){0.f, 0.f, 0.f, 0.f}, tot = (f32x4){0.f, 0.f, 0.f, 0.f};
#pragma unroll
      for (int r = 0; r < 8; ++r) { const f32x4 v = *((const LAS f32x4*)(L + PP_RS) + r * 64 + cp); tot += v; if (r < rg) off += v; }
      f32x4 ei; ei.x = __expf(-tot.x); ei.y = __expf(-tot.y); ei.z = __expf(-tot.z); ei.w = __expf(-tot.w);
      unsigned ke[4][4];
#pragma unroll
      for (int s2 = 0; s2 < 4; ++s2) { f32x4 kev[2]; unsigned qw[4];
#pragma unroll
          for (int u = 0; u < 2; ++u) { const int s = 2 * s2 + u; const f32x4 bb = off + lg[s], tb = tot - bb;
              f32x4 e1, e3; e1.x = __expf(bb.x); e1.y = __expf(bb.y); e1.z = __expf(bb.z); e1.w = __expf(bb.w); e3.x = __expf(tb.x); e3.y = __expf(tb.y); e3.z = __expf(tb.z); e3.w = __expf(tb.w);
              const f32x4 q4 = (f32x4){bf_lo(qr[s].x), bf_hi(qr[s].x), bf_lo(qr[s].y), bf_hi(qr[s].y)}, k4 = (f32x4){bf_lo(kr[s].x), bf_hi(kr[s].x), bf_lo(kr[s].y), bf_hi(kr[s].y)};
              const f32x4 qd = q4 * e1 * 0.0625f; kev[u] = k4 * e3; const f32x4 ki = kev[u] * ei;
              qw[2 * u] = pk2(qd.x, qd.y); qw[2 * u + 1] = pk2(qd.z, qd.w);
              *(LAS v2u*)(L + PP_QD + (8 * rg + s) * QD_PITCH + 8 * cp) = (v2u){qw[2 * u], qw[2 * u + 1]};
              *(LAS v2u*)(L + PP_KI + (8 * rg + s) * QD_PITCH + 8 * cp) = (v2u){pk2(ki.x, ki.y), pk2(ki.z, ki.w)}; }
          *((v4u*)(img + IMG_QD) + s2 * NTHR + tid) = (v4u){qw[0], qw[1], qw[2], qw[3]};
          ke[0][s2] = pk2(kev[0].x, kev[1].x); ke[1][s2] = pk2(kev[0].y, kev[1].y); ke[2][s2] = pk2(kev[0].z, kev[1].z); ke[3][s2] = pk2(kev[0].w, kev[1].w); }
#pragma unroll
      for (int c4 = 0; c4 < 4; ++c4) *((v4u*)(img + IMG_KET) + c4 * NTHR + tid) = (v4u){ke[c4][0], ke[c4][1], ke[c4][2], ke[c4][3]};
      if (rg == 0) { f32x4 dv; dv.x = __expf(tot.x); dv.y = __expf(tot.y); dv.z = __expf(tot.z); dv.w = __expf(tot.w); *((f32x4*)(img + IMG_DV) + cp) = dv; }
    }
    __syncthreads();
    { const int ttw = w >> 1, sp = w & 1;
      f32x4 sc0 = (f32x4){0.f, 0.f, 0.f, 0.f}, sc1 = (f32x4){0.f, 0.f, 0.f, 0.f};
      if (2 * sp <= ttw) {
#pragma unroll
          for (int ks = 0; ks < 8; ++ks) { const pg8::bf16x8 a = *(const LAS pg8::bf16x8*)(L + PP_QD + (16 * ttw + fr) * QD_PITCH + (32 * ks + 8 * fq) * 2);
              const pg8::bf16x8 b0 = *(const LAS pg8::bf16x8*)(L + PP_KI + (16 * (2 * sp) + fr) * QD_PITCH + (32 * ks + 8 * fq) * 2);
              sc0 = __builtin_amdgcn_mfma_f32_16x16x32_bf16(a, b0, sc0, 0, 0, 0);
              if (2 * sp + 1 <= ttw) { const pg8::bf16x8 b1 = *(const LAS pg8::bf16x8*)(L + PP_KI + (16 * (2 * sp + 1) + fr) * QD_PITCH + (32 * ks + 8 * fq) * 2);
                  sc1 = __builtin_amdgcn_mfma_f32_16x16x32_bf16(a, b1, sc1, 0, 0, 0); } } }
#pragma unroll
      for (int r = 0; r < 4; ++r) { const int tl = 4 * fq + r;
          float v0 = sc0[r], v1 = sc1[r];
          if (2 * sp > ttw || (2 * sp == ttw && fr > tl)) v0 = 0.f;
          if (2 * sp + 1 > ttw || (2 * sp + 1 == ttw && fr > tl)) v1 = 0.f;
          *(LAS unsigned short*)(L + PP_P + (16 * ttw + tl) * T_PITCH + (16 * (2 * sp) + fr) * 2) = (unsigned short)(pk2(v0, 0.f) & 0xffffu);
          *(LAS unsigned short*)(L + PP_P + (16 * ttw + tl) * T_PITCH + (16 * (2 * sp + 1) + fr) * 2) = (unsigned short)(pk2(v1, 0.f) & 0xffffu); } }
    __syncthreads();
    *((v4u*)(img + IMG_P) + tid) = *(const LAS v4u*)(L + PP_P + (tid >> 3) * T_PITCH + (tid & 7) * 16);
}
__device__ __forceinline__ void p2a_gla_prep(Frame& F) {
    for (int it = F.vcu; it < NB * NH * (SEQ / 64); it += F.G) gla_prep_item(F, it);
    __syncthreads();
}
constexpr int SC_QD = 0, SC_KET = 33792, SC_VT = 70656, SC_P = 79872, SC_DV = 89088, SC_OX = 90112, SC_END = 106496;
static_assert(SC_END <= MISC_OFF && PP_RS + 8192 <= MISC_OFF, "GLA LDS maps");
__device__ __forceinline__ void gla_prompt_item(Frame& F, int item) {
    const int j = item & 7, h = (item >> 3) & 3, b = item >> 5;
    const bf16* proj = (const bf16*)(F.ws + WS_PROJ); bf16* O = (bf16*)(F.ws + WS_O);
    const unsigned char* img0 = F.ws + WS_IMG + (size_t)((b * NH + h) * (SEQ / 64)) * IMG_BYTES;
    LAS unsigned char* L = F.lds;
    const int tid = F.tid, lane = F.lane, w = F.wave, fr = lane & 15, fq = lane >> 4, cp = tid & 63, rg = tid >> 6;
    const int kh = w >> 2, vt = w & 3;
    f32x4 S[8];
#pragma unroll
    for (int i = 0; i < 8; ++i) S[i] = (f32x4){0.f, 0.f, 0.f, 0.f};
    v4u qdA[4], keA[4], ppA, vrA, qdB[4], keB[4], ppB, vrB; f32x4 dvA = (f32x4){0.f, 0.f, 0.f, 0.f}, dvB = (f32x4){0.f, 0.f, 0.f, 0.f};
#define SC_LOAD(n_, QD_, KE_, PP_, DV_, VR_) do { const unsigned char* im_ = img0 + (size_t)(n_) * IMG_BYTES; \
        _Pragma("unroll") for (int i_ = 0; i_ < 4; ++i_) { QD_[i_] = *((const v4u*)(im_ + IMG_QD) + i_ * NTHR + tid); KE_[i_] = *((const v4u*)(im_ + IMG_KET) + i_ * NTHR + tid); } \
        PP_ = *((const v4u*)(im_ + IMG_P) + tid); if (rg == 0) DV_ = *((const f32x4*)(im_ + IMG_DV) + cp); \
        VR_ = *(const v4u*)(proj + ((size_t)b * SEQ + (size_t)(n_) * 64 + lane) * NPROJ + 2 * KD + h * HV + j * 64 + 8 * w); } while (0)
    SC_LOAD(0, qdA, keA, ppA, dvA, vrA);
    SC_LOAD(1, qdB, keB, ppB, dvB, vrB);
    __syncthreads();
    for (int n = 0; n < SEQ / 64; n += 2) {
#pragma unroll
        for (int s2 = 0; s2 < 4; ++s2) { *(LAS v2u*)(L + SC_QD + (8 * rg + 2 * s2) * QD_PITCH + 8 * cp) = (v2u){qdA[s2].x, qdA[s2].y}; *(LAS v2u*)(L + SC_QD + (8 * rg + 2 * s2 + 1) * QD_PITCH + 8 * cp) = (v2u){qdA[s2].z, qdA[s2].w}; }
#pragma unroll
        for (int c4 = 0; c4 < 4; ++c4) *(LAS v4u*)(L + SC_KET + (4 * cp + c4) * T_PITCH + 16 * rg) = keA[c4];
        *(LAS v4u*)(L + SC_P + (tid >> 3) * T_PITCH + (tid & 7) * 16) = ppA;
        if (rg == 0) *((LAS f32x4*)(L + SC_DV) + cp) = dvA;
        { LAS unsigned short* col = (LAS unsigned short*)(L + SC_VT + (8 * w) * T_PITCH + 2 * lane);
          col[0 * (T_PITCH / 2)] = (unsigned short)(vrA.x & 0xffffu); col[1 * (T_PITCH / 2)] = (unsigned short)(vrA.x >> 16); col[2 * (T_PITCH / 2)] = (unsigned short)(vrA.y & 0xffffu); col[3 * (T_PITCH / 2)] = (unsigned short)(vrA.y >> 16);
          col[4 * (T_PITCH / 2)] = (unsigned short)(vrA.z & 0xffffu); col[5 * (T_PITCH / 2)] = (unsigned short)(vrA.z >> 16); col[6 * (T_PITCH / 2)] = (unsigned short)(vrA.w & 0xffffu); col[7 * (T_PITCH / 2)] = (unsigned short)(vrA.w >> 16); }
        if ((n) + 2 < SEQ / 64) SC_LOAD((n) + 2, qdA, keA, ppA, dvA, vrA);
        __syncthreads();
        { f32x4 Oa[4];
#pragma unroll
        for (int tt = 0; tt < 4; ++tt) Oa[tt] = (f32x4){0.f, 0.f, 0.f, 0.f};
#pragma unroll
        for (int ks = 0; ks < 4; ++ks) {
            const pg8::bf16x8 Bv = as_bf16x8((v4u){pk2(S[2 * ks][0], S[2 * ks][1]), pk2(S[2 * ks][2], S[2 * ks][3]), pk2(S[2 * ks + 1][0], S[2 * ks + 1][1]), pk2(S[2 * ks + 1][2], S[2 * ks + 1][3])});
#pragma unroll
            for (int tt = 0; tt < 4; ++tt) { const v2u lo = *(const LAS v2u*)(L + SC_QD + (16 * tt + fr) * QD_PITCH + (128 * kh + 32 * ks + 4 * fq) * 2), hi = *(const LAS v2u*)(L + SC_QD + (16 * tt + fr) * QD_PITCH + (128 * kh + 32 * ks + 16 + 4 * fq) * 2);
                Oa[tt] = __builtin_amdgcn_mfma_f32_16x16x32_bf16(as_bf16x8((v4u){lo.x, lo.y, hi.x, hi.y}), Bv, Oa[tt], 0, 0, 0); } }
        if (kh == 1) {
#pragma unroll
            for (int tt = 0; tt < 4; ++tt)
#pragma unroll
                for (int r = 0; r < 4; ++r) *(LAS float*)(L + SC_OX + ((vt * 64 + 16 * tt + 4 * fq + r) * 16 + fr) * 4) = Oa[tt][r]; }
        __syncthreads();
        pg8::bf16x8 Vb[2];
#pragma unroll
        for (int k2 = 0; k2 < 2; ++k2) Vb[k2] = *(const LAS pg8::bf16x8*)(L + SC_VT + (16 * vt + fr) * T_PITCH + (32 * k2 + 8 * fq) * 2);
        if (kh == 0) {
#pragma unroll
            for (int tt = 0; tt < 4; ++tt) {
#pragma unroll
                for (int r = 0; r < 4; ++r) Oa[tt][r] += *(const LAS float*)(L + SC_OX + ((vt * 64 + 16 * tt + 4 * fq + r) * 16 + fr) * 4);
#pragma unroll
                for (int k2 = 0; k2 < 2; ++k2) { if (32 * k2 > 16 * tt + 15) continue;
                    const pg8::bf16x8 a = *(const LAS pg8::bf16x8*)(L + SC_P + (16 * tt + fr) * T_PITCH + (32 * k2 + 8 * fq) * 2);
                    Oa[tt] = __builtin_amdgcn_mfma_f32_16x16x32_bf16(a, Vb[k2], Oa[tt], 0, 0, 0); } }
            bf16* op = O + ((size_t)b * SEQ + (size_t)(n) * 64 + 4 * fq) * DM + h * HV + j * 64 + 16 * vt + fr;
#pragma unroll
            for (int tt = 0; tt < 4; ++tt)
#pragma unroll
                for (int r = 0; r < 4; ++r) op[(size_t)(16 * tt + r) * DM] = (bf16)(pk2(Oa[tt][r], 0.f) & 0xffffu); }
#pragma unroll
        for (int kt = 0; kt < 8; ++kt) { const f32x4 d4 = *(const LAS f32x4*)(L + SC_DV + (128 * kh + 16 * kt + 4 * fq) * 4); S[kt] = S[kt] * d4;
#pragma unroll
            for (int k2 = 0; k2 < 2; ++k2) { const pg8::bf16x8 a = *(const LAS pg8::bf16x8*)(L + SC_KET + (128 * kh + 16 * kt + fr) * T_PITCH + (32 * k2 + 8 * fq) * 2);
                S[kt] = __builtin_amdgcn_mfma_f32_16x16x32_bf16(a, Vb[k2], S[kt], 0, 0, 0); } }
        }
        __syncthreads();
#pragma unroll
        for (int s2 = 0; s2 < 4; ++s2) { *(LAS v2u*)(L + SC_QD + (8 * rg + 2 * s2) * QD_PITCH + 8 * cp) = (v2u){qdB[s2].x, qdB[s2].y}; *(LAS v2u*)(L + SC_QD + (8 * rg + 2 * s2 + 1) * QD_PITCH + 8 * cp) = (v2u){qdB[s2].z, qdB[s2].w}; }
#pragma unroll
        for (int c4 = 0; c4 < 4; ++c4) *(LAS v4u*)(L + SC_KET + (4 * cp + c4) * T_PITCH + 16 * rg) = keB[c4];
        *(LAS v4u*)(L + SC_P + (tid >> 3) * T_PITCH + (tid & 7) * 16) = ppB;
        if (rg == 0) *((LAS f32x4*)(L + SC_DV) + cp) = dvB;
        { LAS unsigned short* col = (LAS unsigned short*)(L + SC_VT + (8 * w) * T_PITCH + 2 * lane);
          col[0 * (T_PITCH / 2)] = (unsigned short)(vrB.x & 0xffffu); col[1 * (T_PITCH / 2)] = (unsigned short)(vrB.x >> 16); col[2 * (T_PITCH / 2)] = (unsigned short)(vrB.y & 0xffffu); col[3 * (T_PITCH / 2)] = (unsigned short)(vrB.y >> 16);
          col[4 * (T_PITCH / 2)] = (unsigned short)(vrB.z & 0xffffu); col[5 * (T_PITCH / 2)] = (unsigned short)(vrB.z >> 16); col[6 * (T_PITCH / 2)] = (unsigned short)(vrB.w & 0xffffu); col[7 * (T_PITCH / 2)] = (unsigned short)(vrB.w >> 16); }
        if ((n + 1) + 2 < SEQ / 64) SC_LOAD((n + 1) + 2, qdB, keB, ppB, dvB, vrB);
        __syncthreads();
        { f32x4 Oa[4];
#pragma unroll
        for (int tt = 0; tt < 4; ++tt) Oa[tt] = (f32x4){0.f, 0.f, 0.f, 0.f};
#pragma unroll
        for (int ks = 0; ks < 4; ++ks) {
            const pg8::bf16x8 Bv = as_bf16x8((v4u){pk2(S[2 * ks][0], S[2 * ks][1]), pk2(S[2 * ks][2], S[2 * ks][3]), pk2(S[2 * ks + 1][0], S[2 * ks + 1][1]), pk2(S[2 * ks + 1][2], S[2 * ks + 1][3])});
#pragma unroll
            for (int tt = 0; tt < 4; ++tt) { const v2u lo = *(const LAS v2u*)(L + SC_QD + (16 * tt + fr) * QD_PITCH + (128 * kh + 32 * ks + 4 * fq) * 2), hi = *(const LAS v2u*)(L + SC_QD + (16 * tt + fr) * QD_PITCH + (128 * kh + 32 * ks + 16 + 4 * fq) * 2);
                Oa[tt] = __builtin_amdgcn_mfma_f32_16x16x32_bf16(as_bf16x8((v4u){lo.x, lo.y, hi.x, hi.y}), Bv, Oa[tt], 0, 0, 0); } }
        if (kh == 1) {
#pragma unroll
            for (int tt = 0; tt < 4; ++tt)
#pragma unroll
                for (int r = 0; r < 4; ++r) *(LAS float*)(L + SC_OX + ((vt * 64 + 16 * tt + 4 * fq + r) * 16 + fr) * 4) = Oa[tt][r]; }
        __syncthreads();
        pg8::bf16x8 Vb[2];
#pragma unroll
        for (int k2 = 0; k2 < 2; ++k2) Vb[k2] = *(const LAS pg8::bf16x8*)(L + SC_VT + (16 * vt + fr) * T_PITCH + (32 * k2 + 8 * fq) * 2);
        if (kh == 0) {
#pragma unroll
            for (int tt = 0; tt < 4; ++tt) {
#pragma unroll
                for (int r = 0; r < 4; ++r) Oa[tt][r] += *(const LAS float*)(L + SC_OX + ((vt * 64 + 16 * tt + 4 * fq + r) * 16 + fr) * 4);
#pragma unroll
                for (int k2 = 0; k2 < 2; ++k2) { if (32 * k2 > 16 * tt + 15) continue;
                    const pg8::bf16x8 a = *(const LAS pg8::bf16x8*)(L + SC_P + (16 * tt + fr) * T_PITCH + (32 * k2 + 8 * fq) * 2);
                    Oa[tt] = __builtin_amdgcn_mfma_f32_16x16x32_bf16(a, Vb[k2], Oa[tt], 0, 0, 0); } }
            bf16* op = O + ((size_t)b * SEQ + (size_t)(n + 1) * 64 + 4 * fq) * DM + h * HV + j * 64 + 16 * vt + fr;
#pragma unroll
            for (int tt = 0; tt < 4; ++tt)
#pragma unroll
                for (int r = 0; r < 4; ++r) op[(size_t)(16 * tt + r) * DM] = (bf16)(pk2(Oa[tt][r], 0.f) & 0xffffu); }
#pragma unroll
        for (int kt = 0; kt < 8; ++kt) { const f32x4 d4 = *(const LAS f32x4*)(L + SC_DV + (128 * kh + 16 * kt + 4 * fq) * 4); S[kt] = S[kt] * d4;
#pragma unroll
            for (int k2 = 0; k2 < 2; ++k2) { const pg8::bf16x8 a = *(const LAS pg8::bf16x8*)(L + SC_KET + (128 * kh + 16 * kt + fr) * T_PITCH + (32 * k2 + 8 * fq) * 2);
                S[kt] = __builtin_amdgcn_mfma_f32_16x16x32_bf16(a, Vb[k2], S[kt], 0, 0, 0); } }
        }
        __syncthreads();
    }
#undef SC_LOAD
    { float* SP = F.out + OUT_SP + ((size_t)(b * NH + h) * HK + 128 * kh + 4 * fq) * HV + j * 64 + 16 * vt + fr;
#pragma unroll
      for (int kt = 0; kt < 8; ++kt)
#pragma unroll
          for (int r = 0; r < 4; ++r) SP[(size_t)(16 * kt + r) * HV] = S[kt][r]; }
}
__device__ __forceinline__ void gla_sample_item(Frame& F, int item) {
    const int h = item & 3, b = item >> 2;
    const bf16* proj = (const bf16*)(F.ws + WS_PROJ); const float* loga = (const float*)(F.ws + WS_LOGA); bf16* O = (bf16*)(F.ws + WS_O);
    LAS float* AT = (LAS float*)F.lds;
    LAS float* KT = AT + 256 * 8;
    LAS float* QT = KT + 256 * 8;
    LAS float* VV = QT + 256 * 8;
    LAS float* RED = VV + 8 * 512;
    const size_t r0 = (size_t)MP + (size_t)b * DT;
    const int c4 = F.tid & 127, kg = F.tid >> 7;
    const f32x4* S0 = (const f32x4*)(F.in[2] + (size_t)(b * NH + h) * HK * HV) + c4;
    f32x4* S1 = (f32x4*)(F.out + OUT_SS + (size_t)(b * NH + h) * HK * HV) + c4;
    f32x4 s[8];
#pragma unroll
    for (int u = 0; u < 8; ++u) s[u] = __builtin_nontemporal_load(S0 + (size_t)(kg * 64 + u) * 128);
    for (int idx = F.tid; idx < 8 * 256; idx += NTHR) { const int t = idx >> 8, k = idx & 255; const size_t row = r0 + t;
        AT[k * 8 + t] = __expf(loga[row * KD + h * HK + k]); KT[k * 8 + t] = bf2f(proj[row * NPROJ + KD + h * HK + k]); QT[k * 8 + t] = bf2f(proj[row * NPROJ + h * HK + k]) * 0.0625f; }
    for (int idx = F.tid; idx < 8 * 512; idx += NTHR) { const int t = idx >> 9, v = idx & 511; VV[idx] = bf2f(proj[(r0 + t) * NPROJ + 2 * KD + h * HV + v]); }
    __syncthreads();
    f32x4 vv[8], oa[8];
#pragma unroll
    for (int t = 0; t < 8; ++t) { vv[t] = *(const LAS f32x4*)(VV + t * 512 + 4 * c4); oa[t] = (f32x4){0.f, 0.f, 0.f, 0.f}; }
#define GLA_S_ROW(u_, k_, REFILL) do { const int k = (k_); \
            const f32x4 a0 = *(const LAS f32x4*)(AT + k * 8), a1 = *(const LAS f32x4*)(AT + k * 8 + 4), k0 = *(const LAS f32x4*)(KT + k * 8), k1 = *(const LAS f32x4*)(KT + k * 8 + 4), q0 = *(const LAS f32x4*)(QT + k * 8), q1 = *(const LAS f32x4*)(QT + k * 8 + 4); \
            f32x4 x = s[u_]; \
            x = x * a0.x + vv[0] * k0.x; oa[0] += x * q0.x; \
            x = x * a0.y + vv[1] * k0.y; oa[1] += x * q0.y; \
            x = x * a0.z + vv[2] * k0.z; oa[2] += x * q0.z; \
            x = x * a0.w + vv[3] * k0.w; oa[3] += x * q0.w; \
            x = x * a1.x + vv[4] * k1.x; oa[4] += x * q1.x; \
            x = x * a1.y + vv[5] * k1.y; oa[5] += x * q1.y; \
            x = x * a1.z + vv[6] * k1.z; oa[6] += x * q1.z; \
            x = x * a1.w + vv[7] * k1.w; oa[7] += x * q1.w; \
            __builtin_nontemporal_store(x, S1 + (size_t)k * 128); \
            if (REFILL) s[u_] = __builtin_nontemporal_load(S0 + (size_t)(k + 8) * 128); \
            asm volatile("" ::: "memory"); } while (0)
#pragma unroll 1
    for (int kb = 0; kb < 56; kb += 8) {
#pragma unroll
        for (int u = 0; u < 8; ++u) GLA_S_ROW(u, kg * 64 + kb + u, true);
    }
#pragma unroll
    for (int u = 0; u < 8; ++u) GLA_S_ROW(u, kg * 64 + 56 + u, false);
#undef GLA_S_ROW
#pragma unroll
    for (int t = 0; t < 8; ++t) *(LAS f32x4*)(RED + (kg * 8 + t) * 512 + 4 * c4) = oa[t];
    __syncthreads();
    for (int idx = F.tid; idx < 8 * 128; idx += NTHR) { const int t = idx >> 7, c = idx & 127;
        const f32x4 r = *(const LAS f32x4*)(RED + (0 * 8 + t) * 512 + 4 * c) + *(const LAS f32x4*)(RED + (1 * 8 + t) * 512 + 4 * c) + *(const LAS f32x4*)(RED + (2 * 8 + t) * 512 + 4 * c) + *(const LAS f32x4*)(RED + (3 * 8 + t) * 512 + 4 * c);
        v2u rb; rb.x = pk2(r.x, r.y); rb.y = pk2(r.z, r.w); *(v2u*)(O + (r0 + t) * DM + h * HV + 4 * c) = rb; }
    __syncthreads();
}
__device__ __forceinline__ void p2_gla(Frame& F, int qslot) {
    constexpr int NPI = NB * NH * 8, NSI = DB * NH;
    if ((int)blockIdx.x < NPI) { const int x = (int)blockIdx.x & 7, m = (int)blockIdx.x >> 3;
        gla_prompt_item(F, ((2 * x + (m & 1)) << 3) | (m >> 1));
        __syncthreads();
        pg9::Gemm g{(const bf16*)(F.ws + WS_XB), (const bf16*)(F.ws + WS_WIN) + (size_t)NQKV * PK2, M, NPROJ - NQKV, DM, PK2, PK2};
        pg9::ListOrder S{(int)blockIdx.x, NPI, (M / pg9::BMR) * ((NPROJ - NQKV) / pg9::BNC), M / pg9::BMR};
        pg9::EpiBf16<0> E{(bf16*)(F.ws + WS_PROJ) + NQKV, NPROJ, nullptr};
        pg9::gemm_phase<pg9::EpiBf16<0>, true, pg9::ListOrder>(F.lds, g, S, E);
        __syncthreads(); }
    for (;;) {
        __syncthreads();
        if (F.tid == 0) F.MISC[16] = __hip_atomic_fetch_add(F.ctl + CW_QUEUE + 64 * qslot, 1u, RLX_AGENT);
        __syncthreads();
        const int it = (int)F.MISC[16];
        if (it >= NSI + DT_NCHUNK) break;
        if (it < NSI) gla_sample_item(F, it); else deferred_transpose_chunk(F, it - NSI);
    }
    __syncthreads();
}

__device__ __forceinline__ void gate_rows(Frame& F, int row_lo, int nrows) {
    const bf16* O = (const bf16*)(F.ws + WS_O); const bf16* proj = (const bf16*)(F.ws + WS_PROJ); bf16* A2 = (bf16*)(F.ws + WS_A2); const float* ng = F.in[6];
    const int lane = F.lane; const bool b5 = lane & 32, b4 = lane & 16;
    f32x4 g4[8];
#pragma unroll
    for (int i = 0; i < 8; ++i) g4[i] = *((const f32x4*)ng + lane + 64 * i);
    const int r_lo = (F.wave * nrows) / NWAVES, r_hi = ((F.wave + 1) * nrows) / NWAVES;
    for (int rr = r_lo; rr < r_hi; rr += 2) {
        v2u ow[2][8], rw[2][8];
#pragma unroll
        for (int q = 0; q < 2; ++q) { const int m = row_lo + ((rr + q < r_hi) ? rr + q : r_hi - 1);
#pragma unroll
            for (int i = 0; i < 8; ++i) { ow[q][i] = *((const v2u*)(O + (size_t)m * DM) + lane + 64 * i); rw[q][i] = *((const v2u*)(proj + (size_t)m * NPROJ + 2 * KD + 2048) + lane + 64 * i); } }
#pragma unroll
        for (int q = 0; q < 2; ++q) { const int m = row_lo + ((rr + q < r_hi) ? rr + q : r_hi - 1);
            f32x4 v[8]; float hs[4];
#pragma unroll
            for (int i = 0; i < 8; ++i) v[i] = (f32x4){bf_lo(ow[q][i].x), bf_hi(ow[q][i].x), bf_lo(ow[q][i].y), bf_hi(ow[q][i].y)};
#pragma unroll
            for (int h = 0; h < 4; ++h) { const f32x4 a = v[2 * h], c = v[2 * h + 1]; hs[h] = (a.x * a.x + a.y * a.y) + (a.z * a.z + a.w * a.w) + (c.x * c.x + c.y * c.y) + (c.z * c.z + c.w * c.w); }
            float t2[2], t1;
#pragma unroll
            for (int i = 0; i < 2; ++i) { const float keep = b5 ? hs[i + 2] : hs[i], send = b5 ? hs[i] : hs[i + 2]; t2[i] = keep + __shfl_xor(send, 32); }
            { const float keep = b4 ? t2[1] : t2[0], send = b4 ? t2[0] : t2[1]; t1 = keep + __shfl_xor(send, 16); }
            t1 += __shfl_xor(t1, 8); t1 += __shfl_xor(t1, 4); t1 += __shfl_xor(t1, 2); t1 += __shfl_xor(t1, 1);
            float ss[4];
#pragma unroll
            for (int h = 0; h < 4; ++h) ss[h] = 1.0f / sqrtf(__int_as_float(__builtin_amdgcn_readlane(__float_as_int(t1), 16 * (h & 1) + 32 * (h >> 1))) * (1.0f / HV) + HN_EPS);
            v2u* o8 = (v2u*)(A2 + (size_t)m * PK2) + lane;
#pragma unroll
            for (int i = 0; i < 8; ++i) { const v2u rwv = rw[q][i];
                const float r0 = bf_lo(rwv.x), r1 = bf_hi(rwv.x), r2 = bf_lo(rwv.y), r3 = bf_hi(rwv.y); const float sc = ss[i >> 1];
                const float y0 = v[i].x * sc * g4[i].x * (r0 / (1.f + __expf(-r0))), y1 = v[i].y * sc * g4[i].y * (r1 / (1.f + __expf(-r1))), y2 = v[i].z * sc * g4[i].z * (r2 / (1.f + __expf(-r2))), y3 = v[i].w * sc * g4[i].w * (r3 / (1.f + __expf(-r3)));
                __hip_atomic_store((unsigned long long*)(o8 + 64 * i), ((unsigned long long)pk2(y2, y3) << 32) | pk2(y0, y1), RLX_AGENT); } }
    }
}
__device__ __forceinline__ void gate_panel_and_wait(Frame& F, int pm, int pn, unsigned* cnt) {
    gate_rows(F, pm * 288 + pn * 36, 36);
    asm volatile("s_waitcnt vmcnt(0)" ::: "memory");
    __syncthreads();
    if (F.tid == 0) {
        __hip_atomic_fetch_add(cnt + 64 * pm, 1u, RLX_AGENT);
        unsigned sp = 0u;
        while (__hip_atomic_load(cnt + 64 * pm, RLX_AGENT) < 8u) { __builtin_amdgcn_s_sleep(2); if (++sp > (1u << 22)) { __hip_atomic_store(F.ctl + CW_TMO, 1u, RLX_AGENT); break; } }
        __builtin_amdgcn_fence(__ATOMIC_ACQUIRE, "agent");
        asm volatile("s_waitcnt vmcnt(0)" ::: "memory");
    }
    __syncthreads();
}

__device__ __forceinline__ void ln_rows(Frame& F, const float* in, const float* gam, const float* bet, float* outf, bf16* outb) {
    const int gw = F.vcu * NWAVES + F.wave, NGW = F.G * NWAVES;
    for (int m = gw; m < M; m += NGW) {
        const f32x4* xr = (const f32x4*)(in + (size_t)m * DM) + F.lane;
        f32x4 v[8]; float s = 0.f;
#pragma unroll
        for (int i = 0; i < 8; ++i) { v[i] = xr[64 * i]; s += (v[i].x + v[i].y) + (v[i].z + v[i].w); }
        const float mean = wave_sum(s) * (1.f / DM); float s2 = 0.f;
#pragma unroll
        for (int i = 0; i < 8; ++i) { v[i] = v[i] - mean; s2 += (v[i].x * v[i].x + v[i].y * v[i].y) + (v[i].z * v[i].z + v[i].w * v[i].w); }
        const float rstd = 1.f / sqrtf(wave_sum(s2) * (1.f / DM) + LN_EPS);
#pragma unroll
        for (int i = 0; i < 8; ++i) { const f32x4 g4 = *((const f32x4*)gam + F.lane + 64 * i), b4 = *((const f32x4*)bet + F.lane + 64 * i); const f32x4 y = v[i] * rstd * g4 + b4;
            if (outf) *((f32x4*)(outf + (size_t)m * DM) + F.lane + 64 * i) = y;
            if (outb) { v2u w; w.x = pk2(y.x, y.y); w.y = pk2(y.z, y.w); *((v2u*)(outb + (size_t)m * DM) + F.lane + 64 * i) = w; } }
    }
}
__device__ __forceinline__ void p10_vln(Frame& F) {
    const int gw = F.vcu * NWAVES + F.wave, NGW = F.G * NWAVES;
    const bf16* Z = (const bf16*)(F.ws + WS_Z); bf16* VN = (bf16*)(F.ws + WS_VN); const float* gam = F.in[10]; const float* bet = F.in[11];
    for (int m = gw; m < M; m += NGW) {
        const v2u* zr = (const v2u*)(Z + (size_t)m * (2 * SGW) + SGW) + F.lane;
        f32x4 v[8]; float s = 0.f;
#pragma unroll
        for (int i = 0; i < 8; ++i) { const v2u w = zr[64 * i]; v[i] = (f32x4){bf_lo(w.x), bf_hi(w.x), bf_lo(w.y), bf_hi(w.y)}; s += (v[i].x + v[i].y) + (v[i].z + v[i].w); }
        const float mean = wave_sum(s) * (1.f / SGW); float s2 = 0.f;
#pragma unroll
        for (int i = 0; i < 8; ++i) { v[i] = v[i] - mean; s2 += (v[i].x * v[i].x + v[i].y * v[i].y) + (v[i].z * v[i].z + v[i].w * v[i].w); }
        const float rstd = 1.f / sqrtf(wave_sum(s2) * (1.f / SGW) + LN_EPS);
#pragma unroll
        for (int i = 0; i < 8; ++i) { const f32x4 g4 = *((const f32x4*)gam + F.lane + 64 * i), b4 = *((const f32x4*)bet + F.lane + 64 * i); const f32x4 y = v[i] * rstd * g4 + b4;
            if (m >= MP) *((f32x4*)(F.out + OUT_SGV + (size_t)(m - MP) * SGW) + F.lane + 64 * i) = y;
            v2u w; w.x = pk2(y.x, y.y); w.y = pk2(y.z, y.w); *((v2u*)(VN + (size_t)m * SGW) + F.lane + 64 * i) = w; }
    }
}

constexpr int MIX_PITCH = 272;
__device__ __forceinline__ void mix_prompt_item(Frame& F, int item, bool load_w) {
    const int g = item & 7, ci = item >> 3; const int R0 = ci * SGC;
    const bf16* Z = (const bf16*)(F.ws + WS_Z); const bf16* Wc = (const bf16*)(F.ws + WS_WC); bf16* A2 = (bf16*)(F.ws + WS_A2); const float* stat = (const float*)(F.ws + WS_STAT);
    LAS unsigned char* WL = F.lds;
    LAS unsigned char* VT = F.lds + 128 * MIX_PITCH;
    LAS float* RS = (LAS float*)(F.lds + 128 * MIX_PITCH + 256 * MIX_PITCH);
    const int s_lo = F.lane >> 3, ch_lo = F.lane & 7;
    float sm = 0.f, sq = 0.f; v4u wq[4];
    if (F.tid < SGC) { sm = stat[2 * (size_t)(R0 + F.tid)]; sq = stat[2 * (size_t)(R0 + F.tid) + 1]; }
    if (load_w) {
#pragma unroll
        for (int i = 0; i < 4; ++i) { const int idx = F.tid + NTHR * i, t = idx >> 4, ch = idx & 15; wq[i] = *(const v4u*)(Wc + ((size_t)(g * SGC + t)) * SGC + ch * 8); } }
    v4u vr[8];
#pragma unroll
    for (int i = 0; i < 8; ++i) { const int s = 8 * (F.wave + 8 * (i & 1)) + s_lo, ch = 8 * (i >> 1) + ch_lo;
        vr[i] = *(const v4u*)(Z + (size_t)(R0 + s) * (2 * SGW) + SGW + g * SGD + ch * 8); }
    __syncthreads();
    if (F.tid < SGC) { const float mean = sm * (1.f / SGW), var = fmaxf(sq * (1.f / SGW) - mean * mean, 0.f);
        RS[2 * F.tid] = mean; RS[2 * F.tid + 1] = 1.f / sqrtf(var + LN_EPS); }
    if (load_w) {
#pragma unroll
        for (int i = 0; i < 4; ++i) { const int idx = F.tid + NTHR * i, t = idx >> 4, ch = idx & 15; *(LAS v4u*)(WL + t * MIX_PITCH + ch * 16) = wq[i]; } }
    __syncthreads();
#pragma unroll
    for (int i = 0; i < 8; ++i) { const int sh = F.wave + 8 * (i & 1), s = 8 * sh + s_lo, ch = 8 * (i >> 1) + ch_lo; const v4u w = vr[i];
        const float mean = RS[2 * s], rstd = RS[2 * s + 1];
        const f32x4 ga = *(const f32x4*)(F.in[10] + g * SGD + ch * 8), gb = *(const f32x4*)(F.in[10] + g * SGD + ch * 8 + 4), ba = *(const f32x4*)(F.in[11] + g * SGD + ch * 8), bb = *(const f32x4*)(F.in[11] + g * SGD + ch * 8 + 4);
        LAS unsigned short* col = (LAS unsigned short*)(VT + (size_t)(8 * ch) * MIX_PITCH + 16 * (sh ^ ch_lo) + 2 * s_lo);
        col[0 * (MIX_PITCH / 2)] = (unsigned short)(pk2((bf_lo(w.x) - mean) * rstd * ga.x + ba.x, 0.f) & 0xffffu); col[1 * (MIX_PITCH / 2)] = (unsigned short)(pk2((bf_hi(w.x) - mean) * rstd * ga.y + ba.y, 0.f) & 0xffffu);
        col[2 * (MIX_PITCH / 2)] = (unsigned short)(pk2((bf_lo(w.y) - mean) * rstd * ga.z + ba.z, 0.f) & 0xffffu); col[3 * (MIX_PITCH / 2)] = (unsigned short)(pk2((bf_hi(w.y) - mean) * rstd * ga.w + ba.w, 0.f) & 0xffffu);
        col[4 * (MIX_PITCH / 2)] = (unsigned short)(pk2((bf_lo(w.z) - mean) * rstd * gb.x + bb.x, 0.f) & 0xffffu); col[5 * (MIX_PITCH / 2)] = (unsigned short)(pk2((bf_hi(w.z) - mean) * rstd * gb.y + bb.y, 0.f) & 0xffffu);
        col[6 * (MIX_PITCH / 2)] = (unsigned short)(pk2((bf_lo(w.w) - mean) * rstd * gb.z + bb.z, 0.f) & 0xffffu); col[7 * (MIX_PITCH / 2)] = (unsigned short)(pk2((bf_hi(w.w) - mean) * rstd * gb.w + bb.w, 0.f) & 0xffffu); }
    __syncthreads();
    const int dg = F.wave & 3, th = F.wave >> 2, fr = F.lane & 15, fq = F.lane >> 4;
    f32x4 acc[4][4];
#pragma unroll
    for (int a = 0; a < 4; ++a)
#pragma unroll
        for (int j = 0; j < 4; ++j) acc[a][j] = (f32x4){0.f, 0.f, 0.f, 0.f};
#pragma unroll
    for (int ks = 0; ks < 4; ++ks) {
        bf16x8 af[4];
#pragma unroll
        for (int j = 0; j < 4; ++j) { const int d = 64 * dg + 16 * (fr >> 2) + 4 * j + (fr & 3);
            af[j] = *(const LAS bf16x8*)(VT + (size_t)d * MIX_PITCH + 16 * ((4 * ks + fq) ^ ((d >> 3) & 7))); }
#pragma unroll
        for (int a = 0; a < 4; ++a) { const int tt = th + 2 * a; if (2 * ks > tt) continue;
            const bf16x8 bw = *(const LAS bf16x8*)(WL + (size_t)(16 * tt + fr) * MIX_PITCH + (32 * ks + 8 * fq) * 2);
#pragma unroll
            for (int j = 0; j < 4; ++j) acc[a][j] = __builtin_amdgcn_mfma_f32_16x16x32_bf16(af[j], bw, acc[a][j], 0, 0, 0); }
    }
    const float* bsp = F.in[13] + g * SGC;
#pragma unroll
    for (int a = 0; a < 4; ++a) { const int t = 16 * (th + 2 * a) + fr; const float bb = bsp[t]; const size_t row = (size_t)R0 + t; const int col = g * SGD + 64 * dg + 16 * fq;
        const v4u u0 = *(const v4u*)(Z + row * (2 * SGW) + col), u1 = *(const v4u*)(Z + row * (2 * SGW) + col + 8);
        const f32x4 m0 = acc[a][0] + bb, m1 = acc[a][1] + bb, m2 = acc[a][2] + bb, m3 = acc[a][3] + bb;
        v4u o0, o1;
        o0.x = pk2(bf_lo(u0.x) * m0.x, bf_hi(u0.x) * m0.y); o0.y = pk2(bf_lo(u0.y) * m0.z, bf_hi(u0.y) * m0.w);
        o0.z = pk2(bf_lo(u0.z) * m1.x, bf_hi(u0.z) * m1.y); o0.w = pk2(bf_lo(u0.w) * m1.z, bf_hi(u0.w) * m1.w);
        o1.x = pk2(bf_lo(u1.x) * m2.x, bf_hi(u1.x) * m2.y); o1.y = pk2(bf_lo(u1.y) * m2.z, bf_hi(u1.y) * m2.w);
        o1.z = pk2(bf_lo(u1.z) * m3.x, bf_hi(u1.z) * m3.y); o1.w = pk2(bf_lo(u1.w) * m3.z, bf_hi(u1.w) * m3.w);
        *(v4u*)(A2 + row * PK2 + col) = o0; *(v4u*)(A2 + row * PK2 + col + 8) = o1; }
}
#define MIX_LDS_BARRIER() do { asm volatile("s_waitcnt lgkmcnt(0)" ::: "memory"); __builtin_amdgcn_s_barrier(); asm volatile("" ::: "memory"); } while (0)
__device__ __forceinline__ void mix_load_v(Frame& F, const bf16* Z, int R0, int g, v4u (&vr)[8]) {
    const int s_lo = F.lane >> 3, ch_lo = F.lane & 7;
#pragma unroll
    for (int i = 0; i < 8; ++i) { const int s = 8 * (F.wave + 8 * (i & 1)) + s_lo, ch = 8 * (i >> 1) + ch_lo;
        vr[i] = *(const v4u*)(Z + (size_t)(R0 + s) * (2 * SGW) + SGW + g * SGD + ch * 8); }
}
__device__ __forceinline__ void mix_load_u(Frame& F, const bf16* Z, int R0, int g, v4u (&u)[4][2]) {
    const int dg = F.wave & 3, th = F.wave >> 2, fr = F.lane & 15, fq = F.lane >> 4;
#pragma unroll
    for (int a = 0; a < 4; ++a) { const size_t row = (size_t)R0 + 16 * (th + 2 * a) + fr; const int col = g * SGD + 64 * dg + 16 * fq;
        u[a][0] = *(const v4u*)(Z + row * (2 * SGW) + col); u[a][1] = *(const v4u*)(Z + row * (2 * SGW) + col + 8); }
}
__device__ __forceinline__ void mix_transpose(Frame& F, int g, const v4u (&vr)[8], LAS unsigned char* VT, LAS const float* RS) {
    const int s_lo = F.lane >> 3, ch_lo = F.lane & 7;
#pragma unroll
    for (int i = 0; i < 8; ++i) { const int sh = F.wave + 8 * (i & 1), s = 8 * sh + s_lo, ch = 8 * (i >> 1) + ch_lo; const v4u w = vr[i];
        const float mean = RS[2 * s], rstd = RS[2 * s + 1];
        const f32x4 ga = *(const f32x4*)(F.in[10] + g * SGD + ch * 8), gb = *(const f32x4*)(F.in[10] + g * SGD + ch * 8 + 4), ba = *(const f32x4*)(F.in[11] + g * SGD + ch * 8), bb = *(const f32x4*)(F.in[11] + g * SGD + ch * 8 + 4);
        LAS unsigned short* col = (LAS unsigned short*)(VT + (size_t)(8 * ch) * MIX_PITCH + 16 * (sh ^ ch_lo) + 2 * s_lo);
        col[0 * (MIX_PITCH / 2)] = (unsigned short)(pk2((bf_lo(w.x) - mean) * rstd * ga.x + ba.x, 0.f) & 0xffffu); col[1 * (MIX_PITCH / 2)] = (unsigned short)(pk2((bf_hi(w.x) - mean) * rstd * ga.y + ba.y, 0.f) & 0xffffu);
        col[2 * (MIX_PITCH / 2)] = (unsigned short)(pk2((bf_lo(w.y) - mean) * rstd * ga.z + ba.z, 0.f) & 0xffffu); col[3 * (MIX_PITCH / 2)] = (unsigned short)(pk2((bf_hi(w.y) - mean) * rstd * ga.w + ba.w, 0.f) & 0xffffu);
        col[4 * (MIX_PITCH / 2)] = (unsigned short)(pk2((bf_lo(w.z) - mean) * rstd * gb.x + bb.x, 0.f) & 0xffffu); col[5 * (MIX_PITCH / 2)] = (unsigned short)(pk2((bf_hi(w.z) - mean) * rstd * gb.y + bb.y, 0.f) & 0xffffu);
        col[6 * (MIX_PITCH / 2)] = (unsigned short)(pk2((bf_lo(w.w) - mean) * rstd * gb.z + bb.z, 0.f) & 0xffffu); col[7 * (MIX_PITCH / 2)] = (unsigned short)(pk2((bf_hi(w.w) - mean) * rstd * gb.w + bb.w, 0.f) & 0xffffu); }
}
__device__ __forceinline__ void mix_mma_epi(Frame& F, int R0, int g, const v4u (&u)[4][2], LAS const unsigned char* WL, LAS const unsigned char* VT) {
    bf16* A2 = (bf16*)(F.ws + WS_A2);
    const int dg = F.wave & 3, th = F.wave >> 2, fr = F.lane & 15, fq = F.lane >> 4;
    f32x4 acc[4][4];
#pragma unroll
    for (int a = 0; a < 4; ++a)
#pragma unroll
        for (int j = 0; j < 4; ++j) acc[a][j] = (f32x4){0.f, 0.f, 0.f, 0.f};
#pragma unroll
    for (int ks = 0; ks < 4; ++ks) {
        bf16x8 af[4];
#pragma unroll
        for (int j = 0; j < 4; ++j) { const int d = 64 * dg + 16 * (fr >> 2) + 4 * j + (fr & 3);
            af[j] = *(const LAS bf16x8*)(VT + (size_t)d * MIX_PITCH + 16 * ((4 * ks + fq) ^ ((d >> 3) & 7))); }
#pragma unroll
        for (int a = 0; a < 4; ++a) { const int tt = th + 2 * a; if (2 * ks > tt) continue;
            const bf16x8 bw = *(const LAS bf16x8*)(WL + (size_t)(16 * tt + fr) * MIX_PITCH + (32 * ks + 8 * fq) * 2);
#pragma unroll
            for (int j = 0; j < 4; ++j) acc[a][j] = __builtin_amdgcn_mfma_f32_16x16x32_bf16(af[j], bw, acc[a][j], 0, 0, 0); }
    }
    const float* bsp = F.in[13] + g * SGC;
#pragma unroll
    for (int a = 0; a < 4; ++a) { const int t = 16 * (th + 2 * a) + fr; const float bb = bsp[t]; const size_t row = (size_t)R0 + t; const int col = g * SGD + 64 * dg + 16 * fq;
        const v4u u0 = u[a][0], u1 = u[a][1];
        const f32x4 m0 = acc[a][0] + bb, m1 = acc[a][1] + bb, m2 = acc[a][2] + bb, m3 = acc[a][3] + bb;
        v4u o0, o1;
        o0.x = pk2(bf_lo(u0.x) * m0.x, bf_hi(u0.x) * m0.y); o0.y = pk2(bf_lo(u0.y) * m0.z, bf_hi(u0.y) * m0.w);
        o0.z = pk2(bf_lo(u0.z) * m1.x, bf_hi(u0.z) * m1.y); o0.w = pk2(bf_lo(u0.w) * m1.z, bf_hi(u0.w) * m1.w);
        o1.x = pk2(bf_lo(u1.x) * m2.x, bf_hi(u1.x) * m2.y); o1.y = pk2(bf_lo(u1.y) * m2.z, bf_hi(u1.y) * m2.w);
        o1.z = pk2(bf_lo(u1.z) * m3.x, bf_hi(u1.z) * m3.y); o1.w = pk2(bf_lo(u1.w) * m3.z, bf_hi(u1.w) * m3.w);
        *(v4u*)(A2 + row * PK2 + col) = o0; *(v4u*)(A2 + row * PK2 + col + 8) = o1; }
}
struct MixS { unsigned v[8], u[8]; float st, wv, bv; float2 gam, bet; };
__device__ __forceinline__ void mix_sample_load(Frame& F, int hi, MixS& S) {
    const int g = (hi >> 1) & 7, b = hi >> 4; const size_t r0 = (size_t)MP + (size_t)b * DT; const int col = g * SGD + 128 * (hi & 1) + 2 * F.lane;
    const bf16* Z = (const bf16*)(F.ws + WS_Z); const float* stat = (const float*)(F.ws + WS_STAT);
#pragma unroll
    for (int s = 0; s < 8; ++s) { S.v[s] = *(const unsigned*)(Z + (r0 + s) * (2 * SGW) + SGW + col); S.u[s] = *(const unsigned*)(Z + (r0 + s) * (2 * SGW) + col); }
    S.st = stat[2 * r0 + (F.lane & 15)];
    S.wv = F.in[12][(size_t)g * SGC * SGC + (F.lane >> 3) * SGC + (F.lane & 7)];
    S.bv = F.in[13][g * SGC + (F.lane & 7)];
    S.gam = *(const float2*)(F.in[10] + col); S.bet = *(const float2*)(F.in[11] + col);
}
#define MIX_RDL(x, l) __int_as_float(__builtin_amdgcn_readlane(__float_as_int(x), (l)))
__device__ __forceinline__ void mix_sample_compute(Frame& F, int hi, const MixS& S) {
    const int g = (hi >> 1) & 7, b = hi >> 4; const size_t r0 = (size_t)MP + (size_t)b * DT; const int col = g * SGD + 128 * (hi & 1) + 2 * F.lane;
    bf16* A2 = (bf16*)(F.ws + WS_A2);
    const float wr = bf2f((bf16)(pk2(S.wv, 0.f) & 0xffffu));
    float v0[8], v1[8];
#pragma unroll
    for (int s = 0; s < 8; ++s) { const float sm = MIX_RDL(S.st, 2 * s), sq = MIX_RDL(S.st, 2 * s + 1);
        const float mean = sm * (1.f / SGW), rstd = 1.f / sqrtf(fmaxf(sq * (1.f / SGW) - mean * mean, 0.f) + LN_EPS);
        const float y0 = (bf_lo(S.v[s]) - mean) * rstd * S.gam.x + S.bet.x, y1 = (bf_hi(S.v[s]) - mean) * rstd * S.gam.y + S.bet.y;
        *(float2*)(F.out + OUT_SGV + (size_t)(b * DT + s) * SGW + col) = make_float2(y0, y1);
        const unsigned rb = pk2(y0, y1); v0[s] = bf_lo(rb); v1[s] = bf_hi(rb); }
#pragma unroll
    for (int t = 0; t < 8; ++t) { float m0 = 0.f, m1 = 0.f;
#pragma unroll
        for (int s = 0; s < 8; ++s) if (s <= t) { const float w = MIX_RDL(wr, 8 * t + s); m0 += v0[s] * w; m1 += v1[s] * w; }
        const float bb = MIX_RDL(S.bv, t); m0 += bb; m1 += bb;
        *(unsigned*)(A2 + (r0 + t) * PK2 + col) = pk2(bf_lo(S.u[t]) * m0, bf_hi(S.u[t]) * m1); }
}
__device__ __forceinline__ void mix_prompt_pair(Frame& F, int itA, int itB) {
    const int g = itA & 7; const int R0A = (itA >> 3) * SGC, R0B = (itB >> 3) * SGC;
    const bf16* Z = (const bf16*)(F.ws + WS_Z); const bf16* Wc = (const bf16*)(F.ws + WS_WC); const float* stat = (const float*)(F.ws + WS_STAT);
    LAS unsigned char* WL = F.lds; LAS unsigned char* VT = F.lds + 128 * MIX_PITCH;
    LAS float* RS = (LAS float*)(F.lds + 128 * MIX_PITCH + 256 * MIX_PITCH);
    const int hi = F.vcu * NWAVES + F.wave;
    float sm = 0.f, sq = 0.f; v4u wq[4]; MixS S;
    mix_sample_load(F, hi, S);
    if (F.tid < 2 * SGC) { const size_t r = (F.tid < SGC) ? (size_t)(R0A + F.tid) : (size_t)(R0B + F.tid - SGC); sm = stat[2 * r]; sq = stat[2 * r + 1]; }
#pragma unroll
    for (int i = 0; i < 4; ++i) { const int idx = F.tid + NTHR * i, t = idx >> 4, ch = idx & 15; wq[i] = *(const v4u*)(Wc + ((size_t)(g * SGC + t)) * SGC + ch * 8); }
    v4u vA[8], vB[8], uA[4][2], uB[4][2];
    mix_load_v(F, Z, R0A, g, vA); mix_load_u(F, Z, R0A, g, uA); mix_load_v(F, Z, R0B, g, vB);
    mix_sample_compute(F, hi, S);
    MIX_LDS_BARRIER();
    if (F.tid < 2 * SGC) { const float mean = sm * (1.f / SGW), var = fmaxf(sq * (1.f / SGW) - mean * mean, 0.f);
        RS[2 * F.tid] = mean; RS[2 * F.tid + 1] = 1.f / sqrtf(var + LN_EPS); }
#pragma unroll
    for (int i = 0; i < 4; ++i) { const int idx = F.tid + NTHR * i, t = idx >> 4, ch = idx & 15; *(LAS v4u*)(WL + t * MIX_PITCH + ch * 16) = wq[i]; }
    MIX_LDS_BARRIER();
    mix_transpose(F, g, vA, VT, RS);
    mix_load_u(F, Z, R0B, g, uB);
    MIX_LDS_BARRIER();
    mix_mma_epi(F, R0A, g, uA, WL, VT);
    MIX_LDS_BARRIER();
    mix_transpose(F, g, vB, VT, RS + 2 * SGC);
    MIX_LDS_BARRIER();
    mix_mma_epi(F, R0B, g, uB, WL, VT);
}
__device__ __forceinline__ void p11_mix(Frame& F) {
    constexpr int NPI = (MP / SGC) * SGG, NSH = 2 * DB * SGG;
    if (2 * F.G == NPI && F.G * NWAVES == NSH) mix_prompt_pair(F, F.vcu, F.vcu + F.G);
    else {
        for (int it = F.vcu; it < NPI; it += F.G) mix_prompt_item(F, it, it == F.vcu || (F.G & 7) != 0);
        const int gw = F.vcu * NWAVES + F.wave, NGW = F.G * NWAVES;
        for (int hi = gw; hi < NSH; hi += NGW) { MixS S; mix_sample_load(F, hi, S); mix_sample_compute(F, hi, S); }
    }
    __syncthreads();
}

struct Args { const float* in[21]; float* out; unsigned char* ws; int ph_lo, ph_hi, coop, pad; };
__global__ void __launch_bounds__(NTHR, 2) fwd_kernel(Args args) {
    extern __shared__ __attribute__((aligned(16))) unsigned char lds[];
    Frame F;
    F.lds = (LAS unsigned char*)lds;
    F.MISC = (volatile LAS unsigned*)(F.lds + MISC_OFF);
    F.tid = threadIdx.x; F.lane = F.tid & 63; F.wave = __builtin_amdgcn_readfirstlane(F.tid >> 6);
    F.G = gridDim.x; { const int bx = blockIdx.x; F.vcu = (F.G % 8 == 0) ? (bx % 8) * (F.G / 8) + bx / 8 : bx; }
#pragma unroll
    for (int i = 0; i < 21; ++i) F.in[i] = args.in[i];
    F.out = args.out; F.ws = args.ws; F.ctl = (unsigned*)(args.ws + WS_CTL);
    if (F.tid < 64) F.MISC[F.tid] = 0u;
    __syncthreads();
    XcdBarrier bar; bar.bar = F.ctl + CW_BAR; bar.x = 0; bar.st = nullptr;
    if (args.coop) bar = xcd_barrier_post(F.ctl + CW_BAR, F.MISC + 8);
    unsigned char* ws = F.ws;
    bf16* XB = (bf16*)(ws + WS_XB); bf16* A2 = (bf16*)(ws + WS_A2); bf16* HB = (bf16*)(ws + WS_HB);
    LAS unsigned char* ring = F.lds;

    const int lo = args.ph_lo, hi = args.ph_hi;
#define IN(k) (lo <= (k) && (k) < hi)
#define AGAIN(k) (IN(k) && (((PROBE_MASK) >> (k)) & 1))
#define SEAM(k) do { if (IN(k) && IN((k) + 1)) xcd_barrier(bar); } while (0)
#define GEMM_LN_B(INST, Amat, Bmat, Kdim, GAM, BET, OUTF, OUTB) { pg9::Gemm g{Amat, Bmat, M, DM, Kdim, (Kdim) + 64, (Kdim) + 64}; pg9::Order S; S.init(M, DM, F.G, (int)blockIdx.x); \
        pg9::PanelStats st{(unsigned*)(ws + WS_XCH), F.ctl + CW_LN + (INST) * LN_BANK, F.ctl + CW_TMO, LN_EPS}; pg9::EpiLn E{XB, PK2, ALPHA, GAM, BET, OUTF, OUTB, PK2, st}; \
        pg9::gemm_phase<pg9::EpiLn, false>(ring, g, S, E); }
#define GEMM_LN(k, INST, Amat, Bmat, Kdim, GAM, BET, OUTF, OUTB) if (IN(k)) GEMM_LN_B(INST, Amat, Bmat, Kdim, GAM, BET, OUTF, OUTB) SEAM(k)
#define GEMM_UP_B(l) { pg9::Gemm g{XB, (const bf16*)(ws + WS_W1) + (size_t)(l) * DFF * PK2, M, DFF, DM, PK2, PK2}; pg9::Order S; S.init(M, DFF, F.G, (int)blockIdx.x); pg9::EpiBf16<2> E{HB, PK8, nullptr}; \
        pg9::gemm_phase<pg9::EpiBf16<2>>(ring, g, S, E); }
#define GEMM_UP(k, l) if (IN(k)) GEMM_UP_B(l) if (AGAIN(k)) GEMM_UP_B(l) SEAM(k)
#define GEMM_IN_B { pg9::Gemm g{XB, (const bf16*)(ws + WS_WIN), M, NQKV, DM, PK2, PK2}; pg9::Order S; S.init(M, NQKV, F.G, (int)blockIdx.x); pg9::EpiBf16<0> E{(bf16*)(ws + WS_PROJ), NPROJ, nullptr}; \
        pg9::gemm_phase<pg9::EpiBf16<0>>(ring, g, S, E); }
#define GEMM_SG_B { pg9::Gemm g{XB, (const bf16*)(ws + WS_SGIN), M, 2 * SGW, DM, PK2, PK2}; pg9::Order S; S.init(M, 2 * SGW, F.G, (int)blockIdx.x); pg9::EpiSg E{(bf16*)(ws + WS_Z), 2 * SGW, F.in[9], (float*)(ws + WS_STAT)}; \
        pg9::gemm_phase<pg9::EpiSg>(ring, g, S, E); }
    if (IN(0)) p0_prologue(F); if (AGAIN(0)) p0_prologue(F);
    SEAM(0);
    if (IN(1)) GEMM_IN_B if (AGAIN(1)) GEMM_IN_B
    SEAM(1);
    if (IN(2)) p2a_gla_prep(F);
    SEAM(2);
    if (IN(3)) p2_gla(F, 0); if (AGAIN(3)) p2_gla(F, 1);
    SEAM(3);
    if (IN(4) && F.G == 256) {
        const int c = (int)blockIdx.x, wgid = (c & 7) * 32 + (c >> 3), pm0 = (wgid >> 6) * 8 + (wgid & 7), pn0 = (wgid & 63) >> 3;
        gate_panel_and_wait(F, pm0, pn0, F.ctl + CW_GATE); }
    GEMM_LN(4, 0, A2, (const bf16*)(ws + WS_WOUT), DM, F.in[17], F.in[18], (float*)nullptr, XB);
    GEMM_UP(5, 0);
    GEMM_LN(6, 1, HB, (const bf16*)(ws + WS_W2), DFF, F.in[19], F.in[20], (float*)nullptr, XB);
    if (IN(7)) GEMM_SG_B
    SEAM(7);
    if (IN(8)) p11_mix(F); if (AGAIN(8)) p11_mix(F);
    SEAM(8);
    GEMM_LN(9, 2, A2, (const bf16*)(ws + WS_SGOUT), SGW, F.in[17] + DM, F.in[18] + DM, (float*)nullptr, XB);
    GEMM_UP(10, 1);
    GEMM_LN(11, 3, HB, (const bf16*)(ws + WS_W2) + (size_t)DM * PK8, DFF, F.in[19] + DM, F.in[20] + DM, F.out + OUT_Y, (bf16*)nullptr);
#undef IN
#undef AGAIN
#undef SEAM
}

extern "C" void kernel_launch(void* const* d_in, const int* in_sizes, int n_in, void* d_out, int out_size, void* d_ws, size_t ws_size, hipStream_t stream) {
    static int grid = 0;
    if (grid == 0) {
        if (n_in != 21 || (size_t)out_size != OUT_END || ws_size < WS_END) { fprintf(stderr, "kernel_launch: unexpected shapes: n_in %d out %d ws %zu (need %zu)\n", n_in, out_size, ws_size, (size_t)WS_END); grid = -1; return; }
        int dev = 0, cus = 0, per_cu = 0;
        if (hipGetDevice(&dev) != hipSuccess || hipDeviceGetAttribute(&cus, hipDeviceAttributeMultiprocessorCount, dev) != hipSuccess) { fprintf(stderr, "kernel_launch: device query failed\n"); grid = -1; return; }
        if (hipFuncSetAttribute((const void*)fwd_kernel, hipFuncAttributeMaxDynamicSharedMemorySize, LDS_BYTES) != hipSuccess) { fprintf(stderr, "kernel_launch: hipFuncSetAttribute failed\n"); grid = -1; return; }
        if (hipOccupancyMaxActiveBlocksPerMultiprocessor(&per_cu, (const void*)fwd_kernel, NTHR, LDS_BYTES) != hipSuccess || per_cu < 1) { fprintf(stderr, "kernel_launch: occupancy query says %d blocks per CU\n", per_cu); per_cu = 1; }
        (void)hipGetLastError();
        grid = cus * 1;
    }
    if (grid < 0) return;
    if (hipMemsetAsync((char*)d_ws + WS_CTL, 0, CTL_ZERO_BYTES, stream) != hipSuccess) { fprintf(stderr, "kernel_launch: memset failed\n"); return; }
    Args a{};
    for (int i = 0; i < 21; ++i) a.in[i] = (const float*)d_in[i];
    a.out = (float*)d_out; a.ws = (unsigned char*)d_ws;
    if (N_LAUNCHES == 1) {
        a.ph_lo = 0; a.ph_hi = NPHASE; a.coop = 1;
        void* kargs[] = {&a};
        hipError_t e = hipLaunchCooperativeKernel((const void*)fwd_kernel, dim3(grid), dim3(NTHR), kargs, LDS_BYTES, stream);
        if (e != hipSuccess) fprintf(stderr, "kernel_launch: cooperative launch failed: %s (grid %d)\n", hipGetErrorString(e), grid);
    } else {
        for (int ph = 0; ph < NPHASE; ++ph) {
            a.ph_lo = ph; a.ph_hi = ph + 1; a.coop = 0;
            hipLaunchKernelGGL(fwd_kernel, dim3(grid), dim3(NTHR), LDS_BYTES, stream, a);
            const hipError_t le = hipPeekAtLastError();
            if (le != hipSuccess) { fprintf(stderr, "kernel_launch: launch %d failed: %s\n", ph, hipGetErrorName(le)); break; }
        }
    }
}
```

```cpp
#include <hip/hip_runtime.h>
#include <hip/hip_cooperative_groups.h>
#include <cstdio>
#include <cstdint>
namespace cg = cooperative_groups;

#ifndef PROBE_MASK
#define PROBE_MASK 0
#endif
#ifndef MK_N_LAUNCHES
#define MK_N_LAUNCHES 1
#endif

namespace pg8 {
#define PG8_LAS __attribute__((address_space(3)))
typedef unsigned short bf16_t;
typedef short bf16x8 __attribute__((ext_vector_type(8)));
typedef float f32x4 __attribute__((ext_vector_type(4)));
typedef float f32x2 __attribute__((ext_vector_type(2)));
typedef unsigned u32x4 __attribute__((ext_vector_type(4)));
constexpr int BM = 256, BK = 64, HALF = 128, HTB = HALF * BK * 2, STAGE_BYTES = 8 * HTB, NXCD = 8, WGM = 8;

__host__ __device__ __forceinline__ int lds_byte(int r, int c) { const int st = (r >> 4) * 2 + (c >> 5), rr = r & 15, cc = c & 31, ob = rr * 64 + cc * 2; return st * 1024 + (ob ^ (((ob >> 9) & 1) << 5)); }
__host__ __device__ __forceinline__ void stage_rc(int b, int& R, int& C) { const int st = b / 1024, sb = b % 1024, swz = sb ^ (((sb >> 9) & 1) << 5); R = (st >> 1) * 16 + swz / 64; C = (st & 1) * 32 + (swz % 64) / 2; }
__host__ __device__ __forceinline__ int perm32(int rho) { const int n = rho >> 4, i = rho & 15; return 8 * (i >> 2) + 4 * n + (i & 3); }

struct Unit { int pm, pn; };
struct Gemm { const bf16_t* A; const bf16_t* Bt; int M, N, K; };

struct StaticOrder {
    int nM, nN, nwg, G, c;
    __host__ __device__ void init(int M, int N, int G_, int c_) { nM = M / BM; nN = N / BM; nwg = nM * nN; G = G_; c = c_; }
    __host__ __device__ bool next(int i, Unit& u) const {
        const long L = (long)i * G + c; if (L >= nwg) return false;
        int wgid = (int)L; { const int q = nwg / NXCD, r = nwg % NXCD, xcd = wgid % NXCD, off = wgid / NXCD; wgid = (xcd < r ? xcd * (q + 1) : r * (q + 1) + (xcd - r) * q) + off; }
        const int nig = WGM * nN, gid = wgid / nig, fm = gid * WGM, gsz = (nM - fm) < WGM ? (nM - fm) : WGM;
        u.pm = fm + ((wgid % nig) % gsz); u.pn = (wgid % nig) / gsz; return true;
    }
    __device__ __forceinline__ void a_ready(const Unit&) const {}
    __device__ __forceinline__ void done(const Unit&) const {}
};

__device__ __forceinline__ unsigned cvt_pk_bf16(float lo, float hi) { unsigned r; asm volatile("v_cvt_pk_bf16_f32 %0, %1, %2" : "=v"(r) : "v"(lo), "v"(hi)); return r; }
__device__ __forceinline__ f32x2 gelu_pk(f32x2 v) {
    const f32x2 av = __builtin_elementwise_abs(v), d = av * 0.2316418882f + 1.0f;
    f32x2 t; t.x = __builtin_amdgcn_rcpf(d.x); t.y = __builtin_amdgcn_rcpf(d.y);
    f32x2 q = t * 0.5307027145f + (-0.7265760135f); q = q * t + 0.7107068705f; q = q * t + (-0.142248368f); q = q * t + 0.127414796f; q = q * t;
    const f32x2 s = (v * v) * (-0.72134752044f);
    f32x2 e; e.x = __builtin_amdgcn_exp2f(s.x); e.y = __builtin_amdgcn_exp2f(s.y);
    const f32x2 m = v * (q * e), r = v - m;
    f32x2 o; o.x = v.x < 0.f ? m.x : r.x; o.y = v.y < 0.f ? m.y : r.y; return o;
}

template <int ACT  > struct EpiBf16 {
    static constexpr bool PERM = true, AFTER_DRAIN = false;
    bf16_t* O; int ldc; const float* bias;
    __device__ __forceinline__ void operator()(const f32x4 (&acc)[2][2][4][2], const Unit& u, int wr, int wc, int fr, int fq) const {
        const int row0 = u.pm * BM + wr * 64 + fr; const int col0 = u.pn * BM + wc * 32 + 8 * fq;
        f32x4 bv[2][2];
#pragma unroll
        for (int bj = 0; bj < 2; ++bj)
#pragma unroll
            for (int n = 0; n < 2; ++n) bv[bj][n] = (ACT == 1) ? *(const f32x4*)(bias + col0 + bj * HALF + 4 * n) : (f32x4){0.f, 0.f, 0.f, 0.f};
#pragma unroll
        for (int ai = 0; ai < 2; ++ai)
#pragma unroll
            for (int m = 0; m < 4; ++m) { bf16_t* rowp = O + (size_t)(row0 + ai * HALF + m * 16) * ldc + col0;
#pragma unroll
                for (int bj = 0; bj < 2; ++bj) { f32x4 v0 = acc[ai][bj][m][0] + bv[bj][0], v1 = acc[ai][bj][m][1] + bv[bj][1];
                    if (ACT == 1) { f32x2 a = gelu_pk((f32x2){v0[0], v0[1]}), b = gelu_pk((f32x2){v0[2], v0[3]}), c = gelu_pk((f32x2){v1[0], v1[1]}), d = gelu_pk((f32x2){v1[2], v1[3]});
                        v0 = (f32x4){a.x, a.y, b.x, b.y}; v1 = (f32x4){c.x, c.y, d.x, d.y}; }
                    if (ACT == 2) {
#pragma unroll
                        for (int j = 0; j < 4; ++j) { const float p = fmaxf(v0[j], 0.f), q = fmaxf(v1[j], 0.f); v0[j] = p * p; v1[j] = q * q; } }
                    u32x4 w; w.x = cvt_pk_bf16(v0[0], v0[1]); w.y = cvt_pk_bf16(v0[2], v0[3]); w.z = cvt_pk_bf16(v1[0], v1[1]); w.w = cvt_pk_bf16(v1[2], v1[3]);
                    *(u32x4*)(rowp + bj * HALF) = w; } }
    }
};
struct EpiRes {
    static constexpr bool PERM = false, AFTER_DRAIN = false;
    float* out; int ldc; const float* resA; const float* resB; int split; float alpha;
    __device__ __forceinline__ void operator()(const f32x4 (&acc)[2][2][4][2], const Unit& u, int wr, int wc, int fr, int fq) const {
        const int row0 = u.pm * BM + wr * 64 + fr, col0 = u.pn * BM + wc * 32 + 4 * fq;
#pragma unroll
        for (int ai = 0; ai < 2; ++ai)
#pragma unroll
            for (int m = 0; m < 4; ++m) { const int row = row0 + ai * HALF + m * 16;
                const float* rp = (row < split ? resA + (size_t)row * ldc : resB + (size_t)(row - split) * ldc) + col0; float* op = out + (size_t)row * ldc + col0;
#pragma unroll
                for (int bj = 0; bj < 2; ++bj)
#pragma unroll
                    for (int n = 0; n < 2; ++n) { const f32x4 rv = *(const f32x4*)(rp + bj * HALF + n * 16); *(f32x4*)(op + bj * HALF + n * 16) = acc[ai][bj][m][n] + rv * alpha; } }
    }
};

template <class Epi, class Sched, bool ALIGN_EPI = false, bool SP2 = false>
__device__ __forceinline__ void gemm_phase(PG8_LAS unsigned char* lds, const Gemm g, const Sched& S, const Epi& E) {
    const int tid = threadIdx.x, wid = __builtin_amdgcn_readfirstlane(tid >> 6), lane = tid & 63, wr = wid >> 2, wc = wid & 3, fr = lane & 15, fq = lane >> 4;
    const int K = g.K, nt = K / BK;
    unsigned voffA[2], voffB[2];
#pragma unroll
    for (int i = 0; i < 2; ++i) { int R, C; stage_rc(tid * 16 + i * 8192, R, C); const int Rb = Epi::PERM ? ((R & ~31) + perm32(R & 31)) : R;
        voffA[i] = (unsigned)(R * K + C) * 2u; voffB[i] = (unsigned)(Rb * K + C) * 2u; }
    const size_t kstep = (size_t)(BK * 2);
    const size_t hstep = (size_t)HALF * K * 2;
    const size_t tstep = 2 * hstep;
    const unsigned ldsw = (unsigned)wid * 1024u;
    const int aoff = lds_byte(wr * 64 + fr, fq * 8), boff = lds_byte(wc * 32 + fr, fq * 8);
#define PG8_SA(b, h) (((b) * 2 + (h)) * HTB)
#define PG8_SB(b, h) ((4 + (b) * 2 + (h)) * HTB)
#define PG8_STAGE(bufoff, gbase, voff) do { _Pragma("unroll") for (int _i = 0; _i < 2; ++_i) \
        __builtin_amdgcn_global_load_lds((const unsigned*)((const char*)(gbase) + (voff)[_i]), (PG8_LAS unsigned*)(lds + (bufoff) + ldsw + _i * 8192), 16, 0, 0); } while (0)
#define PG8_LDA(dst, b, h) do { _Pragma("unroll") for (int m = 0; m < 4; ++m) _Pragma("unroll") for (int k = 0; k < 2; ++k) dst[m][k] = *(const PG8_LAS bf16x8*)(lds + PG8_SA(b, h) + aoff + m * 2048 + k * 1024); } while (0)
#define PG8_LDB(dst, b, h) do { _Pragma("unroll") for (int n = 0; n < 2; ++n) _Pragma("unroll") for (int k = 0; k < 2; ++k) dst[n][k] = *(const PG8_LAS bf16x8*)(lds + PG8_SB(b, h) + boff + n * 2048 + k * 1024); } while (0)
#define PG8_MMA(ai, bj, At, Bt) do { __builtin_amdgcn_s_setprio(1); _Pragma("unroll") for (int m = 0; m < 4; ++m) _Pragma("unroll") for (int n = 0; n < 2; ++n) _Pragma("unroll") for (int k = 0; k < 2; ++k) \
        acc[ai][bj][m][n] = __builtin_amdgcn_mfma_f32_16x16x32_bf16(Bt[n][k], At[m][k], acc[ai][bj][m][n], 0, 0, 0); __builtin_amdgcn_s_setprio(0); } while (0)
#define PG8_WAIT_V(n) asm volatile("s_waitcnt vmcnt(" #n ")" ::: "memory")
#define PG8_WAIT_L(n) asm volatile("s_waitcnt lgkmcnt(" #n ")" ::: "memory")
#define PG8_BAR __builtin_amdgcn_s_barrier()
#define PG8_SCHED __builtin_amdgcn_sched_barrier(0)
    Unit cur, nxt; int ui = 0;
    if (!S.next(0, cur)) return;
    f32x4 acc[2][2][4][2];
#pragma unroll
    for (int a = 0; a < 2; ++a)
#pragma unroll
        for (int b = 0; b < 2; ++b)
#pragma unroll
            for (int m = 0; m < 4; ++m)
#pragma unroll
                for (int n = 0; n < 2; ++n) acc[a][b][m][n] = (f32x4){0.f, 0.f, 0.f, 0.f};
    bf16x8 At[4][2], B0[2][2], B1[2][2];
    const char* cA = (const char*)g.A + (size_t)cur.pm * tstep; const char* cB = (const char*)g.Bt + (size_t)cur.pn * tstep;
    S.a_ready(cur);
    if constexpr (SP2) {
        PG8_STAGE(PG8_SB(0, 0), cB, voffB); PG8_STAGE(PG8_SB(0, 1), cB + hstep, voffB); PG8_STAGE(PG8_SA(0, 0), cA, voffA); PG8_STAGE(PG8_SA(0, 1), cA + hstep, voffA);
        if (wr == 1) PG8_BAR;
        PG8_WAIT_V(2); PG8_BAR;
        PG8_STAGE(PG8_SB(1, 0), cB + kstep, voffB); PG8_STAGE(PG8_SA(1, 0), cA + kstep, voffA); PG8_STAGE(PG8_SB(1, 1), cB + hstep + kstep, voffB);
        PG8_WAIT_V(6); PG8_BAR;
    } else {
        PG8_STAGE(PG8_SB(0, 0), cB, voffB); PG8_STAGE(PG8_SA(0, 0), cA, voffA); PG8_STAGE(PG8_SB(0, 1), cB + hstep, voffB); PG8_STAGE(PG8_SA(0, 1), cA + hstep, voffA);
        if (wr == 1) PG8_BAR;
        PG8_WAIT_V(4); PG8_BAR;
        PG8_STAGE(PG8_SB(1, 0), cB + kstep, voffB); PG8_STAGE(PG8_SA(1, 0), cA + kstep, voffA); PG8_STAGE(PG8_SB(1, 1), cB + hstep + kstep, voffB);
        PG8_WAIT_V(6); PG8_BAR;
    }
    for (;;) {
        const bool has_next = S.next(ui + 1, nxt);
        const char* nA = has_next ? (const char*)g.A + (size_t)nxt.pm * tstep : cA; const char* nB = has_next ? (const char*)g.Bt + (size_t)nxt.pn * tstep : cB;
        for (int t = 0; t < nt; t += 2) {
            const bool last = (t == nt - 2);
            const char* a1 = cA + (size_t)(t + 1) * kstep;
            const char* a2 = last ? nA : cA + (size_t)(t + 2) * kstep; const char* b2 = last ? nB : cB + (size_t)(t + 2) * kstep;
            const char* a3 = a2 + kstep; const char* b3 = b2 + kstep;
            if (last && has_next) S.a_ready(nxt);
            if constexpr (SP2) {
            PG8_LDB(B0, 0, 0); PG8_LDB(B1, 0, 1); PG8_SCHED; PG8_LDA(At, 0, 0); PG8_STAGE(PG8_SA(1, 1), a1 + hstep, voffA);
            PG8_WAIT_V(8); PG8_WAIT_L(0); PG8_BAR; PG8_MMA(0, 0, At, B0); PG8_MMA(0, 1, At, B1); PG8_BAR; PG8_SCHED;
            PG8_LDA(At, 0, 1); PG8_STAGE(PG8_SB(0, 0), b2, voffB); PG8_STAGE(PG8_SB(0, 1), b2 + hstep, voffB); PG8_STAGE(PG8_SA(0, 0), a2, voffA);
            PG8_WAIT_V(8); PG8_WAIT_L(0); PG8_BAR; PG8_MMA(1, 0, At, B0); PG8_MMA(1, 1, At, B1); PG8_BAR; PG8_SCHED;
            PG8_LDB(B0, 1, 0); PG8_LDB(B1, 1, 1); PG8_SCHED; PG8_LDA(At, 1, 0); PG8_STAGE(PG8_SA(0, 1), a2 + hstep, voffA);
            PG8_WAIT_V(8); PG8_WAIT_L(0); PG8_BAR; PG8_MMA(0, 0, At, B0); PG8_MMA(0, 1, At, B1); PG8_BAR; PG8_SCHED;
            PG8_LDA(At, 1, 1); PG8_STAGE(PG8_SB(1, 0), b3, voffB); PG8_STAGE(PG8_SB(1, 1), b3 + hstep, voffB); PG8_STAGE(PG8_SA(1, 0), a3, voffA);
            PG8_WAIT_V(8); PG8_WAIT_L(0); PG8_BAR; PG8_MMA(1, 0, At, B0); PG8_MMA(1, 1, At, B1); PG8_BAR; PG8_SCHED;
            } else {
            PG8_LDB(B0, 0, 0); PG8_SCHED; PG8_LDA(At, 0, 0); PG8_STAGE(PG8_SA(1, 1), a1 + hstep, voffA);
            PG8_WAIT_L(8); PG8_BAR; PG8_WAIT_L(0); PG8_MMA(0, 0, At, B0); PG8_BAR; PG8_SCHED;
            PG8_LDB(B1, 0, 1); PG8_STAGE(PG8_SB(0, 0), b2, voffB);
            PG8_BAR; PG8_WAIT_L(0); PG8_MMA(0, 1, At, B1); PG8_BAR;
            PG8_LDA(At, 0, 1); PG8_STAGE(PG8_SA(0, 0), a2, voffA);
            PG8_BAR; PG8_WAIT_L(0); PG8_MMA(1, 0, At, B0); PG8_BAR; PG8_SCHED;
            PG8_STAGE(PG8_SB(0, 1), b2 + hstep, voffB);
            PG8_WAIT_V(6); PG8_BAR; PG8_MMA(1, 1, At, B1); PG8_BAR;
            PG8_LDB(B0, 1, 0); PG8_SCHED; PG8_LDA(At, 1, 0); PG8_STAGE(PG8_SA(0, 1), a2 + hstep, voffA);
            PG8_WAIT_L(8); PG8_BAR; PG8_WAIT_L(0); PG8_MMA(0, 0, At, B0); PG8_BAR; PG8_SCHED;
            PG8_LDB(B1, 1, 1); PG8_STAGE(PG8_SB(1, 0), b3, voffB);
            PG8_BAR; PG8_WAIT_L(0); PG8_MMA(0, 1, At, B1); PG8_BAR;
            PG8_LDA(At, 1, 1); PG8_STAGE(PG8_SA(1, 0), a3, voffA);
            PG8_BAR; PG8_WAIT_L(0); PG8_MMA(1, 0, At, B0); PG8_BAR; PG8_SCHED;
            PG8_STAGE(PG8_SB(1, 1), b3 + hstep, voffB);
            PG8_WAIT_V(6); PG8_BAR; PG8_MMA(1, 1, At, B1); PG8_BAR;
            }
        }
        if constexpr (ALIGN_EPI) { if (wr == 0) PG8_BAR; }
        E(acc, cur, wr, wc, fr, fq); S.done(cur);
        if (!has_next) break;
#pragma unroll
        for (int a = 0; a < 2; ++a)
#pragma unroll
            for (int b = 0; b < 2; ++b)
#pragma unroll
                for (int m = 0; m < 4; ++m)
#pragma unroll
                    for (int n = 0; n < 2; ++n) acc[a][b][m][n] = (f32x4){0.f, 0.f, 0.f, 0.f};
        cur = nxt; cA = nA; cB = nB; ++ui;
        if constexpr (ALIGN_EPI) { if (wr == 1) PG8_BAR; }
    }
    PG8_WAIT_V(0);
    if constexpr (!ALIGN_EPI) { if (wr == 0) PG8_BAR; }
    PG8_BAR;
#undef PG8_SA
#undef PG8_SB
#undef PG8_STAGE
#undef PG8_LDA
#undef PG8_LDB
#undef PG8_MMA
#undef PG8_WAIT_V
#undef PG8_WAIT_L
#undef PG8_BAR
#undef PG8_SCHED
}
}

namespace pg9 {
using pg8::bf16_t; using pg8::bf16x8; using pg8::f32x4; using pg8::f32x2; using pg8::u32x4; using pg8::stage_rc; using pg8::lds_byte; using pg8::perm32; using pg8::cvt_pk_bf16; using pg8::gelu_pk;
constexpr int BMR = 288, BNC = 256, BK = 64, THIRD = 96, HALF = 128, ATB = THIRD * BK * 2, BHB = HALF * BK * 2, NXCD = 8, WGM = 8;
constexpr int STAGE_BYTES = 6 * ATB + 4 * BHB;
struct Unit { int pm, pn; };
struct Gemm { const bf16_t* A; const bf16_t* Bt; int M, N, K, lda, ldb; };
struct Order {
    int nM, nN, nwg, G, c;
    __host__ __device__ void init(int M, int N, int G_, int c_) { nM = M / BMR; nN = N / BNC; nwg = nM * nN; G = G_; c = c_; }
    __host__ __device__ bool next(int i, Unit& u) const {
        const long L = (long)i * G + c; if (L >= nwg) return false;
        int wgid = (int)L; { const int q = nwg / NXCD, r = nwg % NXCD, xcd = wgid % NXCD, off = wgid / NXCD; wgid = (xcd < r ? xcd * (q + 1) : r * (q + 1) + (xcd - r) * q) + off; }
        const int nig = WGM * nN, gid = wgid / nig, fm = gid * WGM, gsz = (nM - fm) < WGM ? (nM - fm) : WGM;
        u.pm = fm + ((wgid % nig) % gsz); u.pn = (wgid % nig) / gsz; return true;
    }
};
template <int ACT  > struct EpiBf16 {
    static constexpr bool PERM = true, AFTER_DRAIN = false, INIT_ACC = false;
    bf16_t* O; int ldc; const float* bias;
    __device__ __forceinline__ void operator()(const f32x4 (&acc)[3][2][3][2], const Unit& u, int wr, int wc, int fr, int fq) const {
        const int row0 = u.pm * BMR + wr * 48 + fr; const int col0 = u.pn * BNC + wc * 32 + 8 * fq;
        f32x4 bv[2][2];
#pragma unroll
        for (int bj = 0; bj < 2; ++bj)
#pragma unroll
            for (int n = 0; n < 2; ++n) bv[bj][n] = (ACT == 1) ? *(const f32x4*)(bias + col0 + bj * HALF + 4 * n) : (f32x4){0.f, 0.f, 0.f, 0.f};
#pragma unroll
        for (int ai = 0; ai < 3; ++ai)
#pragma unroll
            for (int m = 0; m < 3; ++m) { bf16_t* rowp = O + (size_t)(row0 + ai * THIRD + m * 16) * ldc + col0;
#pragma unroll
                for (int bj = 0; bj < 2; ++bj) { f32x4 v0 = acc[ai][bj][m][0] + bv[bj][0], v1 = acc[ai][bj][m][1] + bv[bj][1];
                    if (ACT == 1) { f32x2 a = gelu_pk((f32x2){v0[0], v0[1]}), b = gelu_pk((f32x2){v0[2], v0[3]}), c = gelu_pk((f32x2){v1[0], v1[1]}), d = gelu_pk((f32x2){v1[2], v1[3]});
                        v0 = (f32x4){a.x, a.y, b.x, b.y}; v1 = (f32x4){c.x, c.y, d.x, d.y}; }
                    if (ACT == 2) {
#pragma unroll
                        for (int j = 0; j < 4; ++j) { const float p = fmaxf(v0[j], 0.f), q = fmaxf(v1[j], 0.f); v0[j] = p * p; v1[j] = q * q; } }
                    u32x4 w; w.x = cvt_pk_bf16(v0[0], v0[1]); w.y = cvt_pk_bf16(v0[2], v0[3]); w.z = cvt_pk_bf16(v1[0], v1[1]); w.w = cvt_pk_bf16(v1[2], v1[3]);
                    *(u32x4*)(rowp + bj * HALF) = w; } }
    }
};
struct EpiRes {
    static constexpr bool PERM = false, AFTER_DRAIN = false, INIT_ACC = false;
    float* out; int ldc; const float* resA; const float* resB; int split; float alpha;
    __device__ __forceinline__ void operator()(const f32x4 (&acc)[3][2][3][2], const Unit& u, int wr, int wc, int fr, int fq) const {
        const int row0 = u.pm * BMR + wr * 48 + fr, col0 = u.pn * BNC + wc * 32 + 4 * fq;
#pragma unroll
        for (int ai = 0; ai < 3; ++ai)
#pragma unroll
            for (int m = 0; m < 3; ++m) { const int row = row0 + ai * THIRD + m * 16;
                const float* rp = (row < split ? resA + (size_t)row * ldc : resB + (size_t)(row - split) * ldc) + col0; float* op = out + (size_t)row * ldc + col0;
#pragma unroll
                for (int bj = 0; bj < 2; ++bj)
#pragma unroll
                    for (int n = 0; n < 2; ++n) { const f32x4 rv = *(const f32x4*)(rp + bj * HALF + n * 16); *(f32x4*)(op + bj * HALF + n * 16) = acc[ai][bj][m][n] + rv * alpha; } }
    }
};

struct EpiSg {
    static constexpr bool PERM = true, AFTER_DRAIN = false, INIT_ACC = false;
    bf16_t* O; int ldc; const float* bias; float* stat;
    __device__ __forceinline__ void operator()(const f32x4 (&acc)[3][2][3][2], const Unit& u, int wr, int wc, int fr, int fq) const {
        const int row0 = u.pm * BMR + wr * 48 + fr; const int col0 = u.pn * BNC + wc * 32 + 8 * fq;
        f32x4 bv[2][2];
#pragma unroll
        for (int bj = 0; bj < 2; ++bj)
#pragma unroll
            for (int n = 0; n < 2; ++n) bv[bj][n] = *(const f32x4*)(bias + col0 + bj * HALF + 4 * n);
        const bool vhalf = u.pn >= 8;
#pragma unroll
        for (int ai = 0; ai < 3; ++ai)
#pragma unroll
            for (int m = 0; m < 3; ++m) { const int row = row0 + ai * THIRD + m * 16; bf16_t* rowp = O + (size_t)row * ldc + col0; float s = 0.f, q = 0.f;
#pragma unroll
                for (int bj = 0; bj < 2; ++bj) { f32x4 v0 = acc[ai][bj][m][0] + bv[bj][0], v1 = acc[ai][bj][m][1] + bv[bj][1];
                    { f32x2 a = gelu_pk((f32x2){v0[0], v0[1]}), b = gelu_pk((f32x2){v0[2], v0[3]}), c = gelu_pk((f32x2){v1[0], v1[1]}), d = gelu_pk((f32x2){v1[2], v1[3]});
                        v0 = (f32x4){a.x, a.y, b.x, b.y}; v1 = (f32x4){c.x, c.y, d.x, d.y}; }
                    s += ((v0[0] + v0[1]) + (v0[2] + v0[3])) + ((v1[0] + v1[1]) + (v1[2] + v1[3]));
                    q += ((v0[0] * v0[0] + v0[1] * v0[1]) + (v0[2] * v0[2] + v0[3] * v0[3])) + ((v1[0] * v1[0] + v1[1] * v1[1]) + (v1[2] * v1[2] + v1[3] * v1[3]));
                    u32x4 w; w.x = cvt_pk_bf16(v0[0], v0[1]); w.y = cvt_pk_bf16(v0[2], v0[3]); w.z = cvt_pk_bf16(v1[0], v1[1]); w.w = cvt_pk_bf16(v1[2], v1[3]);
                    *(u32x4*)(rowp + bj * HALF) = w; }
                if (vhalf) { s += __shfl_xor(s, 16); s += __shfl_xor(s, 32); q += __shfl_xor(q, 16); q += __shfl_xor(q, 32);
                    if (fq == 0) { (void)__hip_atomic_fetch_add(stat + 2 * (size_t)row, s, __ATOMIC_RELAXED, __HIP_MEMORY_SCOPE_AGENT); (void)__hip_atomic_fetch_add(stat + 2 * (size_t)row + 1, q, __ATOMIC_RELAXED, __HIP_MEMORY_SCOPE_AGENT); } } }
    }
};

struct PanelStats {
    unsigned* xbuf; unsigned* cnt; unsigned* tmo; float eps;
    __device__ __forceinline__ void run(const f32x4 (&v)[3][2][3][2], const Unit& u, int wr, int wc, int fr, int fq, PG8_LAS unsigned char* lds, int wid, int lane) const {
        PG8_LAS f32x2* P = (PG8_LAS f32x2*)lds;
        PG8_LAS f32x2* St = (PG8_LAS f32x2*)(lds + 9216);
#pragma unroll
        for (int ai = 0; ai < 3; ++ai)
#pragma unroll
            for (int m = 0; m < 3; ++m) {
                float s = 0.f;
#pragma unroll
                for (int bj = 0; bj < 2; ++bj)
#pragma unroll
                    for (int n = 0; n < 2; ++n) { const f32x4 x = v[ai][bj][m][n]; s += (x[0] + x[1]) + (x[2] + x[3]); }
                s += __shfl_xor(s, 16); s += __shfl_xor(s, 32);
                const float mw = s * (1.0f / 64.0f); float q = 0.f;
#pragma unroll
                for (int bj = 0; bj < 2; ++bj)
#pragma unroll
                    for (int n = 0; n < 2; ++n) { const f32x4 d = v[ai][bj][m][n] - mw; q += (d[0] * d[0] + d[1] * d[1]) + (d[2] * d[2] + d[3] * d[3]); }
                q += __shfl_xor(q, 16); q += __shfl_xor(q, 32);
                if (fq == 0) P[(ai * THIRD + wr * 48 + m * 16 + fr) * 4 + wc] = (f32x2){mw, q};
            }
        asm volatile("s_waitcnt lgkmcnt(0)" ::: "memory"); __builtin_amdgcn_s_barrier(); asm volatile("" ::: "memory");
        const int row = wid * 64 + lane;
        if (row < BMR) {
            const f32x2 a = P[row * 4 + 0], b = P[row * 4 + 1], c = P[row * 4 + 2], d = P[row * 4 + 3];
            const float mt = (a.x + b.x + c.x + d.x) * 0.25f;
            const float da = a.x - mt, db = b.x - mt, dc = c.x - mt, dd = d.x - mt;
            const float m2 = (a.y + b.y) + (c.y + d.y) + 64.0f * ((da * da + db * db) + (dc * dc + dd * dd));
            unsigned long long* slot = (unsigned long long*)xbuf + ((size_t)(u.pm * BMR + row) * 8 + u.pn);
            __hip_atomic_store(slot, ((unsigned long long)__float_as_uint(m2) << 32) | __float_as_uint(mt), __ATOMIC_RELAXED, __HIP_MEMORY_SCOPE_AGENT);
        }
        asm volatile("s_waitcnt vmcnt(0)" ::: "memory");
        if (lane == 0) __hip_atomic_fetch_add(cnt + 64 * u.pm, 1u, __ATOMIC_RELAXED, __HIP_MEMORY_SCOPE_AGENT);
        if (wid == 0) {
            unsigned sp = 0u;
            for (;;) {
                if ((unsigned)__builtin_amdgcn_readfirstlane(__hip_atomic_load(cnt + 64 * u.pm, __ATOMIC_RELAXED, __HIP_MEMORY_SCOPE_AGENT)) >= 64u) break;
                __builtin_amdgcn_s_sleep(2);
                if (++sp > (1u << 22)) { if (lane == 0) __hip_atomic_store(tmo, 1u, __ATOMIC_RELAXED, __HIP_MEMORY_SCOPE_AGENT); break; }
            }
        }
        asm volatile("s_waitcnt vmcnt(0) lgkmcnt(0)" ::: "memory"); __builtin_amdgcn_s_barrier(); asm volatile("" ::: "memory");
        if (row < BMR) {
            const unsigned long long* slot = (const unsigned long long*)xbuf + (size_t)(u.pm * BMR + row) * 8; float mt[8], m2[8]; float ms = 0.f;
#pragma unroll
            for (int t = 0; t < 8; ++t) { const unsigned long long w = __hip_atomic_load(slot + t, __ATOMIC_RELAXED, __HIP_MEMORY_SCOPE_AGENT); mt[t] = __uint_as_float((unsigned)w); m2[t] = __uint_as_float((unsigned)(w >> 32)); ms += mt[t]; }
            const float mean = ms * 0.125f; float q = 0.f;
#pragma unroll
            for (int t = 0; t < 8; ++t) { const float dm = mt[t] - mean; q += m2[t] + 256.0f * dm * dm; }
            St[row] = (f32x2){mean, 1.0f / sqrtf(q * (1.0f / 2048.0f) + eps)};
        }
        asm volatile("s_waitcnt lgkmcnt(0)" ::: "memory"); __builtin_amdgcn_s_barrier(); asm volatile("" ::: "memory");
    }
};
struct EpiLn {
    static constexpr bool PERM = true, AFTER_DRAIN = true, INIT_ACC = true;
    const bf16_t* res; int ldr; float alpha;
    const float* gam; const float* bet; float* outf; bf16_t* outb; int ldb16;
    PanelStats st;
    __device__ __forceinline__ void init_load(u32x4 (&rw)[3][3][2], const Unit& u, int wr, int wc, int fr, int fq) const {
        const int row0 = u.pm * BMR + wr * 48 + fr, col0 = u.pn * BNC + wc * 32 + 8 * fq;
#pragma unroll
        for (int ai = 0; ai < 3; ++ai)
#pragma unroll
            for (int m = 0; m < 3; ++m)
#pragma unroll
                for (int bj = 0; bj < 2; ++bj) rw[ai][m][bj] = *(const u32x4*)(res + (size_t)(row0 + ai * THIRD + m * 16) * ldr + col0 + bj * HALF);
    }
    __device__ __forceinline__ void init_acc(f32x4 (&acc)[3][2][3][2], const u32x4 (&rw)[3][3][2]) const {
#pragma unroll
        for (int ai = 0; ai < 3; ++ai)
#pragma unroll
            for (int m = 0; m < 3; ++m)
#pragma unroll
                for (int bj = 0; bj < 2; ++bj) { const u32x4 w = rw[ai][m][bj];
                    acc[ai][bj][m][0] = (f32x4){__uint_as_float(w.x << 16), __uint_as_float(w.x & 0xffff0000u), __uint_as_float(w.y << 16), __uint_as_float(w.y & 0xffff0000u)} * alpha;
                    acc[ai][bj][m][1] = (f32x4){__uint_as_float(w.z << 16), __uint_as_float(w.z & 0xffff0000u), __uint_as_float(w.w << 16), __uint_as_float(w.w & 0xffff0000u)} * alpha; }
    }
    __device__ __forceinline__ void fused(f32x4 (&acc)[3][2][3][2], const Unit& u, int wr, int wc, int fr, int fq, PG8_LAS unsigned char* lds, int wid, int lane) const {
        const PG8_LAS f32x2* St = (const PG8_LAS f32x2*)(lds + 9216);
        const int row0 = u.pm * BMR + wr * 48 + fr, col0 = u.pn * BNC + wc * 32 + 8 * fq;
        st.run(acc, u, wr, wc, fr, fq, lds, wid, lane);
#pragma unroll
        for (int bj = 0; bj < 2; ++bj) {
            const f32x4 g0 = *(const f32x4*)(gam + col0 + bj * HALF), g1 = *(const f32x4*)(gam + col0 + bj * HALF + 4), b0 = *(const f32x4*)(bet + col0 + bj * HALF), b1 = *(const f32x4*)(bet + col0 + bj * HALF + 4);
#pragma unroll
            for (int ai = 0; ai < 3; ++ai)
#pragma unroll
                for (int m = 0; m < 3; ++m) { const int rl = ai * THIRD + wr * 48 + m * 16 + fr; const f32x2 sr = St[rl]; const size_t off = (size_t)(u.pm * BMR + rl) * 2048 + col0 + bj * HALF;
                    const f32x4 y0 = (acc[ai][bj][m][0] - sr.x) * sr.y * g0 + b0, y1 = (acc[ai][bj][m][1] - sr.x) * sr.y * g1 + b1;
                    if (outf) { *(f32x4*)(outf + off) = y0; *(f32x4*)(outf + off + 4) = y1; }
                    if (outb) { u32x4 w; w.x = cvt_pk_bf16(y0[0], y0[1]); w.y = cvt_pk_bf16(y0[2], y0[3]); w.z = cvt_pk_bf16(y1[0], y1[1]); w.w = cvt_pk_bf16(y1[2], y1[3]); *(u32x4*)(outb + (size_t)(u.pm * BMR + rl) * ldb16 + col0 + bj * HALF) = w; }
                    asm volatile("" ::: "memory"); }
        }
    }
};

struct ListOrder { int first, stride, total, nM;
    __host__ __device__ bool next(int i, Unit& u) const { const int id = first + i * stride; if (id >= total) return false; u.pm = id % nM; u.pn = id / nM; return true; } };

template <class Epi, bool ALIGN_EPI = true, class Sched = Order>
__device__ __forceinline__ void gemm_phase(PG8_LAS unsigned char* lds, const Gemm g, const Sched& S, const Epi& E) {
    const int tid = threadIdx.x, wid = __builtin_amdgcn_readfirstlane(tid >> 6), lane = tid & 63, wr = wid >> 2, wc = wid & 3, fr = lane & 15, fq = lane >> 4;
    const int K = g.K, nt = K / BK;
    const int lda = g.lda, ldb = g.ldb;
    unsigned voffA0, voffA1, voffB[2];
    { int R, C; stage_rc((wid & 3) * 1024 + lane * 16, R, C); voffA0 = (unsigned)(R * lda + C) * 2u; stage_rc((wid + 4) * 1024 + lane * 16, R, C); voffA1 = (unsigned)(R * lda + C) * 2u; }
#pragma unroll
    for (int i = 0; i < 2; ++i) { int R, C; stage_rc(tid * 16 + i * 8192, R, C); const int Rb = Epi::PERM ? ((R & ~31) + perm32(R & 31)) : R; voffB[i] = (unsigned)(Rb * ldb + C) * 2u; }
    const size_t kstep = (size_t)(BK * 2);
    const size_t thstep = (size_t)THIRD * lda * 2, hstep = (size_t)HALF * ldb * 2;
    const size_t tstepA = 3 * thstep, tstepB = 2 * hstep;
    const unsigned ldsw = (unsigned)wid * 1024u;
    const int aoff = lds_byte(wr * 48 + fr, fq * 8), boff = lds_byte(wc * 32 + fr, fq * 8);
#define PG9_SA(b, a) (((b) * 3 + (a)) * ATB)
#define PG9_SB(b, h) (6 * ATB + ((b) * 2 + (h)) * BHB)
#define PG9_GLDS(gp, lp) __builtin_amdgcn_global_load_lds((const unsigned*)(gp), (PG8_LAS unsigned*)(lp), 16, 0, 0)
#define PG9_STAGE_A(slot, gbase) do { if (wr == 0) PG9_GLDS((const char*)(gbase) + voffA0, lds + (slot) + ldsw); PG9_GLDS((const char*)(gbase) + voffA1, lds + (slot) + ldsw + 4096); } while (0)
#define PG9_STAGE_B(slot, gbase) do { PG9_GLDS((const char*)(gbase) + voffB[0], lds + (slot) + ldsw); PG9_GLDS((const char*)(gbase) + voffB[1], lds + (slot) + ldsw + 8192); } while (0)
#define PG9_LDA(dst, b, a) do { _Pragma("unroll") for (int m = 0; m < 3; ++m) _Pragma("unroll") for (int k = 0; k < 2; ++k) dst[m][k] = *(const PG8_LAS bf16x8*)(lds + PG9_SA(b, a) + aoff + m * 2048 + k * 1024); } while (0)
#define PG9_LDB(dst, b, h) do { _Pragma("unroll") for (int n = 0; n < 2; ++n) _Pragma("unroll") for (int k = 0; k < 2; ++k) dst[n][k] = *(const PG8_LAS bf16x8*)(lds + PG9_SB(b, h) + boff + n * 2048 + k * 1024); } while (0)
#define PG9_MMA(ai, bj, At, Bt) do { _Pragma("unroll") for (int m = 0; m < 3; ++m) _Pragma("unroll") for (int n = 0; n < 2; ++n) _Pragma("unroll") for (int k = 0; k < 2; ++k) \
        acc[ai][bj][m][n] = __builtin_amdgcn_mfma_f32_16x16x32_bf16(Bt[n][k], At[m][k], acc[ai][bj][m][n], 0, 0, 0); } while (0)
#define PG9_MMA2(ai) do { __builtin_amdgcn_s_setprio(1); PG9_MMA(ai, 0, At, B0); PG9_MMA(ai, 1, At, B1); __builtin_amdgcn_s_setprio(0); } while (0)
#define PG9_WAIT_V2(a, b) do { if (wr == 0) asm volatile("s_waitcnt vmcnt(" #a ")" ::: "memory"); else asm volatile("s_waitcnt vmcnt(" #b ")" ::: "memory"); } while (0)
#define PG9_WAIT_L0 asm volatile("s_waitcnt lgkmcnt(0)" ::: "memory")
#define PG9_BAR __builtin_amdgcn_s_barrier()
#define PG9_SCHED __builtin_amdgcn_sched_barrier(0)
    Unit cur, nxt; int ui = 0;
    if (!S.next(0, cur)) return;
    f32x4 acc[3][2][3][2];
    u32x4 rinit[3][3][2];
    if constexpr (Epi::INIT_ACC) E.init_load(rinit, cur, wr, wc, fr, fq);
    else {
#pragma unroll
    for (int a = 0; a < 3; ++a)
#pragma unroll
        for (int b = 0; b < 2; ++b)
#pragma unroll
            for (int m = 0; m < 3; ++m)
#pragma unroll
                for (int n = 0; n < 2; ++n) acc[a][b][m][n] = (f32x4){0.f, 0.f, 0.f, 0.f};
    }
    bf16x8 At[3][2], B0[2][2], B1[2][2];
    const char* cA = (const char*)g.A + (size_t)cur.pm * tstepA; const char* cB = (const char*)g.Bt + (size_t)cur.pn * tstepB;
    PG9_STAGE_B(PG9_SB(0, 0), cB); PG9_STAGE_B(PG9_SB(0, 1), cB + hstep); PG9_STAGE_A(PG9_SA(0, 0), cA); PG9_STAGE_A(PG9_SA(0, 1), cA + thstep); PG9_STAGE_A(PG9_SA(0, 2), cA + 2 * thstep);
    if constexpr (Epi::INIT_ACC) { PG9_SCHED; E.init_acc(acc, rinit); PG9_SCHED; }
    if (wr == 1) PG9_BAR;
    PG9_WAIT_V2(4, 2); PG9_BAR;
    PG9_STAGE_B(PG9_SB(1, 0), cB + kstep); PG9_STAGE_B(PG9_SB(1, 1), cB + hstep + kstep); PG9_STAGE_A(PG9_SA(1, 0), cA + kstep); PG9_STAGE_A(PG9_SA(1, 1), cA + thstep + kstep);
    PG9_WAIT_V2(8, 6); PG9_BAR;
    for (;;) {
        const bool has_next = S.next(ui + 1, nxt);
        const char* nA = has_next ? (const char*)g.A + (size_t)nxt.pm * tstepA : cA; const char* nB = has_next ? (const char*)g.Bt + (size_t)nxt.pn * tstepB : cB;
        for (int t = 0; t < nt; t += 2) {
            const bool last = (t == nt - 2);
            const char* a1 = cA + (size_t)(t + 1) * kstep;
            const char* a2 = last ? nA : cA + (size_t)(t + 2) * kstep; const char* b2 = last ? nB : cB + (size_t)(t + 2) * kstep;
            const char* a3 = a2 + kstep; const char* b3 = b2 + kstep;
            PG9_LDB(B0, 0, 0); PG9_LDB(B1, 0, 1); PG9_SCHED; PG9_LDA(At, 0, 0); PG9_STAGE_A(PG9_SA(1, 2), a1 + 2 * thstep);
            PG9_WAIT_V2(12, 8); PG9_WAIT_L0; PG9_BAR; PG9_MMA2(0); PG9_BAR; PG9_SCHED;
            PG9_LDA(At, 0, 1); PG9_STAGE_B(PG9_SB(0, 0), b2); PG9_STAGE_B(PG9_SB(0, 1), b2 + hstep);
            PG9_WAIT_V2(14, 11); PG9_WAIT_L0; PG9_BAR; PG9_MMA2(1); PG9_BAR; PG9_SCHED;
            PG9_LDA(At, 0, 2); PG9_STAGE_A(PG9_SA(0, 0), a2); PG9_STAGE_A(PG9_SA(0, 1), a2 + thstep);
            PG9_WAIT_V2(12, 8); PG9_WAIT_L0; PG9_BAR; PG9_MMA2(2); PG9_BAR; PG9_SCHED;
            PG9_LDB(B0, 1, 0); PG9_LDB(B1, 1, 1); PG9_SCHED; PG9_LDA(At, 1, 0); PG9_STAGE_A(PG9_SA(0, 2), a2 + 2 * thstep);
            PG9_WAIT_V2(12, 8); PG9_WAIT_L0; PG9_BAR; PG9_MMA2(0); PG9_BAR; PG9_SCHED;
            PG9_LDA(At, 1, 1); PG9_STAGE_B(PG9_SB(1, 0), b3); PG9_STAGE_B(PG9_SB(1, 1), b3 + hstep);
            PG9_WAIT_V2(14, 11); PG9_WAIT_L0; PG9_BAR; PG9_MMA2(1); PG9_BAR; PG9_SCHED;
            PG9_LDA(At, 1, 2); PG9_STAGE_A(PG9_SA(1, 0), a3); PG9_STAGE_A(PG9_SA(1, 1), a3 + thstep);
            PG9_WAIT_V2(12, 8); PG9_WAIT_L0; PG9_BAR; PG9_MMA2(2); PG9_BAR; PG9_SCHED;
        }
        if constexpr (ALIGN_EPI) { if (wr == 0) PG9_BAR; }
        if constexpr (!Epi::AFTER_DRAIN) E(acc, cur, wr, wc, fr, fq);
        if (!has_next) break;
#pragma unroll
        for (int a = 0; a < 3; ++a)
#pragma unroll
            for (int b = 0; b < 2; ++b)
#pragma unroll
                for (int m = 0; m < 3; ++m)
#pragma unroll
                    for (int n = 0; n < 2; ++n) acc[a][b][m][n] = (f32x4){0.f, 0.f, 0.f, 0.f};
        cur = nxt; cA = nA; cB = nB; ++ui;
        if constexpr (ALIGN_EPI) { if (wr == 1) PG9_BAR; }
    }
    asm volatile("s_waitcnt vmcnt(0)" ::: "memory");
    if constexpr (!ALIGN_EPI) { if (wr == 0) PG9_BAR; }
    PG9_BAR;
    if constexpr (Epi::AFTER_DRAIN) E.fused(acc, cur, wr, wc, fr, fq, lds, wid, lane);
#undef PG9_SA
#undef PG9_SB
#undef PG9_GLDS
#undef PG9_STAGE_A
#undef PG9_STAGE_B
#undef PG9_LDA
#undef PG9_LDB
#undef PG9_MMA
#undef PG9_MMA2
#undef PG9_WAIT_V2
#undef PG9_WAIT_L0
#undef PG9_BAR
#undef PG9_SCHED
}
}

constexpr int NWAVES = 8, NTHR = NWAVES * 64;
constexpr int N_LAUNCHES = MK_N_LAUNCHES;
constexpr int NPHASE = 12;
constexpr int DM = 2048, MP = 8192, MS = 1024, M = MP + MS;
constexpr int SEQ = 2048, NB = 4, DB = 128, DT = 8;
constexpr int NH = 4, HK = 256, HV = 512, KD = 1024, RANK = 16;
constexpr int NPROJ = 6144, NQKV = 4096, RG_WGS = 86, WIN_LD = 6160, DFF = 8192, SGW = 2048, SGG = 8, SGC = 128, SGD = 256;
constexpr int PK2 = DM + 64, PK8 = DFF + 64;
constexpr float ALPHA = 1.41421356237309515f;
constexpr float LN_EPS = 1e-5f, HN_EPS = 1e-6f;
constexpr size_t OUT_Y = 0, OUT_SP = (size_t)M * DM, OUT_SS = OUT_SP + (size_t)NB * NH * HK * HV, OUT_SGV = OUT_SS + (size_t)DB * NH * HK * HV, OUT_END = OUT_SGV + (size_t)MS * SGW;

constexpr size_t MiB = 1u << 20;
constexpr size_t WS_CTL = 0, CTL_ZERO_BYTES = 1 * MiB;
constexpr size_t WS_WIN = 1 * MiB;
constexpr size_t WS_WOUT = WS_WIN + 25 * MiB;
constexpr size_t WS_W1 = WS_WOUT + 9 * MiB;
constexpr size_t WS_W2 = WS_W1 + 66 * MiB;
constexpr size_t WS_SGIN = WS_W2 + 65 * MiB;
constexpr size_t WS_SGOUT = WS_SGIN + 17 * MiB;
constexpr size_t WS_WC = WS_SGOUT + 9 * MiB;
constexpr size_t WS_XB = WS_WC + 1 * MiB;
constexpr size_t WS_RA = WS_XB + 38 * MiB;
constexpr size_t WS_PROJ = WS_RA, WS_LOGA = WS_RA + 108 * MiB, WS_HB = WS_RA;
constexpr size_t WS_RB = WS_RA + 146 * MiB;
constexpr size_t WS_O = WS_RB, WS_Z = WS_RB;
constexpr size_t WS_A2 = WS_RB + 72 * MiB;
constexpr size_t WS_XCH = WS_A2 + 38 * MiB;
constexpr size_t WS_X1 = WS_XCH + 1 * MiB;
constexpr size_t WS_X2 = WS_X1 + 72 * MiB;
constexpr size_t WS_VN = WS_X2 + 72 * MiB;
constexpr size_t WS_STAT = WS_VN + 36 * MiB;
constexpr size_t WS_IMG = WS_STAT + 1 * MiB;
constexpr size_t WS_END = WS_IMG + 37 * MiB;
constexpr int CW_BAR = 4096;
constexpr int CW_QUEUE = 64;
constexpr int CW_TMO = 1;
constexpr int CW_GATE = 8192;
constexpr int CW_LN = 16384, LN_BANK = 32 * 64;

constexpr int RING_BYTES = 139264;
constexpr int LDS_BYTES = 147456;
constexpr int MISC_OFF = LDS_BYTES - 256;

#define GAS __attribute__((address_space(1)))
#define LAS __attribute__((address_space(3)))
typedef unsigned short bf16;
typedef unsigned v4u __attribute__((ext_vector_type(4)));
typedef unsigned v2u __attribute__((ext_vector_type(2)));
typedef float f32x4 __attribute__((ext_vector_type(4)));
typedef short bf16x8 __attribute__((ext_vector_type(8)));
#define RLX_AGENT __ATOMIC_RELAXED, __HIP_MEMORY_SCOPE_AGENT
#define LDS_WAIT() asm volatile("s_waitcnt lgkmcnt(0)" ::: "memory")
#define VM_WAIT() asm volatile("s_waitcnt vmcnt(0)" ::: "memory")
__device__ __forceinline__ unsigned pk2(float lo, float hi) { return pg8::cvt_pk_bf16(lo, hi); }
__device__ __forceinline__ float bf_lo(unsigned w) { return __uint_as_float(w << 16); }
__device__ __forceinline__ float bf_hi(unsigned w) { return __uint_as_float(w & 0xffff0000u); }
__device__ __forceinline__ float bf2f(bf16 b) { return __uint_as_float(((unsigned)b) << 16); }

#define XB_TMO      128
#define XB_XCNT(j)  (256  + 64 * (j))
#define XB_XSUB(j)  (1280 + 64 * (j))
#define XB_XGEN(j)  (2304 + 64 * (j))
#define XB_TOP      3328
#define XB_TOPGEN   3392
#define XCD_BAR_WORDS 3456
#define XB_SPIN_CAP (1u << 22)
__device__ __forceinline__ unsigned xb_ld(unsigned* p)              { return __hip_atomic_load(p, __ATOMIC_RELAXED, __HIP_MEMORY_SCOPE_AGENT); }
__device__ __forceinline__ unsigned xb_add(unsigned* p, unsigned v) { return __hip_atomic_fetch_add(p, v, __ATOMIC_RELAXED, __HIP_MEMORY_SCOPE_AGENT); }
__device__ __forceinline__ unsigned xb_xcc_id() { return (unsigned)__builtin_amdgcn_s_getreg((3 << 11) | 20) & 0xFu; }
#define XB_SPIN(cond, bar) do { unsigned _sp = 0; while (cond) { __builtin_amdgcn_s_sleep(1); \
    if ((++_sp & 255u) == 0u) { if (xb_ld(&(bar)[XB_TMO])) break; if (_sp > XB_SPIN_CAP) { atomicAdd(&(bar)[XB_TMO], 1u); break; } } } } while (0)
struct XcdBarrier { unsigned* bar; unsigned x; volatile LAS unsigned* st; };
__device__ __forceinline__ XcdBarrier xcd_barrier_post(unsigned* bar, volatile LAS unsigned* st) {
    XcdBarrier b; b.bar = bar; b.x = xb_xcc_id(); b.st = st;
    if (threadIdx.x == 0) (void)xb_add(&bar[XB_XCNT(b.x)], 1u);
    return b;
}
__device__ __forceinline__ void xcd_barrier_complete(unsigned* bar, unsigned x, unsigned& nloc, unsigned& nx) {
    const unsigned G = gridDim.x * gridDim.y * gridDim.z;
    unsigned sum, cnt, mine, sp = 0u;
    for (;;) {
        sum = 0u; cnt = 0u; mine = 0u;
#pragma unroll
        for (unsigned j = 0; j < 16; ++j) { const unsigned c = xb_ld(&bar[XB_XCNT(j)]); sum += c; cnt += (c > 0u) ? 1u : 0u; mine = (j == x) ? c : mine; }
        if (sum == G) break;
        __builtin_amdgcn_s_sleep(1);
        if ((++sp & 255u) == 0u) { if (xb_ld(&bar[XB_TMO])) break; if (sp > XB_SPIN_CAP) { atomicAdd(&bar[XB_TMO], 1u); break; } }
    }
    nloc = mine > 0u ? mine : 1u; nx = cnt > 0u ? cnt : 1u;
}
__device__ __forceinline__ void xcd_barrier(const XcdBarrier& b) {
    asm volatile("s_waitcnt vmcnt(0)" ::: "memory");
    __syncthreads();
    if (threadIdx.x == 0) {
        unsigned* bar = b.bar;
        __builtin_amdgcn_s_waitcnt(0);
        unsigned nloc = b.st[0], nx = b.st[1];
        if (nloc == 0u) { xcd_barrier_complete(bar, b.x, nloc, nx); b.st[0] = nloc; b.st[1] = nx; }
        const unsigned old = xb_add(&bar[XB_XSUB(b.x)], 1u);
        const unsigned gen = old / nloc;
        if (old + 1u == (gen + 1u) * nloc) {
            __builtin_amdgcn_fence(__ATOMIC_RELEASE, "agent");
            asm volatile("s_waitcnt vmcnt(0)" ::: "memory");
            const unsigned og = xb_add(&bar[XB_TOP], 1u);
            const unsigned tg = og / nx;
            if (og + 1u == (tg + 1u) * nx) xb_add(&bar[XB_TOPGEN], 1u);
            else XB_SPIN(xb_ld(&bar[XB_TOPGEN]) == tg, bar);
            __builtin_amdgcn_fence(__ATOMIC_ACQUIRE, "agent");
            xb_add(&bar[XB_XGEN(b.x)], 1u);
            asm volatile("s_waitcnt vmcnt(0)" ::: "memory");
        } else {
            XB_SPIN(xb_ld(&bar[XB_XGEN(b.x)]) == gen, bar);
            __builtin_amdgcn_fence(__ATOMIC_ACQUIRE, "agent");
            asm volatile("s_waitcnt vmcnt(0)" ::: "memory");
        }
    }
    __syncthreads();
}

struct Frame {
    LAS unsigned char* lds;
    volatile LAS unsigned* MISC;
    unsigned* ctl;
    int tid, lane, wave, vcu, G;
    const float* in[21];
    float* out;
    unsigned char* ws;
};
__device__ __forceinline__ float wave_sum(float v) {
#pragma unroll
    for (int o = 1; o < 64; o <<= 1) v += __shfl_xor(v, o);
    return v;
}
__device__ __forceinline__ const float* xrow_ptr(const Frame& F, int m) { return m < MP ? F.in[0] + (size_t)m * DM : F.in[1] + (size_t)(m - MP) * DM; }

__device__ __forceinline__ void p0_transpose_item(const float* W, int ldw, int ldk, bf16* WT, int item, int nblk, int lane) {
    const int kb = item / nblk, nb = item - kb * nblk, k0 = 64 * kb, n0 = 64 * nb, q = lane >> 4, c = lane & 15;
    f32x4 v[16];
    const float* src = W + (size_t)(k0 + 16 * q) * ldw + n0 + 4 * c;
#pragma unroll
    for (int i = 0; i < 16; ++i) v[i] = __builtin_nontemporal_load((const f32x4*)(src + (size_t)i * ldw));
#pragma unroll
    for (int j = 0; j < 4; ++j) {
        v4u lo, hi;
        lo.x = pk2(v[0][j], v[1][j]); lo.y = pk2(v[2][j], v[3][j]); lo.z = pk2(v[4][j], v[5][j]); lo.w = pk2(v[6][j], v[7][j]);
        hi.x = pk2(v[8][j], v[9][j]); hi.y = pk2(v[10][j], v[11][j]); hi.z = pk2(v[12][j], v[13][j]); hi.w = pk2(v[14][j], v[15][j]);
        bf16* dst = WT + (size_t)(n0 + 4 * c + j) * ldk + k0 + 16 * q;
        *(v4u*)dst = lo; *(v4u*)(dst + 8) = hi;
    }
}
constexpr int DT_I_WOUT = (DM / 64) * (DM / 64), DT_I_W1 = (DM / 64) * (DFF / 64), DT_I_W2 = (DFF / 64) * (DM / 64), DT_I_SGIN = (DM / 64) * (2 * SGW / 64), DT_I_SGOUT = (SGW / 64) * (DM / 64);
constexpr int DT_NITEMS = DT_I_WOUT + 2 * DT_I_W1 + 2 * DT_I_W2 + DT_I_SGIN + DT_I_SGOUT, DT_NCHUNK = DT_NITEMS / 64;
static_assert(DT_NITEMS % 64 == 0, "deferred transposes: whole chunks");
__device__ __forceinline__ void deferred_transpose_chunk(Frame& F, int chunk) {
    unsigned char* ws = F.ws;
    for (int i = 0; i < 8; ++i) {
        int r = chunk * 64 + F.wave * 8 + i;
        if (r < DT_I_WOUT) { p0_transpose_item(F.in[7], DM, PK2, (bf16*)(ws + WS_WOUT), r, DM / 64, F.lane); continue; } r -= DT_I_WOUT;
        if (r < 2 * DT_I_W1) { const int l = r / DT_I_W1; r -= l * DT_I_W1; p0_transpose_item(F.in[15] + (size_t)l * DM * DFF, DFF, PK2, (bf16*)(ws + WS_W1) + (size_t)l * DFF * PK2, r, DFF / 64, F.lane); continue; } r -= 2 * DT_I_W1;
        if (r < 2 * DT_I_W2) { const int l = r / DT_I_W2; r -= l * DT_I_W2; p0_transpose_item(F.in[16] + (size_t)l * DFF * DM, DM, PK8, (bf16*)(ws + WS_W2) + (size_t)l * DM * PK8, r, DM / 64, F.lane); continue; } r -= 2 * DT_I_W2;
        if (r < DT_I_SGIN) { p0_transpose_item(F.in[8], 2 * SGW, PK2, (bf16*)(ws + WS_SGIN), r, 2 * SGW / 64, F.lane); continue; } r -= DT_I_SGIN;
        p0_transpose_item(F.in[14], DM, PK2, (bf16*)(ws + WS_SGOUT), r, DM / 64, F.lane);
    }
}
__device__ __forceinline__ float logsigmoid_f(float x) { return fminf(x, 0.f) - log1pf(expf(-fabsf(x))); }
__device__ __forceinline__ float logsigmoid_fast(float x) { return fminf(x, 0.f) - __logf(1.0f + __expf(-fabsf(x))); }
__device__ __forceinline__ void p0_prologue(Frame& F) {
    const int gw = F.vcu * NWAVES + F.wave, NGW = F.G * NWAVES;
    unsigned char* ws = F.ws;
    {
        constexpr int I_WIN = (DM / 64) * (NPROJ / 64);
        for (int it = gw; it < I_WIN; it += NGW) p0_transpose_item(F.in[3], WIN_LD, PK2, (bf16*)(ws + WS_WIN), it, NPROJ / 64, F.lane);
    }
    {
        bf16* wc = (bf16*)(ws + WS_WC); const float* wsp = F.in[12];
        for (int i = F.vcu * NTHR + F.tid; i < SGG * SGC * SGC; i += F.G * NTHR) { const int s = i & 127, t = (i >> 7) & 127; wc[i] = (bf16)(pk2(s <= t ? wsp[i] : 0.f, 0.f) & 0xffffu); }
        float* stat = (float*)(ws + WS_STAT);
        for (int i = F.vcu * NTHR + F.tid; i < 2 * M; i += F.G * NTHR) stat[i] = 0.f;
    }
    {
        constexpr int WGP = DM + 4;
        LAS float* wgT = (LAS float*)F.lds;
        for (int idx = F.tid; idx < DM * 4; idx += NTHR) { const int k = idx >> 2, part = idx & 3; const f32x4 w = *(const f32x4*)(F.in[3] + (size_t)k * WIN_LD + NPROJ + 4 * part);
            wgT[(4 * part + 0) * WGP + k] = w.x; wgT[(4 * part + 1) * WGP + k] = w.y; wgT[(4 * part + 2) * WGP + k] = w.z; wgT[(4 * part + 3) * WGP + k] = w.w; }
        __syncthreads();
        const float* wgate = F.in[4]; const float* bgate = F.in[5];
        bf16* xb = (bf16*)(ws + WS_XB); float* loga = (float*)(ws + WS_LOGA);
        const int rows_wg = M / F.G;
        const int r_lo = (F.wave * rows_wg) / NWAVES, r_hi = ((F.wave + 1) * rows_wg) / NWAVES;
        const int lane = F.lane, fr = lane & 15, fq = lane >> 4;
        LAS float* GT = (LAS float*)(F.lds + 16 * WGP * 4);
        {
            const int kw = F.wave * 256, ntile = (rows_wg + 15) >> 4;
            pg8::bf16x8 bh[8], bl[8];
#pragma unroll
            for (int ks = 0; ks < 8; ++ks) { const f32x4 w0 = *(const LAS f32x4*)(wgT + fr * WGP + kw + 32 * ks + 8 * fq), w1 = *(const LAS f32x4*)(wgT + fr * WGP + kw + 32 * ks + 8 * fq + 4);
                const v4u h = (v4u){pk2(w0.x, w0.y), pk2(w0.z, w0.w), pk2(w1.x, w1.y), pk2(w1.z, w1.w)};
                const v4u l = (v4u){pk2(w0.x - bf_lo(h.x), w0.y - bf_hi(h.x)), pk2(w0.z - bf_lo(h.y), w0.w - bf_hi(h.y)), pk2(w1.x - bf_lo(h.z), w1.y - bf_hi(h.z)), pk2(w1.z - bf_lo(h.w), w1.w - bf_hi(h.w))};
                bh[ks] = __builtin_bit_cast(pg8::bf16x8, h); bl[ks] = __builtin_bit_cast(pg8::bf16x8, l); }
            __syncthreads();
            LAS f32x4* PS = (LAS f32x4*)F.lds;
            f32x4 xa[8][2];
            { const int row = fr < rows_wg ? fr : rows_wg - 1; const float* xp = xrow_ptr(F, F.vcu * rows_wg + row) + kw + 8 * fq;
#pragma unroll
              for (int ks = 0; ks < 8; ++ks) { xa[ks][0] = *(const f32x4*)(xp + 32 * ks); xa[ks][1] = *(const f32x4*)(xp + 32 * ks + 4); } }
            for (int rt = 0; rt < ntile; ++rt) {
                const int row = 16 * rt + fr; const bool valid = row < rows_wg; const int m = F.vcu * rows_wg + (valid ? row : rows_wg - 1);
                f32x4 xc[8][2];
#pragma unroll
                for (int ks = 0; ks < 8; ++ks) { xc[ks][0] = xa[ks][0]; xc[ks][1] = xa[ks][1]; }
                if (rt + 1 < ntile) { const int rown = 16 * (rt + 1) + fr; const float* xp = xrow_ptr(F, F.vcu * rows_wg + (rown < rows_wg ? rown : rows_wg - 1)) + kw + 8 * fq;
#pragma unroll
                    for (int ks = 0; ks < 8; ++ks) { xa[ks][0] = *(const f32x4*)(xp + 32 * ks); xa[ks][1] = *(const f32x4*)(xp + 32 * ks + 4); } }
                f32x4 acc = (f32x4){0.f, 0.f, 0.f, 0.f};
                bf16* xo = xb + (size_t)m * PK2 + kw + 8 * fq;
#pragma unroll
                for (int ks = 0; ks < 8; ++ks) { const f32x4 w0 = xc[ks][0], w1 = xc[ks][1];
                    const v4u h = (v4u){pk2(w0.x, w0.y), pk2(w0.z, w0.w), pk2(w1.x, w1.y), pk2(w1.z, w1.w)};
                    const v4u l = (v4u){pk2(w0.x - bf_lo(h.x), w0.y - bf_hi(h.x)), pk2(w0.z - bf_lo(h.y), w0.w - bf_hi(h.y)), pk2(w1.x - bf_lo(h.z), w1.y - bf_hi(h.z)), pk2(w1.z - bf_lo(h.w), w1.w - bf_hi(h.w))};
                    if (valid) *(v4u*)(xo + 32 * ks) = h;
                    const pg8::bf16x8 ah = __builtin_bit_cast(pg8::bf16x8, h), al = __builtin_bit_cast(pg8::bf16x8, l);
                    acc = __builtin_amdgcn_mfma_f32_16x16x32_bf16(ah, bh[ks], acc, 0, 0, 0);
                    acc = __builtin_amdgcn_mfma_f32_16x16x32_bf16(al, bh[ks], acc, 0, 0, 0);
                    acc = __builtin_amdgcn_mfma_f32_16x16x32_bf16(ah, bl[ks], acc, 0, 0, 0); }
                PS[(F.wave * ntile + rt) * 64 + lane] = acc;
            }
            __syncthreads();
            for (int idx = F.tid; idx < rows_wg * 16; idx += NTHR) { const int row = idx >> 4, r = idx & 15, rt = row >> 4, ml = row & 15; float t = 0.f;
#pragma unroll
                for (int w = 0; w < NWAVES; ++w) t += ((const LAS float*)(PS + (w * ntile + rt) * 64 + 16 * (ml >> 2) + r))[ml & 3];
                GT[row * 16 + r] = t; }
        }
        __syncthreads();
        LAS float* WG = (LAS float*)F.lds;
        LAS float* BG = WG + 16 * KD;
        for (int idx = F.tid; idx < 17 * KD / 4; idx += NTHR) *((LAS f32x4*)F.lds + idx) = (idx < 16 * KD / 4) ? *((const f32x4*)wgate + idx) : *((const f32x4*)bgate + (idx - 16 * KD / 4));
        __syncthreads();
        for (int rl = r_lo; rl < r_hi; ++rl) { const int m = F.vcu * rows_wg + rl;
            const f32x4 g0 = *(const LAS f32x4*)(GT + rl * 16), g1 = *(const LAS f32x4*)(GT + rl * 16 + 4), g2 = *(const LAS f32x4*)(GT + rl * 16 + 8), g3 = *(const LAS f32x4*)(GT + rl * 16 + 12);
            const float g[16] = {g0.x, g0.y, g0.z, g0.w, g1.x, g1.y, g1.z, g1.w, g2.x, g2.y, g2.z, g2.w, g3.x, g3.y, g3.z, g3.w};
#pragma unroll
            for (int j = 0; j < 4; ++j) { const int c0 = 4 * lane + 256 * j; f32x4 lg0 = *(const LAS f32x4*)(BG + c0);
#pragma unroll
                for (int r = 0; r < 16; ++r) { const f32x4 w = *(const LAS f32x4*)(WG + r * KD + c0); lg0 += w * g[r]; }
                f32x4 o;
                o.x = logsigmoid_fast(lg0.x) * 0.0625f; o.y = logsigmoid_fast(lg0.y) * 0.0625f; o.z = logsigmoid_fast(lg0.z) * 0.0625f; o.w = logsigmoid_fast(lg0.w) * 0.0625f; *(f32x4*)(loga + (size_t)m * KD + c0) = o;
                asm volatile("" ::: "memory"); }
        }
        __syncthreads();
    }
}

constexpr size_t IMG_QD = 0, IMG_KET = 32768, IMG_P = 65536, IMG_DV = 73728, IMG_BYTES = 74752;
constexpr int PP_QD = 0, PP_KI = 33792, PP_P = 67584, PP_RS = 76800;
constexpr int QD_PITCH = 528, T_PITCH = 144;
__device__ __forceinline__ pg8::bf16x8 as_bf16x8(v4u w) { return __builtin_bit_cast(pg8::bf16x8, w); }
__device__ __forceinline__ void gla_prep_item(Frame& F, int item) {
    const int n = item & 31, h = (item >> 5) & 3, b = item >> 7;
    const bf16* proj = (const bf16*)(F.ws + WS_PROJ); const float* loga = (const float*)(F.ws + WS_LOGA);
    unsigned char* img = F.ws + WS_IMG + (size_t)item * IMG_BYTES;
    LAS unsigned char* L = F.lds;
    const int tid = F.tid, lane = F.lane, w = F.wave, fr = lane & 15, fq = lane >> 4, cp = tid & 63, rg = tid >> 6;
    f32x4 lg[8]; v2u qr[8], kr[8];
    { const size_t R0 = (size_t)b * SEQ + (size_t)n * 64;
#pragma unroll
      for (int s = 0; s < 8; ++s) { const size_t row = R0 + 8 * rg + s;
          lg[s] = *(const f32x4*)(loga + row * KD + h * HK + 4 * cp); qr[s] = *(const v2u*)(proj + row * NPROJ + h * HK + 4 * cp); kr[s] = *(const v2u*)(proj + row * NPROJ + KD + h * HK + 4 * cp); } }
    __syncthreads();
    { f32x4 c = (f32x4){0.f, 0.f, 0.f, 0.f};
#pragma unroll
      for (int s = 0; s < 8; ++s) { c += lg[s]; lg[s] = c; }
      *((LAS f32x4*)(L + PP_RS) + rg * 64 + cp) = c; }
    __syncthreads();
    { f32x4 off = (f32x4){0.f, 0.f, 0.f, 0.f}, tot = (f32x4){0.f, 0.f, 0.f, 0.f};
#pragma unroll
      for (int r = 0; r < 8; ++r) { const f32x4 v = *((const LAS f32x4*)(L + PP_RS) + r * 64 + cp); tot += v; if (r < rg) off += v; }
      f32x4 ei; ei.x = __expf(-tot.x); ei.y = __expf(-tot.y); ei.z = __expf(-tot.z); ei.w = __expf(-tot.w);
      unsigned ke[4][4];
#pragma unroll
      for (int s2 = 0; s2 < 4; ++s2) { f32x4 kev[2]; unsigned qw[4];
#pragma unroll
          for (int u = 0; u < 2; ++u) { const int s = 2 * s2 + u; const f32x4 bb = off + lg[s], tb = tot - bb;
              f32x4 e1, e3; e1.x = __expf(bb.x); e1.y = __expf(bb.y); e1.z = __expf(bb.z); e1.w = __expf(bb.w); e3.x = __expf(tb.x); e3.y = __expf(tb.y); e3.z = __expf(tb.z); e3.w = __expf(tb.w);
              const f32x4 q4 = (f32x4){bf_lo(qr[s].x), bf_hi(qr[s].x), bf_lo(qr[s].y), bf_hi(qr[s].y)}, k4 = (f32x4){bf_lo(kr[s].x), bf_hi(kr[s].x), bf_lo(kr[s].y), bf_hi(kr[s].y)};
              const f32x4 qd = q4 * e1 * 0.0625f; kev[u] = k4 * e3; const f32x4 ki = kev[u] * ei;
              qw[2 * u] = pk2(qd.x, qd.y); qw[2 * u + 1] = pk2(qd.z, qd.w);
              *(LAS v2u*)(L + PP_QD + (8 * rg + s) * QD_PITCH + 8 * cp) = (v2u){qw[2 * u], qw[2 * u + 1]};
              *(LAS v2u*)(L + PP_KI + (8 * rg + s) * QD_PITCH + 8 * cp) = (v2u){pk2(ki.x, ki.y), pk2(ki.z, ki.w)}; }
          *((v4u*)(img + IMG_QD) + s2 * NTHR + tid) = (v4u){qw[0], qw[1], qw[2], qw[3]};
          ke[0][s2] = pk2(kev[0].x, kev[1].x); ke[1][s2] = pk2(kev[0].y, kev[1].y); ke[2][s2] = pk2(kev[0].z, kev[1].z); ke[3][s2] = pk2(kev[0].w, kev[1].w); }
#pragma unroll
      for (int c4 = 0; c4 < 4; ++c4) *((v4u*)(img + IMG_KET) + c4 * NTHR + tid) = (v4u){ke[c4][0], ke[c4][1], ke[c4][2], ke[c4][3]};
      if (rg == 0) { f32x4 dv; dv.x = __expf(tot.x); dv.y = __expf(tot.y); dv.z = __expf(tot.z); dv.w = __expf(tot.w); *((f32x4*)(img + IMG_DV) + cp) = dv; }
    }
    __syncthreads();
    { const int ttw = w >> 1, sp = w & 1;
      f32x4 sc0 = (f32x4){0.f, 0.f, 0.f, 0.f}, sc1 = (f32x4){0.f, 0.f, 0.f, 0.f};
      if (2 * sp <= ttw) {
#pragma unroll
          for (int ks = 0; ks < 8; ++ks) { const pg8::bf16x8 a = *(const LAS pg8::bf16x8*)(L + PP_QD + (16 * ttw + fr) * QD_PITCH + (32 * ks + 8 * fq) * 2);
              const pg8::bf16x8 b0 = *(const LAS pg8::bf16x8*)(L + PP_KI + (16 * (2 * sp) + fr) * QD_PITCH + (32 * ks + 8 * fq) * 2);
              sc0 = __builtin_amdgcn_mfma_f32_16x16x32_bf16(a, b0, sc0, 0, 0, 0);
              if (2 * sp + 1 <= ttw) { const pg8::bf16x8 b1 = *(const LAS pg8::bf16x8*)(L + PP_KI + (16 * (2 * sp + 1) + fr) * QD_PITCH + (32 * ks + 8 * fq) * 2);
                  sc1 = __builtin_amdgcn_mfma_f32_16x16x32_bf16(a, b1, sc1, 0, 0, 0); } } }
#pragma unroll
      for (int r = 0; r < 4; ++r) { const int tl = 4 * fq + r;
          float v0 = sc0[r], v1 = sc1[r];
          if (2 * sp > ttw || (2 * sp == ttw && fr > tl)) v0 = 0.f;
          if (2 * sp + 1 > ttw || (2 * sp + 1 == ttw && fr > tl)) v1 = 0.f;
          *(LAS unsigned short*)(L + PP_P + (16 * ttw + tl) * T_PITCH + (16 * (2 * sp) + fr) * 2) = (unsigned short)(pk2(v0, 0.f) & 0xffffu);
          *(LAS unsigned short*)(L + PP_P + (16 * ttw + tl) * T_PITCH + (16 * (2 * sp + 1) + fr) * 2) = (unsigned short)(pk2(v1, 0.f) & 0xffffu); } }
    __syncthreads();
    *((v4u*)(img + IMG_P) + tid) = *(const LAS v4u*)(L + PP_P + (tid >> 3) * T_PITCH + (tid & 7) * 16);
}
__device__ __forceinline__ void p2a_gla_prep(Frame& F) {
    for (int it = F.vcu; it < NB * NH * (SEQ / 64); it += F.G) gla_prep_item(F, it);
    __syncthreads();
}
constexpr int SC_QD = 0, SC_KET = 33792, SC_VT = 70656, SC_P = 79872, SC_DV = 89088, SC_OX = 90112, SC_END = 106496;
static_assert(SC_END <= MISC_OFF && PP_RS + 8192 <= MISC_OFF, "GLA LDS maps");
__device__ __forceinline__ void gla_prompt_item(Frame& F, int item) {
    const int j = item & 7, h = (item >> 3) & 3, b = item >> 5;
    const bf16* proj = (const bf16*)(F.ws + WS_PROJ); bf16* O = (bf16*)(F.ws + WS_O);
    const unsigned char* img0 = F.ws + WS_IMG + (size_t)((b * NH + h) * (SEQ / 64)) * IMG_BYTES;
    LAS unsigned char* L = F.lds;
    const int tid = F.tid, lane = F.lane, w = F.wave, fr = lane & 15, fq = lane >> 4, cp = tid & 63, rg = tid >> 6;
    const int kh = w >> 2, vt = w & 3;
    f32x4 S[8];
#pragma unroll
    for (int i = 0; i < 8; ++i) S[i] = (f32x4){0.f, 0.f, 0.f, 0.f};
    v4u qdA[4], keA[4], ppA, vrA, qdB[4], keB[4], ppB, vrB; f32x4 dvA = (f32x4){0.f, 0.f, 0.f, 0.f}, dvB = (f32x4){0.f, 0.f, 0.f, 0.f};
#define SC_LOAD(n_, QD_, KE_, PP_, DV_, VR_) do { const unsigned char* im_ = img0 + (size_t)(n_) * IMG_BYTES; \
        _Pragma("unroll") for (int i_ = 0; i_ < 4; ++i_) { QD_[i_] = *((const v4u*)(im_ + IMG_QD) + i_ * NTHR + tid); KE_[i_] = *((const v4u*)(im_ + IMG_KET) + i_ * NTHR + tid); } \
        PP_ = *((const v4u*)(im_ + IMG_P) + tid); if (rg == 0) DV_ = *((const f32x4*)(im_ + IMG_DV) + cp); \
        VR_ = *(const v4u*)(proj + ((size_t)b * SEQ + (size_t)(n_) * 64 + lane) * NPROJ + 2 * KD + h * HV + j * 64 + 8 * w); } while (0)
    SC_LOAD(0, qdA, keA, ppA, dvA, vrA);
    SC_LOAD(1, qdB, keB, ppB, dvB, vrB);
    __syncthreads();
    for (int n = 0; n < SEQ / 64; n += 2) {
#pragma unroll
        for (int s2 = 0; s2 < 4; ++s2) { *(LAS v2u*)(L + SC_QD + (8 * rg + 2 * s2) * QD_PITCH + 8 * cp) = (v2u){qdA[s2].x, qdA[s2].y}; *(LAS v2u*)(L + SC_QD + (8 * rg + 2 * s2 + 1) * QD_PITCH + 8 * cp) = (v2u){qdA[s2].z, qdA[s2].w}; }
#pragma unroll
        for (int c4 = 0; c4 < 4; ++c4) *(LAS v4u*)(L + SC_KET + (4 * cp + c4) * T_PITCH + 16 * rg) = keA[c4];
        *(LAS v4u*)(L + SC_P + (tid >> 3) * T_PITCH + (tid & 7) * 16) = ppA;
        if (rg == 0) *((LAS f32x4*)(L + SC_DV) + cp) = dvA;
        { LAS unsigned short* col = (LAS unsigned short*)(L + SC_VT + (8 * w) * T_PITCH + 2 * lane);
          col[0 * (T_PITCH / 2)] = (unsigned short)(vrA.x & 0xffffu); col[1 * (T_PITCH / 2)] = (unsigned short)(vrA.x >> 16); col[2 * (T_PITCH / 2)] = (unsigned short)(vrA.y & 0xffffu); col[3 * (T_PITCH / 2)] = (unsigned short)(vrA.y >> 16);
          col[4 * (T_PITCH / 2)] = (unsigned short)(vrA.z & 0xffffu); col[5 * (T_PITCH / 2)] = (unsigned short)(vrA.z >> 16); col[6 * (T_PITCH / 2)] = (unsigned short)(vrA.w & 0xffffu); col[7 * (T_PITCH / 2)] = (unsigned short)(vrA.w >> 16); }
        if ((n) + 2 < SEQ / 64) SC_LOAD((n) + 2, qdA, keA, ppA, dvA, vrA);
        __syncthreads();
        { f32x4 Oa[4];
#pragma unroll
        for (int tt = 0; tt < 4; ++tt) Oa[tt] = (f32x4){0.f, 0.f, 0.f, 0.f};
#pragma unroll
        for (int ks = 0; ks < 4; ++ks) {
            const pg8::bf16x8 Bv = as_bf16x8((v4u){pk2(S[2 * ks][0], S[2 * ks][1]), pk2(S[2 * ks][2], S[2 * ks][3]), pk2(S[2 * ks + 1][0], S[2 * ks + 1][1]), pk2(S[2 * ks + 1][2], S[2 * ks + 1][3])});
#pragma unroll
            for (int tt = 0; tt < 4; ++tt) { const v2u lo = *(const LAS v2u*)(L + SC_QD + (16 * tt + fr) * QD_PITCH + (128 * kh + 32 * ks + 4 * fq) * 2), hi = *(const LAS v2u*)(L + SC_QD + (16 * tt + fr) * QD_PITCH + (128 * kh + 32 * ks + 16 + 4 * fq) * 2);
                Oa[tt] = __builtin_amdgcn_mfma_f32_16x16x32_bf16(as_bf16x8((v4u){lo.x, lo.y, hi.x, hi.y}), Bv, Oa[tt], 0, 0, 0); } }
        if (kh == 1) {
#pragma unroll
            for (int tt = 0; tt < 4; ++tt)
#pragma unroll
                for (int r = 0; r < 4; ++r) *(LAS float*)(L + SC_OX + ((vt * 64 + 16 * tt + 4 * fq + r) * 16 + fr) * 4) = Oa[tt][r]; }
        __syncthreads();
        pg8::bf16x8 Vb[2];
#pragma unroll
        for (int k2 = 0; k2 < 2; ++k2) Vb[k2] = *(const LAS pg8::bf16x8*)(L + SC_VT + (16 * vt + fr) * T_PITCH + (32 * k2 + 8 * fq) * 2);
        if (kh == 0) {
#pragma unroll
            for (int tt = 0; tt < 4; ++tt) {
#pragma unroll
                for (int r = 0; r < 4; ++r) Oa[tt][r] += *(const LAS float*)(L + SC_OX + ((vt * 64 + 16 * tt + 4 * fq + r) * 16 + fr) * 4);
#pragma unroll
                for (int k2 = 0; k2 < 2; ++k2) { if (32 * k2 > 16 * tt + 15) continue;
                    const pg8::bf16x8 a = *(const LAS pg8::bf16x8*)(L + SC_P + (16 * tt + fr) * T_PITCH + (32 * k2 + 8 * fq) * 2);
                    Oa[tt] = __builtin_amdgcn_mfma_f32_16x16x32_bf16(a, Vb[k2], Oa[tt], 0, 0, 0); } }
            bf16* op = O + ((size_t)b * SEQ + (size_t)(n) * 64 + 4 * fq) * DM + h * HV + j * 64 + 16 * vt + fr;
#pragma unroll
            for (int tt = 0; tt < 4; ++tt)
#pragma unroll
                for (int r = 0; r < 4; ++r) op[(size_t)(16 * tt + r) * DM] = (bf16)(pk2(Oa[tt][r], 0.f) & 0xffffu); }
#pragma unroll
        for (int kt = 0; kt < 8; ++kt) { const f32x4 d4 = *(const LAS f32x4*)(L + SC_DV + (128 * kh + 16 * kt + 4 * fq) * 4); S[kt] = S[kt] * d4;
#pragma unroll
            for (int k2 = 0; k2 < 2; ++k2) { const pg8::bf16x8 a = *(const LAS pg8::bf16x8*)(L + SC_KET + (128 * kh + 16 * kt + fr) * T_PITCH + (32 * k2 + 8 * fq) * 2);
                S[kt] = __builtin_amdgcn_mfma_f32_16x16x32_bf16(a, Vb[k2], S[kt], 0, 0, 0); } }
        }
        __syncthreads();
#pragma unroll
        for (int s2 = 0; s2 < 4; ++s2) { *(LAS v2u*)(L + SC_QD + (8 * rg + 2 * s2) * QD_PITCH + 8 * cp) = (v2u){qdB[s2].x, qdB[s2].y}; *(LAS v2u*)(L + SC_QD + (8 * rg + 2 * s2 + 1) * QD_PITCH + 8 * cp) = (v2u){qdB[s2].z, qdB[s2].w}; }
#pragma unroll
        for (int c4 = 0; c4 < 4; ++c4) *(LAS v4u*)(L + SC_KET + (4 * cp + c4) * T_PITCH + 16 * rg) = keB[c4];
        *(LAS v4u*)(L + SC_P + (tid >> 3) * T_PITCH + (tid & 7) * 16) = ppB;
        if (rg == 0) *((LAS f32x4*)(L + SC_DV) + cp) = dvB;
        { LAS unsigned short* col = (LAS unsigned short*)(L + SC_VT + (8 * w) * T_PITCH + 2 * lane);
          col[0 * (T_PITCH / 2)] = (unsigned short)(vrB.x & 0xffffu); col[1 * (T_PITCH / 2)] = (unsigned short)(vrB.x >> 16); col[2 * (T_PITCH / 2)] = (unsigned short)(vrB.y & 0xffffu); col[3 * (T_PITCH / 2)] = (unsigned short)(vrB.y >> 16);
          col[4 * (T_PITCH / 2)] = (unsigned short)(vrB.z & 0xffffu); col[5 * (T_PITCH / 2)] = (unsigned short)(vrB.z >> 16); col[6 * (T_PITCH / 2)] = (unsigned short)(vrB.w & 0xffffu); col[7 * (T_PITCH / 2)] = (unsigned short)(vrB.w >> 16); }
        if ((n + 1) + 2 < SEQ / 64) SC_LOAD((n + 1) + 2, qdB, keB, ppB, dvB, vrB);
        __syncthreads();
        { f32x4 Oa[4];
#pragma unroll
        for (int tt = 0; tt < 4; ++tt) Oa[tt] = (f32x4){0.f, 0.f, 0.f, 0.f};
#pragma unroll
        for (int ks = 0; ks < 4; ++ks) {
            const pg8::bf16x8 Bv = as_bf16x8((v4u){pk2(S[2 * ks][0], S[2 * ks][1]), pk2(S[2 * ks][2], S[2 * ks][3]), pk2(S[2 * ks + 1][0], S[2 * ks + 1][1]), pk2(S[2 * ks + 1][2], S[2 * ks + 1][3])});
#pragma unroll
            for (int tt = 0; tt < 4; ++tt) { const v2u lo = *(const LAS v2u*)(L + SC_QD + (16 * tt + fr) * QD_PITCH + (128 * kh + 32 * ks + 4 * fq) * 2), hi = *(const LAS v2u*)(L + SC_QD + (16 * tt + fr) * QD_PITCH + (128 * kh + 32 * ks + 16 + 4 * fq) * 2);
                Oa[tt] = __builtin_amdgcn_mfma_f32_16x16x32_bf16(as_bf16x8((v4u){lo.x, lo.y, hi.x, hi.y}), Bv, Oa[tt], 0, 0, 0); } }
        if (kh == 1) {
#pragma unroll
            for (int tt = 0; tt < 4; ++tt)
#pragma unroll
                for (int r = 0; r < 4; ++r) *(LAS float*)(L + SC_OX + ((vt * 64 + 16 * tt + 4 * fq + r) * 16 + fr) * 4) = Oa[tt][r]; }
        __syncthreads();
        pg8::bf16x8 Vb[2];
#pragma unroll
        for (int k2 = 0; k2 < 2; ++k2) Vb[k2] = *(const LAS pg8::bf16x8*)(L + SC_VT + (16 * vt + fr) * T_PITCH + (32 * k2 + 8 * fq) * 2);
        if (kh == 0) {
#pragma unroll
            for (int tt = 0; tt < 4; ++tt) {
#pragma unroll
                for (int r = 0; r < 4; ++r) Oa[tt][r] += *(const LAS float*)(L + SC_OX + ((vt * 64 + 16 * tt + 4 * fq + r) * 16 + fr) * 4);
#pragma unroll
                for (int k2 = 0; k2 < 2; ++k2) { if (32 * k2 > 16 * tt + 15) continue;
                    const pg8::bf16x8 a = *(const LAS pg8::bf16x8*)(L + SC_P + (16 * tt + fr) * T_PITCH + (32 * k2 + 8 * fq) * 2);
                    Oa[tt] = __builtin_amdgcn_mfma_f32_16x16x32_bf16(a, Vb[k2], Oa[tt], 0, 0, 0); } }
            bf16* op = O + ((size_t)b * SEQ + (size_t)(n + 1) * 64 + 4 * fq) * DM + h * HV + j * 64 + 16 * vt + fr;
#pragma unroll
            for (int tt = 0; tt < 4; ++tt)
#pragma unroll
                for (int r = 0; r < 4; ++r) op[(size_t)(16 * tt + r) * DM] = (bf16)(pk2(Oa[tt][r], 0.f) & 0xffffu); }
#pragma unroll
        for (int kt = 0; kt < 8; ++kt) { const f32x4 d4 = *(const LAS f32x4*)(L + SC_DV + (128 * kh + 16 * kt + 4 * fq) * 4); S[kt] = S[kt] * d4;
#pragma unroll
            for (int k2 = 0; k2 < 2; ++k2) { const pg8::bf16x8 a = *(const LAS pg8::bf16x8*)(L + SC_KET + (128 * kh + 16 * kt + fr) * T_PITCH + (32 * k2 + 8 * fq) * 2);
                S[kt] = __builtin_amdgcn_mfma_f32_16x16x32_bf16(a, Vb[k2], S[kt], 0, 0, 0); } }
        }
        __syncthreads();
    }
#undef SC_LOAD
    { float* SP = F.out + OUT_SP + ((size_t)(b * NH + h) * HK + 128 * kh + 4 * fq) * HV + j * 64 + 16 * vt + fr;
#pragma unroll
      for (int kt = 0; kt < 8; ++kt)
#pragma unroll
          for (int r = 0; r < 4; ++r) SP[(size_t)(16 * kt + r) * HV] = S[kt][r]; }
}
__device__ __forceinline__ void gla_sample_item(Frame& F, int item) {
    const int h = item & 3, b = item >> 2;
    const bf16* proj = (const bf16*)(F.ws + WS_PROJ); const float* loga = (const float*)(F.ws + WS_LOGA); bf16* O = (bf16*)(F.ws + WS_O);
    LAS float* AT = (LAS float*)F.lds;
    LAS float* KT = AT + 256 * 8;
    LAS float* QT = KT + 256 * 8;
    LAS float* VV = QT + 256 * 8;
    LAS float* RED = VV + 8 * 512;
    const size_t r0 = (size_t)MP + (size_t)b * DT;
    const int c4 = F.tid & 127, kg = F.tid >> 7;
    const f32x4* S0 = (const f32x4*)(F.in[2] + (size_t)(b * NH + h) * HK * HV) + c4;
    f32x4* S1 = (f32x4*)(F.out + OUT_SS + (size_t)(b * NH + h) * HK * HV) + c4;
    f32x4 s[8];
#pragma unroll
    for (int u = 0; u < 8; ++u) s[u] = __builtin_nontemporal_load(S0 + (size_t)(kg * 64 + u) * 128);
    for (int idx = F.tid; idx < 8 * 256; idx += NTHR) { const int t = idx >> 8, k = idx & 255; const size_t row = r0 + t;
        AT[k * 8 + t] = __expf(loga[row * KD + h * HK + k]); KT[k * 8 + t] = bf2f(proj[row * NPROJ + KD + h * HK + k]); QT[k * 8 + t] = bf2f(proj[row * NPROJ + h * HK + k]) * 0.0625f; }
    for (int idx = F.tid; idx < 8 * 512; idx += NTHR) { const int t = idx >> 9, v = idx & 511; VV[idx] = bf2f(proj[(r0 + t) * NPROJ + 2 * KD + h * HV + v]); }
    __syncthreads();
    f32x4 vv[8], oa[8];
#pragma unroll
    for (int t = 0; t < 8; ++t) { vv[t] = *(const LAS f32x4*)(VV + t * 512 + 4 * c4); oa[t] = (f32x4){0.f, 0.f, 0.f, 0.f}; }
#define GLA_S_ROW(u_, k_, REFILL) do { const int k = (k_); \
            const f32x4 a0 = *(const LAS f32x4*)(AT + k * 8), a1 = *(const LAS f32x4*)(AT + k * 8 + 4), k0 = *(const LAS f32x4*)(KT + k * 8), k1 = *(const LAS f32x4*)(KT + k * 8 + 4), q0 = *(const LAS f32x4*)(QT + k * 8), q1 = *(const LAS f32x4*)(QT + k * 8 + 4); \
            f32x4 x = s[u_]; \
            x = x * a0.x + vv[0] * k0.x; oa[0] += x * q0.x; \
            x = x * a0.y + vv[1] * k0.y; oa[1] += x * q0.y; \
            x = x * a0.z + vv[2] * k0.z; oa[2] += x * q0.z; \
            x = x * a0.w + vv[3] * k0.w; oa[3] += x * q0.w; \
            x = x * a1.x + vv[4] * k1.x; oa[4] += x * q1.x; \
            x = x * a1.y + vv[5] * k1.y; oa[5] += x * q1.y; \
            x = x * a1.z + vv[6] * k1.z; oa[6] += x * q1.z; \
            x = x * a1.w + vv[7] * k1.w; oa[7] += x * q1.w; \
            __builtin_nontemporal_store(x, S1 + (size_t)k * 128); \
            if (REFILL) s[u_] = __builtin_nontemporal_load(S0 + (size_t)(k + 8) * 128); \
            asm volatile("" ::: "memory"); } while (0)
#pragma unroll 1
    for (int kb = 0; kb < 56; kb += 8) {
#pragma unroll
        for (int u = 0; u < 8; ++u) GLA_S_ROW(u, kg * 64 + kb + u, true);
    }
#pragma unroll
    for (int u = 0; u < 8; ++u) GLA_S_ROW(u, kg * 64 + 56 + u, false);
#undef GLA_S_ROW
#pragma unroll
    for (int t = 0; t < 8; ++t) *(LAS f32x4*)(RED + (kg * 8 + t) * 512 + 4 * c4) = oa[t];
    __syncthreads();
    for (int idx = F.tid; idx < 8 * 128; idx += NTHR) { const int t = idx >> 7, c = idx & 127;
        const f32x4 r = *(const LAS f32x4*)(RED + (0 * 8 + t) * 512 + 4 * c) + *(const LAS f32x4*)(RED + (1 * 8 + t) * 512 + 4 * c) + *(const LAS f32x4*)(RED + (2 * 8 + t) * 512 + 4 * c) + *(const LAS f32x4*)(RED + (3 * 8 + t) * 512 + 4 * c);
        v2u rb; rb.x = pk2(r.x, r.y); rb.y = pk2(r.z, r.w); *(v2u*)(O + (r0 + t) * DM + h * HV + 4 * c) = rb; }
    __syncthreads();
}
__device__ __forceinline__ void p2_gla(Frame& F, int qslot) {
    constexpr int NPI = NB * NH * 8, NSI = DB * NH;
    if ((int)blockIdx.x < NPI) { const int x = (int)blockIdx.x & 7, m = (int)blockIdx.x >> 3;
        gla_prompt_item(F, ((2 * x + (m & 1)) << 3) | (m >> 1));
        __syncthreads();
        pg9::Gemm g{(const bf16*)(F.ws + WS_XB), (const bf16*)(F.ws + WS_WIN) + (size_t)NQKV * PK2, M, NPROJ - NQKV, DM, PK2, PK2};
        pg9::ListOrder S{(int)blockIdx.x, NPI, (M / pg9::BMR) * ((NPROJ - NQKV) / pg9::BNC), M / pg9::BMR};
        pg9::EpiBf16<0> E{(bf16*)(F.ws + WS_PROJ) + NQKV, NPROJ, nullptr};
        pg9::gemm_phase<pg9::EpiBf16<0>, true, pg9::ListOrder>(F.lds, g, S, E);
        __syncthreads(); }
    for (;;) {
        __syncthreads();
        if (F.tid == 0) F.MISC[16] = __hip_atomic_fetch_add(F.ctl + CW_QUEUE + 64 * qslot, 1u, RLX_AGENT);
        __syncthreads();
        const int it = (int)F.MISC[16];
        if (it >= NSI + DT_NCHUNK) break;
        if (it < NSI) gla_sample_item(F, it); else deferred_transpose_chunk(F, it - NSI);
    }
    __syncthreads();
}

__device__ __forceinline__ void gate_rows(Frame& F, int row_lo, int nrows) {
    const bf16* O = (const bf16*)(F.ws + WS_O); const bf16* proj = (const bf16*)(F.ws + WS_PROJ); bf16* A2 = (bf16*)(F.ws + WS_A2); const float* ng = F.in[6];
    const int lane = F.lane; const bool b5 = lane & 32, b4 = lane & 16;
    f32x4 g4[8];
#pragma unroll
    for (int i = 0; i < 8; ++i) g4[i] = *((const f32x4*)ng + lane + 64 * i);
    const int r_lo = (F.wave * nrows) / NWAVES, r_hi = ((F.wave + 1) * nrows) / NWAVES;
    for (int rr = r_lo; rr < r_hi; rr += 2) {
        v2u ow[2][8], rw[2][8];
#pragma unroll
        for (int q = 0; q < 2; ++q) { const int m = row_lo + ((rr + q < r_hi) ? rr + q : r_hi - 1);
#pragma unroll
            for (int i = 0; i < 8; ++i) { ow[q][i] = *((const v2u*)(O + (size_t)m * DM) + lane + 64 * i); rw[q][i] = *((const v2u*)(proj + (size_t)m * NPROJ + 2 * KD + 2048) + lane + 64 * i); } }
#pragma unroll
        for (int q = 0; q < 2; ++q) { const int m = row_lo + ((rr + q < r_hi) ? rr + q : r_hi - 1);
            f32x4 v[8]; float hs[4];
#pragma unroll
            for (int i = 0; i < 8; ++i) v[i] = (f32x4){bf_lo(ow[q][i].x), bf_hi(ow[q][i].x), bf_lo(ow[q][i].y), bf_hi(ow[q][i].y)};
#pragma unroll
            for (int h = 0; h < 4; ++h) { const f32x4 a = v[2 * h], c = v[2 * h + 1]; hs[h] = (a.x * a.x + a.y * a.y) + (a.z * a.z + a.w * a.w) + (c.x * c.x + c.y * c.y) + (c.z * c.z + c.w * c.w); }
            float t2[2], t1;
#pragma unroll
            for (int i = 0; i < 2; ++i) { const float keep = b5 ? hs[i + 2] : hs[i], send = b5 ? hs[i] : hs[i + 2]; t2[i] = keep + __shfl_xor(send, 32); }
            { const float keep = b4 ? t2[1] : t2[0], send = b4 ? t2[0] : t2[1]; t1 = keep + __shfl_xor(send, 16); }
            t1 += __shfl_xor(t1, 8); t1 += __shfl_xor(t1, 4); t1 += __shfl_xor(t1, 2); t1 += __shfl_xor(t1, 1);
            float ss[4];
#pragma unroll
            for (int h = 0; h < 4; ++h) ss[h] = 1.0f / sqrtf(__int_as_float(__builtin_amdgcn_readlane(__float_as_int(t1), 16 * (h & 1) + 32 * (h >> 1))) * (1.0f / HV) + HN_EPS);
            v2u* o8 = (v2u*)(A2 + (size_t)m * PK2) + lane;
#pragma unroll
            for (int i = 0; i < 8; ++i) { const v2u rwv = rw[q][i];
                const float r0 = bf_lo(rwv.x), r1 = bf_hi(rwv.x), r2 = bf_lo(rwv.y), r3 = bf_hi(rwv.y); const float sc = ss[i >> 1];
                const float y0 = v[i].x * sc * g4[i].x * (r0 / (1.f + __expf(-r0))), y1 = v[i].y * sc * g4[i].y * (r1 / (1.f + __expf(-r1))), y2 = v[i].z * sc * g4[i].z * (r2 / (1.f + __expf(-r2))), y3 = v[i].w * sc * g4[i].w * (r3 / (1.f + __expf(-r3)));
                __hip_atomic_store((unsigned long long*)(o8 + 64 * i), ((unsigned long long)pk2(y2, y3) << 32) | pk2(y0, y1), RLX_AGENT); } }
    }
}
__device__ __forceinline__ void gate_panel_and_wait(Frame& F, int pm, int pn, unsigned* cnt) {
    gate_rows(F, pm * 288 + pn * 36, 36);
    asm volatile("s_waitcnt vmcnt(0)" ::: "memory");
    __syncthreads();
    if (F.tid == 0) {
        __hip_atomic_fetch_add(cnt + 64 * pm, 1u, RLX_AGENT);
        unsigned sp = 0u;
        while (__hip_atomic_load(cnt + 64 * pm, RLX_AGENT) < 8u) { __builtin_amdgcn_s_sleep(2); if (++sp > (1u << 22)) { __hip_atomic_store(F.ctl + CW_TMO, 1u, RLX_AGENT); break; } }
        __builtin_amdgcn_fence(__ATOMIC_ACQUIRE, "agent");
        asm volatile("s_waitcnt vmcnt(0)" ::: "memory");
    }
    __syncthreads();
}

__device__ __forceinline__ void ln_rows(Frame& F, const float* in, const float* gam, const float* bet, float* outf, bf16* outb) {
    const int gw = F.vcu * NWAVES + F.wave, NGW = F.G * NWAVES;
    for (int m = gw; m < M; m += NGW) {
        const f32x4* xr = (const f32x4*)(in + (size_t)m * DM) + F.lane;
        f32x4 v[8]; float s = 0.f;
#pragma unroll
        for (int i = 0; i < 8; ++i) { v[i] = xr[64 * i]; s += (v[i].x + v[i].y) + (v[i].z + v[i].w); }
        const float mean = wave_sum(s) * (1.f / DM); float s2 = 0.f;
#pragma unroll
        for (int i = 0; i < 8; ++i) { v[i] = v[i] - mean; s2 += (v[i].x * v[i].x + v[i].y * v[i].y) + (v[i].z * v[i].z + v[i].w * v[i].w); }
        const float rstd = 1.f / sqrtf(wave_sum(s2) * (1.f / DM) + LN_EPS);
#pragma unroll
        for (int i = 0; i < 8; ++i) { const f32x4 g4 = *((const f32x4*)gam + F.lane + 64 * i), b4 = *((const f32x4*)bet + F.lane + 64 * i); const f32x4 y = v[i] * rstd * g4 + b4;
            if (outf) *((f32x4*)(outf + (size_t)m * DM) + F.lane + 64 * i) = y;
            if (outb) { v2u w; w.x = pk2(y.x, y.y); w.y = pk2(y.z, y.w); *((v2u*)(outb + (size_t)m * DM) + F.lane + 64 * i) = w; } }
    }
}
__device__ __forceinline__ void p10_vln(Frame& F) {
    const int gw = F.vcu * NWAVES + F.wave, NGW = F.G * NWAVES;
    const bf16* Z = (const bf16*)(F.ws + WS_Z); bf16* VN = (bf16*)(F.ws + WS_VN); const float* gam = F.in[10]; const float* bet = F.in[11];
    for (int m = gw; m < M; m += NGW) {
        const v2u* zr = (const v2u*)(Z + (size_t)m * (2 * SGW) + SGW) + F.lane;
        f32x4 v[8]; float s = 0.f;
#pragma unroll
        for (int i = 0; i < 8; ++i) { const v2u w = zr[64 * i]; v[i] = (f32x4){bf_lo(w.x), bf_hi(w.x), bf_lo(w.y), bf_hi(w.y)}; s += (v[i].x + v[i].y) + (v[i].z + v[i].w); }
        const float mean = wave_sum(s) * (1.f / SGW); float s2 = 0.f;
#pragma unroll
        for (int i = 0; i < 8; ++i) { v[i] = v[i] - mean; s2 += (v[i].x * v[i].x + v[i].y * v[i].y) + (v[i].z * v[i].z + v[i].w * v[i].w); }
        const float rstd = 1.f / sqrtf(wave_sum(s2) * (1.f / SGW) + LN_EPS);
#pragma unroll
        for (int i = 0; i < 8; ++i) { const f32x4 g4 = *((const f32x4*)gam + F.lane + 64 * i), b4 = *((const f32x4*)bet + F.lane + 64 * i); const f32x4 y = v[i] * rstd * g4 + b4;
            if (m >= MP) *((f32x4*)(F.out + OUT_SGV + (size_t)(m - MP) * SGW) + F.lane + 64 * i) = y;
            v2u w; w.x = pk2(y.x, y.y); w.y = pk2(y.z, y.w); *((v2u*)(VN + (size_t)m * SGW) + F.lane + 64 * i) = w; }
    }
}

constexpr int MIX_PITCH = 272;
__device__ __forceinline__ void mix_prompt_item(Frame& F, int item, bool load_w) {
    const int g = item & 7, ci = item >> 3; const int R0 = ci * SGC;
    const bf16* Z = (const bf16*)(F.ws + WS_Z); const bf16* Wc = (const bf16*)(F.ws + WS_WC); bf16* A2 = (bf16*)(F.ws + WS_A2); const float* stat = (const float*)(F.ws + WS_STAT);
    LAS unsigned char* WL = F.lds;
    LAS unsigned char* VT = F.lds + 128 * MIX_PITCH;
    LAS float* RS = (LAS float*)(F.lds + 128 * MIX_PITCH + 256 * MIX_PITCH);
    const int s_lo = F.lane >> 3, ch_lo = F.lane & 7;
    float sm = 0.f, sq = 0.f; v4u wq[4];
    if (F.tid < SGC) { sm = stat[2 * (size_t)(R0 + F.tid)]; sq = stat[2 * (size_t)(R0 + F.tid) + 1]; }
    if (load_w) {
#pragma unroll
        for (int i = 0; i < 4; ++i) { const int idx = F.tid + NTHR * i, t = idx >> 4, ch = idx & 15; wq[i] = *(const v4u*)(Wc + ((size_t)(g * SGC + t)) * SGC + ch * 8); } }
    v4u vr[8];
#pragma unroll
    for (int i = 0; i < 8; ++i) { const int s = 8 * (F.wave + 8 * (i & 1)) + s_lo, ch = 8 * (i >> 1) + ch_lo;
        vr[i] = *(const v4u*)(Z + (size_t)(R0 + s) * (2 * SGW) + SGW + g * SGD + ch * 8); }
    __syncthreads();
    if (F.tid < SGC) { const float mean = sm * (1.f / SGW), var = fmaxf(sq * (1.f / SGW) - mean * mean, 0.f);
        RS[2 * F.tid] = mean; RS[2 * F.tid + 1] = 1.f / sqrtf(var + LN_EPS); }
    if (load_w) {
#pragma unroll
        for (int i = 0; i < 4; ++i) { const int idx = F.tid + NTHR * i, t = idx >> 4, ch = idx & 15; *(LAS v4u*)(WL + t * MIX_PITCH + ch * 16) = wq[i]; } }
    __syncthreads();
#pragma unroll
    for (int i = 0; i < 8; ++i) { const int sh = F.wave + 8 * (i & 1), s = 8 * sh + s_lo, ch = 8 * (i >> 1) + ch_lo; const v4u w = vr[i];
        const float mean = RS[2 * s], rstd = RS[2 * s + 1];
        const f32x4 ga = *(const f32x4*)(F.in[10] + g * SGD + ch * 8), gb = *(const f32x4*)(F.in[10] + g * SGD + ch * 8 + 4), ba = *(const f32x4*)(F.in[11] + g * SGD + ch * 8), bb = *(const f32x4*)(F.in[11] + g * SGD + ch * 8 + 4);
        LAS unsigned short* col = (LAS unsigned short*)(VT + (size_t)(8 * ch) * MIX_PITCH + 16 * (sh ^ ch_lo) + 2 * s_lo);
        col[0 * (MIX_PITCH / 2)] = (unsigned short)(pk2((bf_lo(w.x) - mean) * rstd * ga.x + ba.x, 0.f) & 0xffffu); col[1 * (MIX_PITCH / 2)] = (unsigned short)(pk2((bf_hi(w.x) - mean) * rstd * ga.y + ba.y, 0.f) & 0xffffu);
        col[2 * (MIX_PITCH / 2)] = (unsigned short)(pk2((bf_lo(w.y) - mean) * rstd * ga.z + ba.z, 0.f) & 0xffffu); col[3 * (MIX_PITCH / 2)] = (unsigned short)(pk2((bf_hi(w.y) - mean) * rstd * ga.w + ba.w, 0.f) & 0xffffu);
        col[4 * (MIX_PITCH / 2)] = (unsigned short)(pk2((bf_lo(w.z) - mean) * rstd * gb.x + bb.x, 0.f) & 0xffffu); col[5 * (MIX_PITCH / 2)] = (unsigned short)(pk2((bf_hi(w.z) - mean) * rstd * gb.y + bb.y, 0.f) & 0xffffu);
        col[6 * (MIX_PITCH / 2)] = (unsigned short)(pk2((bf_lo(w.w) - mean) * rstd * gb.z + bb.z, 0.f) & 0xffffu); col[7 * (MIX_PITCH / 2)] = (unsigned short)(pk2((bf_hi(w.w) - mean) * rstd * gb.w + bb.w, 0.f) & 0xffffu); }
    __syncthreads();
    const int dg = F.wave & 3, th = F.wave >> 2, fr = F.lane & 15, fq = F.lane >> 4;
    f32x4 acc[4][4];
#pragma unroll
    for (int a = 0; a < 4; ++a)
#pragma unroll
        for (int j = 0; j < 4; ++j) acc[a][j] = (f32x4){0.f, 0.f, 0.f, 0.f};
#pragma unroll
    for (int ks = 0; ks < 4; ++ks) {
        bf16x8 af[4];
#pragma unroll
        for (int j = 0; j < 4; ++j) { const int d = 64 * dg + 16 * (fr >> 2) + 4 * j + (fr & 3);
            af[j] = *(const LAS bf16x8*)(VT + (size_t)d * MIX_PITCH + 16 * ((4 * ks + fq) ^ ((d >> 3) & 7))); }
#pragma unroll
        for (int a = 0; a < 4; ++a) { const int tt = th + 2 * a; if (2 * ks > tt) continue;
            const bf16x8 bw = *(const LAS bf16x8*)(WL + (size_t)(16 * tt + fr) * MIX_PITCH + (32 * ks + 8 * fq) * 2);
#pragma unroll
            for (int j = 0; j < 4; ++j) acc[a][j] = __builtin_amdgcn_mfma_f32_16x16x32_bf16(af[j], bw, acc[a][j], 0, 0, 0); }
    }
    const float* bsp = F.in[13] + g * SGC;
#pragma unroll
    for (int a = 0; a < 4; ++a) { const int t = 16 * (th + 2 * a) + fr; const float bb = bsp[t]; const size_t row = (size_t)R0 + t; const int col = g * SGD + 64 * dg + 16 * fq;
        const v4u u0 = *(const v4u*)(Z + row * (2 * SGW) + col), u1 = *(const v4u*)(Z + row * (2 * SGW) + col + 8);
        const f32x4 m0 = acc[a][0] + bb, m1 = acc[a][1] + bb, m2 = acc[a][2] + bb, m3 = acc[a][3] + bb;
        v4u o0, o1;
        o0.x = pk2(bf_lo(u0.x) * m0.x, bf_hi(u0.x) * m0.y); o0.y = pk2(bf_lo(u0.y) * m0.z, bf_hi(u0.y) * m0.w);
        o0.z = pk2(bf_lo(u0.z) * m1.x, bf_hi(u0.z) * m1.y); o0.w = pk2(bf_lo(u0.w) * m1.z, bf_hi(u0.w) * m1.w);
        o1.x = pk2(bf_lo(u1.x) * m2.x, bf_hi(u1.x) * m2.y); o1.y = pk2(bf_lo(u1.y) * m2.z, bf_hi(u1.y) * m2.w);
        o1.z = pk2(bf_lo(u1.z) * m3.x, bf_hi(u1.z) * m3.y); o1.w = pk2(bf_lo(u1.w) * m3.z, bf_hi(u1.w) * m3.w);
        *(v4u*)(A2 + row * PK2 + col) = o0; *(v4u*)(A2 + row * PK2 + col + 8) = o1; }
}
#define MIX_LDS_BARRIER() do { asm volatile("s_waitcnt lgkmcnt(0)" ::: "memory"); __builtin_amdgcn_s_barrier(); asm volatile("" ::: "memory"); } while (0)
__device__ __forceinline__ void mix_load_v(Frame& F, const bf16* Z, int R0, int g, v4u (&vr)[8]) {
    const int s_lo = F.lane >> 3, ch_lo = F.lane & 7;
#pragma unroll
    for (int i = 0; i < 8; ++i) { const int s = 8 * (F.wave + 8 * (i & 1)) + s_lo, ch = 8 * (i >> 1) + ch_lo;
        vr[i] = *(const v4u*)(Z + (size_t)(R0 + s) * (2 * SGW) + SGW + g * SGD + ch * 8); }
}
__device__ __forceinline__ void mix_load_u(Frame& F, const bf16* Z, int R0, int g, v4u (&u)[4][2]) {
    const int dg = F.wave & 3, th = F.wave >> 2, fr = F.lane & 15, fq = F.lane >> 4;
#pragma unroll
    for (int a = 0; a < 4; ++a) { const size_t row = (size_t)R0 + 16 * (th + 2 * a) + fr; const int col = g * SGD + 64 * dg + 16 * fq;
        u[a][0] = *(const v4u*)(Z + row * (2 * SGW) + col); u[a][1] = *(const v4u*)(Z + row * (2 * SGW) + col + 8); }
}
__device__ __forceinline__ void mix_transpose(Frame& F, int g, const v4u (&vr)[8], LAS unsigned char* VT, LAS const float* RS) {
    const int s_lo = F.lane >> 3, ch_lo = F.lane & 7;
#pragma unroll
    for (int i = 0; i < 8; ++i) { const int sh = F.wave + 8 * (i & 1), s = 8 * sh + s_lo, ch = 8 * (i >> 1) + ch_lo; const v4u w = vr[i];
        const float mean = RS[2 * s], rstd = RS[2 * s + 1];
        const f32x4 ga = *(const f32x4*)(F.in[10] + g * SGD + ch * 8), gb = *(const f32x4*)(F.in[10] + g * SGD + ch * 8 + 4), ba = *(const f32x4*)(F.in[11] + g * SGD + ch * 8), bb = *(const f32x4*)(F.in[11] + g * SGD + ch * 8 + 4);
        LAS unsigned short* col = (LAS unsigned short*)(VT + (size_t)(8 * ch) * MIX_PITCH + 16 * (sh ^ ch_lo) + 2 * s_lo);
        col[0 * (MIX_PITCH / 2)] = (unsigned short)(pk2((bf_lo(w.x) - mean) * rstd * ga.x + ba.x, 0.f) & 0xffffu); col[1 * (MIX_PITCH / 2)] = (unsigned short)(pk2((bf_hi(w.x) - mean) * rstd * ga.y + ba.y, 0.f) & 0xffffu);
        col[2 * (MIX_PITCH / 2)] = (unsigned short)(pk2((bf_lo(w.y) - mean) * rstd * ga.z + ba.z, 0.f) & 0xffffu); col[3 * (MIX_PITCH / 2)] = (unsigned short)(pk2((bf_hi(w.y) - mean) * rstd * ga.w + ba.w, 0.f) & 0xffffu);
        col[4 * (MIX_PITCH / 2)] = (unsigned short)(pk2((bf_lo(w.z) - mean) * rstd * gb.x + bb.x, 0.f) & 0xffffu); col[5 * (MIX_PITCH / 2)] = (unsigned short)(pk2((bf_hi(w.z) - mean) * rstd * gb.y + bb.y, 0.f) & 0xffffu);
        col[6 * (MIX_PITCH / 2)] = (unsigned short)(pk2((bf_lo(w.w) - mean) * rstd * gb.z + bb.z, 0.f) & 0xffffu); col[7 * (MIX_PITCH / 2)] = (unsigned short)(pk2((bf_hi(w.w) - mean) * rstd * gb.w + bb.w, 0.f) & 0xffffu); }
}
__device__ __forceinline__ void mix_mma_epi(Frame& F, int R0, int g, const v4u (&u)[4][2], LAS const unsigned char* WL, LAS const unsigned char* VT) {
    bf16* A2 = (bf16*)(F.ws + WS_A2);
    const int dg = F.wave & 3, th = F.wave >> 2, fr = F.lane & 15, fq = F.lane >> 4;
    f32x4 acc[4][4];
#pragma unroll
    for (int a = 0; a < 4; ++a)
#pragma unroll
        for (int j = 0; j < 4; ++j) acc[a][j] = (f32x4){0.f, 0.f, 0.f, 0.f};
#pragma unroll
    for (int ks = 0; ks < 4; ++ks) {
        bf16x8 af[4];
#pragma unroll
        for (int j = 0; j < 4; ++j) { const int d = 64 * dg + 16 * (fr >> 2) + 4 * j + (fr & 3);
            af[j] = *(const LAS bf16x8*)(VT + (size_t)d * MIX_PITCH + 16 * ((4 * ks + fq) ^ ((d >> 3) & 7))); }
#pragma unroll
        for (int a = 0; a < 4; ++a) { const int tt = th + 2 * a; if (2 * ks > tt) continue;
            const bf16x8 bw = *(const LAS bf16x8*)(WL + (size_t)(16 * tt + fr) * MIX_PITCH + (32 * ks + 8 * fq) * 2);
#pragma unroll
            for (int j = 0; j < 4; ++j) acc[a][j] = __builtin_amdgcn_mfma_f32_16x16x32_bf16(af[j], bw, acc[a][j], 0, 0, 0); }
    }
    const float* bsp = F.in[13] + g * SGC;
#pragma unroll
    for (int a = 0; a < 4; ++a) { const int t = 16 * (th + 2 * a) + fr; const float bb = bsp[t]; const size_t row = (size_t)R0 + t; const int col = g * SGD + 64 * dg + 16 * fq;
        const v4u u0 = u[a][0], u1 = u[a][1];
        const f32x4 m0 = acc[a][0] + bb, m1 = acc[a][1] + bb, m2 = acc[a][2] + bb, m3 = acc[a][3] + bb;
        v4u o0, o1;
        o0.x = pk2(bf_lo(u0.x) * m0.x, bf_hi(u0.x) * m0.y); o0.y = pk2(bf_lo(u0.y) * m0.z, bf_hi(u0.y) * m0.w);
        o0.z = pk2(bf_lo(u0.z) * m1.x, bf_hi(u0.z) * m1.y); o0.w = pk2(bf_lo(u0.w) * m1.z, bf_hi(u0.w) * m1.w);
        o1.x = pk2(bf_lo(u1.x) * m2.x, bf_hi(u1.x) * m2.y); o1.y = pk2(bf_lo(u1.y) * m2.z, bf_hi(u1.y) * m2.w);
        o1.z = pk2(bf_lo(u1.z) * m3.x, bf_hi(u1.z) * m3.y); o1.w = pk2(bf_lo(u1.w) * m3.z, bf_hi(u1.w) * m3.w);
        *(v4u*)(A2 + row * PK2 + col) = o0; *(v4u*)(A2 + row * PK2 + col + 8) = o1; }
}
struct MixS { unsigned v[8], u[8]; float st, wv, bv; float2 gam, bet; };
__device__ __forceinline__ void mix_sample_load(Frame& F, int hi, MixS& S) {
    const int g = (hi >> 1) & 7, b = hi >> 4; const size_t r0 = (size_t)MP + (size_t)b * DT; const int col = g * SGD + 128 * (hi & 1) + 2 * F.lane;
    const bf16* Z = (const bf16*)(F.ws + WS_Z); const float* stat = (const float*)(F.ws + WS_STAT);
#pragma unroll
    for (int s = 0; s < 8; ++s) { S.v[s] = *(const unsigned*)(Z + (r0 + s) * (2 * SGW) + SGW + col); S.u[s] = *(const unsigned*)(Z + (r0 + s) * (2 * SGW) + col); }
    S.st = stat[2 * r0 + (F.lane & 15)];
    S.wv = F.in[12][(size_t)g * SGC * SGC + (F.lane >> 3) * SGC + (F.lane & 7)];
    S.bv = F.in[13][g * SGC + (F.lane & 7)];
    S.gam = *(const float2*)(F.in[10] + col); S.bet = *(const float2*)(F.in[11] + col);
}
#define MIX_RDL(x, l) __int_as_float(__builtin_amdgcn_readlane(__float_as_int(x), (l)))
__device__ __forceinline__ void mix_sample_compute(Frame& F, int hi, const MixS& S) {
    const int g = (hi >> 1) & 7, b = hi >> 4; const size_t r0 = (size_t)MP + (size_t)b * DT; const int col = g * SGD + 128 * (hi & 1) + 2 * F.lane;
    bf16* A2 = (bf16*)(F.ws + WS_A2);
    const float wr = bf2f((bf16)(pk2(S.wv, 0.f) & 0xffffu));
    float v0[8], v1[8];
#pragma unroll
    for (int s = 0; s < 8; ++s) { const float sm = MIX_RDL(S.st, 2 * s), sq = MIX_RDL(S.st, 2 * s + 1);
        const float mean = sm * (1.f / SGW), rstd = 1.f / sqrtf(fmaxf(sq * (1.f / SGW) - mean * mean, 0.f) + LN_EPS);
        const float y0 = (bf_lo(S.v[s]) - mean) * rstd * S.gam.x + S.bet.x, y1 = (bf_hi(S.v[s]) - mean) * rstd * S.gam.y + S.bet.y;
        *(float2*)(F.out + OUT_SGV + (size_t)(b * DT + s) * SGW + col) = make_float2(y0, y1);
        const unsigned rb = pk2(y0, y1); v0[s] = bf_lo(rb); v1[s] = bf_hi(rb); }
#pragma unroll
    for (int t = 0; t < 8; ++t) { float m0 = 0.f, m1 = 0.f;
#pragma unroll
        for (int s = 0; s < 8; ++s) if (s <= t) { const float w = MIX_RDL(wr, 8 * t + s); m0 += v0[s] * w; m1 += v1[s] * w; }
        const float bb = MIX_RDL(S.bv, t); m0 += bb; m1 += bb;
        *(unsigned*)(A2 + (r0 + t) * PK2 + col) = pk2(bf_lo(S.u[t]) * m0, bf_hi(S.u[t]) * m1); }
}
__device__ __forceinline__ void mix_prompt_pair(Frame& F, int itA, int itB) {
    const int g = itA & 7; const int R0A = (itA >> 3) * SGC, R0B = (itB >> 3) * SGC;
    const bf16* Z = (const bf16*)(F.ws + WS_Z); const bf16* Wc = (const bf16*)(F.ws + WS_WC); const float* stat = (const float*)(F.ws + WS_STAT);
    LAS unsigned char* WL = F.lds; LAS unsigned char* VT = F.lds + 128 * MIX_PITCH;
    LAS float* RS = (LAS float*)(F.lds + 128 * MIX_PITCH + 256 * MIX_PITCH);
    const int hi = F.vcu * NWAVES + F.wave;
    float sm = 0.f, sq = 0.f; v4u wq[4]; MixS S;
    mix_sample_load(F, hi, S);
    if (F.tid < 2 * SGC) { const size_t r = (F.tid < SGC) ? (size_t)(R0A + F.tid) : (size_t)(R0B + F.tid - SGC); sm = stat[2 * r]; sq = stat[2 * r + 1]; }
#pragma unroll
    for (int i = 0; i < 4; ++i) { const int idx = F.tid + NTHR * i, t = idx >> 4, ch = idx & 15; wq[i] = *(const v4u*)(Wc + ((size_t)(g * SGC + t)) * SGC + ch * 8); }
    v4u vA[8], vB[8], uA[4][2], uB[4][2];
    mix_load_v(F, Z, R0A, g, vA); mix_load_u(F, Z, R0A, g, uA); mix_load_v(F, Z, R0B, g, vB);
    mix_sample_compute(F, hi, S);
    MIX_LDS_BARRIER();
    if (F.tid < 2 * SGC) { const float mean = sm * (1.f / SGW), var = fmaxf(sq * (1.f / SGW) - mean * mean, 0.f);
        RS[2 * F.tid] = mean; RS[2 * F.tid + 1] = 1.f / sqrtf(var + LN_EPS); }
#pragma unroll
    for (int i = 0; i < 4; ++i) { const int idx = F.tid + NTHR * i, t = idx >> 4, ch = idx & 15; *(LAS v4u*)(WL + t * MIX_PITCH + ch * 16) = wq[i]; }
    MIX_LDS_BARRIER();
    mix_transpose(F, g, vA, VT, RS);
    mix_load_u(F, Z, R0B, g, uB);
    MIX_LDS_BARRIER();
    mix_mma_epi(F, R0A, g, uA, WL, VT);
    MIX_LDS_BARRIER();
    mix_transpose(F, g, vB, VT, RS + 2 * SGC);
    MIX_LDS_BARRIER();
    mix_mma_epi(F, R0B, g, uB, WL, VT);
}
__device__ __forceinline__ void p11_mix(Frame& F) {
    constexpr int NPI = (MP / SGC) * SGG, NSH = 2 * DB * SGG;
    if (2 * F.G == NPI && F.G * NWAVES == NSH) mix_prompt_pair(F, F.vcu, F.vcu + F.G);
    else {
        for (int it = F.vcu; it < NPI; it += F.G) mix_prompt_item(F, it, it == F.vcu || (F.G & 7) != 0);
        const int gw = F.vcu * NWAVES + F.wave, NGW = F.G * NWAVES;
        for (int hi = gw; hi < NSH; hi += NGW) { MixS S; mix_sample_load(F, hi, S); mix_sample_compute(F, hi, S); }
    }
    __syncthreads();
}

struct Args { const float* in[21]; float* out; unsigned char* ws; int ph_lo, ph_hi, coop, pad; };
__global__ void __launch_bounds__(NTHR, 2) fwd_kernel(Args args) {
    extern __shared__ __attribute__((aligned(16))) unsigned char lds[];
    Frame F;
    F.lds = (LAS unsigned char*)lds;
    F.MISC = (volatile LAS unsigned*)(F.lds + MISC_OFF);
    F.tid = threadIdx.x; F.lane = F.tid & 63; F.wave = __builtin_amdgcn_readfirstlane(F.tid >> 6);
    F.G = gridDim.x; { const int bx = blockIdx.x; F.vcu = (F.G % 8 == 0) ? (bx % 8) * (F.G / 8) + bx / 8 : bx; }
#pragma unroll
    for (int i = 0; i < 21; ++i) F.in[i] = args.in[i];
    F.out = args.out; F.ws = args.ws; F.ctl = (unsigned*)(args.ws + WS_CTL);
    if (F.tid < 64) F.MISC[F.tid] = 0u;
    __syncthreads();
    XcdBarrier bar; bar.bar = F.ctl + CW_BAR; bar.x = 0; bar.st = nullptr;
    if (args.coop) bar = xcd_barrier_post(F.ctl + CW_BAR, F.MISC + 8);
    unsigned char* ws = F.ws;
    bf16* XB = (bf16*)(ws + WS_XB); bf16* A2 = (bf16*)(ws + WS_A2); bf16* HB = (bf16*)(ws + WS_HB);
    LAS unsigned char* ring = F.lds;

    const int lo = args.ph_lo, hi = args.ph_hi;
#define IN(k) (lo <= (k) && (k) < hi)
#define AGAIN(k) (IN(k) && (((PROBE_MASK) >> (k)) & 1))
#define SEAM(k) do { if (IN(k) && IN((k) + 1)) xcd_barrier(bar); } while (0)
#define GEMM_LN_B(INST, Amat, Bmat, Kdim, GAM, BET, OUTF, OUTB) { pg9::Gemm g{Amat, Bmat, M, DM, Kdim, (Kdim) + 64, (Kdim) + 64}; pg9::Order S; S.init(M, DM, F.G, (int)blockIdx.x); \
        pg9::PanelStats st{(unsigned*)(ws + WS_XCH), F.ctl + CW_LN + (INST) * LN_BANK, F.ctl + CW_TMO, LN_EPS}; pg9::EpiLn E{XB, PK2, ALPHA, GAM, BET, OUTF, OUTB, PK2, st}; \
        pg9::gemm_phase<pg9::EpiLn, false>(ring, g, S, E); }
#define GEMM_LN(k, INST, Amat, Bmat, Kdim, GAM, BET, OUTF, OUTB) if (IN(k)) GEMM_LN_B(INST, Amat, Bmat, Kdim, GAM, BET, OUTF, OUTB) SEAM(k)
#define GEMM_UP_B(l) { pg9::Gemm g{XB, (const bf16*)(ws + WS_W1) + (size_t)(l) * DFF * PK2, M, DFF, DM, PK2, PK2}; pg9::Order S; S.init(M, DFF, F.G, (int)blockIdx.x); pg9::EpiBf16<2> E{HB, PK8, nullptr}; \
        pg9::gemm_phase<pg9::EpiBf16<2>>(ring, g, S, E); }
#define GEMM_UP(k, l) if (IN(k)) GEMM_UP_B(l) if (AGAIN(k)) GEMM_UP_B(l) SEAM(k)
#define GEMM_IN_B { pg9::Gemm g{XB, (const bf16*)(ws + WS_WIN), M, NQKV, DM, PK2, PK2}; pg9::Order S; S.init(M, NQKV, F.G, (int)blockIdx.x); pg9::EpiBf16<0> E{(bf16*)(ws + WS_PROJ), NPROJ, nullptr}; \
        pg9::gemm_phase<pg9::EpiBf16<0>>(ring, g, S, E); }
#define GEMM_SG_B { pg9::Gemm g{XB, (const bf16*)(ws + WS_SGIN), M, 2 * SGW, DM, PK2, PK2}; pg9::Order S; S.init(M, 2 * SGW, F.G, (int)blockIdx.x); pg9::EpiSg E{(bf16*)(ws + WS_Z), 2 * SGW, F.in[9], (float*)(ws + WS_STAT)}; \
        pg9::gemm_phase<pg9::EpiSg>(ring, g, S, E); }
    if (IN(0)) p0_prologue(F); if (AGAIN(0)) p0_prologue(F);
    SEAM(0);
    if (IN(1)) GEMM_IN_B if (AGAIN(1)) GEMM_IN_B
    SEAM(1);
    if (IN(2)) p2a_gla_prep(F);
    SEAM(2);
    if (IN(3)) p2_gla(F, 0); if (AGAIN(3)) p2_gla(F, 1);
    SEAM(3);
    if (IN(4) && F.G == 256) {
        const int c = (int)blockIdx.x, wgid = (c & 7) * 32 + (c >> 3), pm0 = (wgid >> 6) * 8 + (wgid & 7), pn0 = (wgid & 63) >> 3;
        gate_panel_and_wait(F, pm0, pn0, F.ctl + CW_GATE); }
    GEMM_LN(4, 0, A2, (const bf16*)(ws + WS_WOUT), DM, F.in[17], F.in[18], (float*)nullptr, XB);
    GEMM_UP(5, 0);
    GEMM_LN(6, 1, HB, (const bf16*)(ws + WS_W2), DFF, F.in[19], F.in[20], (float*)nullptr, XB);
    if (IN(7)) GEMM_SG_B
    SEAM(7);
    if (IN(8)) p11_mix(F); if (AGAIN(8)) p11_mix(F);
    SEAM(8);
    GEMM_LN(9, 2, A2, (const bf16*)(ws + WS_SGOUT), SGW, F.in[17] + DM, F.in[18] + DM, (float*)nullptr, XB);
    GEMM_UP(10, 1);
    GEMM_LN(11, 3, HB, (const bf16*)(ws + WS_W2) + (size_t)DM * PK8, DFF, F.in[19] + DM, F.in[20] + DM, F.out + OUT_Y, (bf16*)nullptr);
#undef IN
#undef AGAIN
#undef SEAM
}

extern "C" void kernel_launch(void* const* d_in, const int* in_sizes, int n_in, void* d_out, int out_size, void* d_ws, size_t ws_size, hipStream_t stream) {
    static int grid = 0;
    if (grid == 0) {
        if (n_in != 21 || (size_t)out_size != OUT_END || ws_size < WS_END) { fprintf(stderr, "kernel_launch: unexpected shapes: n_in %d out %d ws %zu (need %zu)\n", n_in, out_size, ws_size, (size_t)WS_END); grid = -1; return; }
        int dev = 0, cus = 0, per_cu = 0;
        if (hipGetDevice(&dev) != hipSuccess || hipDeviceGetAttribute(&cus, hipDeviceAttributeMultiprocessorCount, dev) != hipSuccess) { fprintf(stderr, "kernel_launch: device query failed\n"); grid = -1; return; }
        if (hipFuncSetAttribute((const void*)fwd_kernel, hipFuncAttributeMaxDynamicSharedMemorySize, LDS_BYTES) != hipSuccess) { fprintf(stderr, "kernel_launch: hipFuncSetAttribute failed\n"); grid = -1; return; }
        if (hipOccupancyMaxActiveBlocksPerMultiprocessor(&per_cu, (const void*)fwd_kernel, NTHR, LDS_BYTES) != hipSuccess || per_cu < 1) { fprintf(stderr, "kernel_launch: occupancy query says %d blocks per CU\n", per_cu); per_cu = 1; }
        (void)hipGetLastError();
        grid = cus * 1;
    }
    if (grid < 0) return;
    if (hipMemsetAsync((char*)d_ws + WS_CTL, 0, CTL_ZERO_BYTES, stream) != hipSuccess) { fprintf(stderr, "kernel_launch: memset failed\n"); return; }
    Args a{};
    for (int i = 0; i < 21; ++i) a.in[i] = (const float*)d_in[i];
    a.out = (float*)d_out; a.ws = (unsigned char*)d_ws;
    if (N_LAUNCHES == 1) {
        a.ph_lo = 0; a.ph_hi = NPHASE; a.coop = 1;
        void* kargs[] = {&a};
        hipError_t e = hipLaunchCooperativeKernel((const void*)fwd_kernel, dim3(grid), dim3(NTHR), kargs, LDS_BYTES, stream);
        if (e != hipSuccess) fprintf(stderr, "kernel_launch: cooperative launch failed: %s (grid %d)\n", hipGetErrorString(e), grid);
    } else {
        for (int ph = 0; ph < NPHASE; ++ph) {
            a.ph_lo = ph; a.ph_hi = ph + 1; a.coop = 0;
            hipLaunchKernelGGL(fwd_kernel, dim3(grid), dim3(NTHR), LDS_BYTES, stream, a);
            const hipError_t le = hipPeekAtLastError();
            if (le != hipSuccess) { fprintf(stderr, "kernel_launch: launch %d failed: %s\n", ph, hipGetErrorName(le)); break; }
        }
    }
}
```
